# Optimizing an MI355X kernel written in HIP

```python
import math
import jax, jax.numpy as jnp
from jax import lax
import numpy as np


D_MODEL = 1024
BATCH = 16
SEQ = 2048
DEPTH = 1

D_RNN = D_MODEL
N_RNN_BLOCKS = 16
RNN_BLOCK = D_RNN // N_RNN_BLOCKS
RNN_CONV_W = 4
RNN_CONV_LEFT = 2
RG_C = 8.0
N_DIR = 2
N_HEADS = 8
HEAD_DIM = 64
V_DIM = 2 * HEAD_DIM
ATTN_WIDTH = N_HEADS * V_DIM
QK_WIDTH = N_HEADS * 2 * HEAD_DIM
ROPE_DIM = HEAD_DIM // 4
ROPE_THETA = 500000.0
Q_BLOCK = 128
N_BRANCHES = 2
D_FF = 2816
FFN_CONV_W = 3
FFN_CONV_LEFT = 1
N_MOD = 6
NORM_EPS = 1e-6

IN_SIZES = (D_RNN, D_RNN, QK_WIDTH, QK_WIDTH, ATTN_WIDTH, N_BRANCHES * D_MODEL)
IN_COLS = sum(IN_SIZES)
IN_SPLITS = tuple(int(v) for v in np.cumsum(IN_SIZES)[:-1])

kernel_name = "hybrid_rglru_diffattn_convffn_encoder_block"


def lambda_init_fn(layer_idx):
    return 0.8 - 0.6 * math.exp(-0.3 * layer_idx)


def rms_norm(x, g):
    xf = x.astype(jnp.float32)
    y = xf * lax.rsqrt(jnp.mean(xf * xf, axis=-1, keepdims=True) + NORM_EPS)
    return (y * g.astype(jnp.float32)).astype(x.dtype)


def depthwise_conv(x, w, b, left):
    K = w.shape[0]
    S = x.shape[1]
    xp = jnp.pad(x, ((0, 0), (left, K - 1 - left), (0, 0)))
    out = b
    for k in range(K):
        out = out + xp[:, k:k + S] * w[k]
    return out


def apply_partial_rope(t, cos, sin):
    half = ROPE_DIM // 2
    t1 = t[..., :half]
    t2 = t[..., half:ROPE_DIM]
    rot = jnp.concatenate([t1 * cos - t2 * sin, t2 * cos + t1 * sin], axis=-1)
    return jnp.concatenate([rot, t[..., ROPE_DIM:]], axis=-1)


def _lin_comb(left, right):
    a_l, b_l = left
    a_r, b_r = right
    return a_l * a_r, a_r * b_l + b_r


def bidir_rg_lru(xc, w_a, b_a, w_i, b_i, lam):
    B, S, _ = xc.shape
    xb = xc.reshape(B, S, N_RNN_BLOCKS, RNN_BLOCK)
    r = jax.nn.sigmoid(jnp.einsum('bsnk,dnkj->dbsnj', xb, w_a).reshape(N_DIR, B, S, D_RNN)
                       + b_a[:, None, None, :])
    i = jax.nn.sigmoid(jnp.einsum('bsnk,dnkj->dbsnj', xb, w_i).reshape(N_DIR, B, S, D_RNN)
                       + b_i[:, None, None, :])
    log_a = -RG_C * r.astype(jnp.float32) * jax.nn.softplus(-lam.astype(jnp.float32))[:, None, None, :]
    a = jnp.exp(log_a)
    u = jnp.sqrt(-jnp.expm1(2.0 * log_a)) * (i * xc[None]).astype(jnp.float32)
    _, h_fwd = lax.associative_scan(_lin_comb, (a[0], u[0]), axis=1)
    _, h_bwd = lax.associative_scan(_lin_comb, (a[1], u[1]), axis=1, reverse=True)
    return (h_fwd + h_bwd).astype(xc.dtype)


def diff_attention(q, k, v, lam, subln_g, lam_init):
    B, S = q.shape[0], q.shape[1]
    n_blk = S // Q_BLOCK
    scale = HEAD_DIM ** -0.5
    qb = q.reshape(B, n_blk, Q_BLOCK, N_HEADS, 2, HEAD_DIM).transpose(1, 0, 2, 3, 4, 5)

    def block(qblk):
        s = jnp.einsum('bqhcd,bkhcd->bhcqk', qblk, k).astype(jnp.float32) * scale
        p = jax.nn.softmax(s, axis=-1)
        w = p[:, :, 0] - lam * p[:, :, 1]
        return jnp.einsum('bhqk,bkhe->bqhe', w.astype(v.dtype), v)

    o = lax.map(block, qb)
    o = o.transpose(1, 0, 2, 3, 4).reshape(B, S, N_HEADS, V_DIM)
    o = rms_norm(o, subln_g) * (1.0 - lam_init)
    return o.reshape(B, S, ATTN_WIDTH)


def setup_inputs(seed: int = 0) -> dict:
    key = jax.random.key(seed)
    ks = iter(jax.random.split(key, 40))

    def nrm(shape, scale):
        return jax.random.normal(next(ks), shape, jnp.float32) * scale

    L = DEPTH
    x = nrm((BATCH, SEQ, D_MODEL), 1.0)
    c = nrm((BATCH, D_MODEL), 1.0)
    offs = jax.random.randint(next(ks), (BATCH, 1), 0, 4096, dtype=jnp.int32)
    positions = (jnp.arange(SEQ, dtype=jnp.int32)[None, :] + offs).astype(jnp.int32)

    u = jax.random.uniform(next(ks), (L, N_DIR, D_RNN), jnp.float32, 0.9, 0.999)
    base = u ** (1.0 / RG_C)
    rg_lambda = jnp.log(base / (1.0 - base))

    return {
        "x": x,
        "c": c,
        "positions": positions,
        "w_ada": nrm((L, D_MODEL, N_MOD * D_MODEL), 0.5 * D_MODEL ** -0.5),
        "b_ada": nrm((L, N_MOD * D_MODEL), 0.01),
        "norm1_g": 1.0 + nrm((L, D_MODEL), 0.02),
        "w_in": nrm((L, D_MODEL, IN_COLS), D_MODEL ** -0.5),
        "conv_rnn_w": nrm((L, RNN_CONV_W, D_RNN), RNN_CONV_W ** -0.5),
        "conv_rnn_b": nrm((L, D_RNN), 0.01),
        "w_rg_a": nrm((L, N_DIR, N_RNN_BLOCKS, RNN_BLOCK, RNN_BLOCK), RNN_BLOCK ** -0.5),
        "b_rg_a": nrm((L, N_DIR, D_RNN), 0.01),
        "w_rg_i": nrm((L, N_DIR, N_RNN_BLOCKS, RNN_BLOCK, RNN_BLOCK), RNN_BLOCK ** -0.5),
        "b_rg_i": nrm((L, N_DIR, D_RNN), 0.01),
        "rg_lambda": rg_lambda,
        "w_rnn_o": nrm((L, D_RNN, D_MODEL), D_RNN ** -0.5),
        "lam_q1": nrm((L, HEAD_DIM), 0.1),
        "lam_k1": nrm((L, HEAD_DIM), 0.1),
        "lam_q2": nrm((L, HEAD_DIM), 0.1),
        "lam_k2": nrm((L, HEAD_DIM), 0.1),
        "subln_g": 1.0 + nrm((L, V_DIM), 0.02),
        "w_attn_o": nrm((L, ATTN_WIDTH, D_MODEL), ATTN_WIDTH ** -0.5),
        "w_out": nrm((L, D_MODEL, D_MODEL), D_MODEL ** -0.5),
        "norm2_g": 1.0 + nrm((L, D_MODEL), 0.02),
        "w_up": nrm((L, D_MODEL, 2 * D_FF), D_MODEL ** -0.5),
        "conv_ffn_w": nrm((L, FFN_CONV_W, 2 * D_FF), FFN_CONV_W ** -0.5),
        "conv_ffn_b": nrm((L, 2 * D_FF), 0.01),
        "w_down": nrm((L, D_FF, D_MODEL), D_FF ** -0.5),
        "final_g": 1.0 + nrm((D_MODEL,), 0.02),
    }


def reference(x, c, positions, w_ada, b_ada, norm1_g, w_in, conv_rnn_w, conv_rnn_b,
              w_rg_a, b_rg_a, w_rg_i, b_rg_i, rg_lambda, w_rnn_o,
              lam_q1, lam_k1, lam_q2, lam_k2, subln_g, w_attn_o, w_out,
              norm2_g, w_up, conv_ffn_w, conv_ffn_b, w_down, final_g):
    B, S, _ = x.shape

    inv_freq = ROPE_THETA ** (-jnp.arange(0, ROPE_DIM, 2, dtype=jnp.float32) / ROPE_DIM)
    ang = positions.astype(jnp.float32)[..., None] * inv_freq
    cos = jnp.cos(ang)[:, :, None, None, :].astype(x.dtype)
    sin = jnp.sin(ang)[:, :, None, None, :].astype(x.dtype)
    c_act = jax.nn.silu(c)

    for l in range(DEPTH):
        lam_init = lambda_init_fn(l)
        mod = (c_act @ w_ada[l] + b_ada[l])[:, None, :]
        sh1, sc1, g1, sh2, sc2, g2 = jnp.split(mod, N_MOD, axis=-1)

        h = rms_norm(x, norm1_g[l]) * (1.0 + sc1) + sh1
        proj = h @ w_in[l]
        xr, yr, q, k, v, gates = jnp.split(proj, IN_SPLITS, axis=-1)

        xr = depthwise_conv(xr, conv_rnn_w[l], conv_rnn_b[l], RNN_CONV_LEFT)
        hr = bidir_rg_lru(xr, w_rg_a[l], b_rg_a[l], w_rg_i[l], b_rg_i[l], rg_lambda[l])
        branch_a = (hr * jax.nn.gelu(yr)) @ w_rnn_o[l]

        q = apply_partial_rope(q.reshape(B, S, N_HEADS, 2, HEAD_DIM), cos, sin)
        k = apply_partial_rope(k.reshape(B, S, N_HEADS, 2, HEAD_DIM), cos, sin)
        v = v.reshape(B, S, N_HEADS, V_DIM)
        lam = (jnp.exp(jnp.sum(lam_q1[l].astype(jnp.float32) * lam_k1[l].astype(jnp.float32)))
               - jnp.exp(jnp.sum(lam_q2[l].astype(jnp.float32) * lam_k2[l].astype(jnp.float32)))
               + lam_init)
        branch_b = diff_attention(q, k, v, lam, subln_g[l], lam_init) @ w_attn_o[l]

        gate_a, gate_b = jnp.split(jax.nn.sigmoid(gates), N_BRANCHES, axis=-1)
        merged = gate_a * branch_a + gate_b * branch_b
        x = x + g1 * (merged @ w_out[l])

        h = rms_norm(x, norm2_g[l]) * (1.0 + sc2) + sh2
        up = depthwise_conv(h @ w_up[l], conv_ffn_w[l], conv_ffn_b[l], FFN_CONV_LEFT)
        val, gt = jnp.split(up, 2, axis=-1)
        x = x + g2 * ((jax.nn.silu(gt) * val) @ w_down[l])

    return rms_norm(x, final_g)
```

```cpp
#include <hip/hip_runtime.h>
#include <cstdint>
#include <cstdio>

typedef unsigned short bf16_t;
constexpr int DM = 1024, BATCH = 16, SEQ = 2048, M = BATCH * SEQ, INCOLS = 7168, DFF = 2816, NMODC = 6 * DM;
constexpr float EPS = 1e-6f;
constexpr float C2 = 0.125f * 1.4426950408889634f;
constexpr size_t MiB = 1u << 20;
constexpr size_t WS_MOD = 1 * MiB, WS_COS = 2 * MiB, WS_SIN = 3 * MiB;
constexpr size_t WS_H = 48 * MiB, WS_XR = 112 * MiB, WS_AO = 176 * MiB, WS_K = 304 * MiB, WS_V = 368 * MiB, WS_HF = 432 * MiB;
constexpr size_t WS_UP = 112 * MiB, WS_ACT = 288 * MiB;

__device__ __forceinline__ float bf2f(bf16_t v) { return __uint_as_float((unsigned)v << 16); }
__device__ __forceinline__ bf16_t f2bf(float f) { unsigned u = __float_as_uint(f); return (bf16_t)((u + 0x7fffu + ((u >> 16) & 1u)) >> 16); }
__device__ __forceinline__ float sigmoidf_(float x) { return 1.f / (1.f + __expf(-x)); }
__device__ __forceinline__ float gelu_tanh(float x) { const float u = 1.5957691216057308f * (x + 0.044715f * x * x * x); return x / (1.f + __expf(-u)); }

__global__ void __launch_bounds__(256) k_mod(const float* __restrict__ c, const float* __restrict__ w_ada, const float* __restrict__ b_ada, float* __restrict__ mod,
                                             const float* lq1, const float* lk1, const float* lq2, const float* lk2) {
    const int j = blockIdx.x * 256 + threadIdx.x, b = blockIdx.y;
    float acc = b_ada[j];
    for (int k = 0; k < DM; ++k) { const float cv = c[b * DM + k]; acc += (cv / (1.f + __expf(-cv))) * w_ada[(size_t)k * NMODC + j]; }
    mod[b * NMODC + j] = acc;
    if (blockIdx.x == 0 && blockIdx.y == 0 && threadIdx.x == 0) {
        float s1 = 0.f, s2 = 0.f;
        for (int i = 0; i < 64; ++i) { s1 += lq1[i] * lk1[i]; s2 += lq2[i] * lk2[i]; }
        mod[BATCH * NMODC] = __expf(s1) - __expf(s2) + 0.2f;
    }
}
__global__ void __launch_bounds__(256) k_rope_tab(const int* __restrict__ pos, float* __restrict__ cs, float* __restrict__ sn) {
    const int idx = blockIdx.x * 256 + threadIdx.x; if (idx >= M * 8) return;
    const int row = idx >> 3, i = idx & 7;
    const float invf = powf(500000.0f, -(float)i / 8.0f);
    const float ang = (float)pos[row] * invf;
    const double rev = (double)ang * 0.15915494309189535;
    const double fr = rev - rint(rev);
    cs[idx] = __builtin_amdgcn_cosf((float)fr); sn[idx] = __builtin_amdgcn_sinf((float)fr);
}
__global__ void __launch_bounds__(256) k_normmod(const float* __restrict__ x, const float* __restrict__ g, const float* __restrict__ mod, int sh_off, int sc_off, bf16_t* __restrict__ out) {
    const int row = blockIdx.x * 4 + (threadIdx.x >> 6), lane = threadIdx.x & 63, b = row / SEQ;
    const float* xr = x + (size_t)row * DM; float v[16]; float ss = 0.f;
#pragma unroll
    for (int j = 0; j < 16; ++j) { v[j] = xr[lane + 64 * j]; ss += v[j] * v[j]; }
#pragma unroll
    for (int o = 1; o < 64; o <<= 1) ss += __shfl_xor(ss, o);
    const float rstd = rsqrtf(ss * (1.f / DM) + EPS);
#pragma unroll
    for (int j = 0; j < 16; ++j) { const int k = lane + 64 * j; out[(size_t)row * DM + k] = f2bf(v[j] * rstd * g[k] * (1.f + mod[b * NMODC + sc_off + k]) + mod[b * NMODC + sh_off + k]); }
}
__global__ void __launch_bounds__(256) k_final(float* __restrict__ x, const float* __restrict__ g) {
    const int row = blockIdx.x * 4 + (threadIdx.x >> 6), lane = threadIdx.x & 63;
    float* xr = x + (size_t)row * DM; float v[16]; float ss = 0.f;
#pragma unroll
    for (int j = 0; j < 16; ++j) { v[j] = xr[lane + 64 * j]; ss += v[j] * v[j]; }
#pragma unroll
    for (int o = 1; o < 64; o <<= 1) ss += __shfl_xor(ss, o);
    const float rstd = rsqrtf(ss * (1.f / DM) + EPS);
#pragma unroll
    for (int j = 0; j < 16; ++j) { const int k = lane + 64 * j; xr[k] = v[j] * rstd * g[k]; }
}
template <class Epi> __global__ void __launch_bounds__(256) nv_gemm(const bf16_t* __restrict__ A, int lda, const float* __restrict__ W, int N, int K, Epi E) {
    __shared__ float As[16][68]; __shared__ float Bs[16][64];
    const int tid = threadIdx.x, tx = tid & 15, ty = tid >> 4, m0 = blockIdx.y * 64, n0 = blockIdx.x * 64;
    float acc[4][4] = {};
    for (int k0 = 0; k0 < K; k0 += 16) {
        { const int r = tid >> 2, kk = (tid & 3) * 4; const bf16_t* ap = A + (size_t)(m0 + r) * lda + k0 + kk;
          As[kk + 0][r] = bf2f(ap[0]); As[kk + 1][r] = bf2f(ap[1]); As[kk + 2][r] = bf2f(ap[2]); As[kk + 3][r] = bf2f(ap[3]); }
        { const int kk = tid >> 4, n = (tid & 15) * 4; const float4 w = *(const float4*)(W + (size_t)(k0 + kk) * N + n0 + n); *(float4*)&Bs[kk][n] = w; }
        __syncthreads();
#pragma unroll
        for (int k = 0; k < 16; ++k) { const float4 a = *(const float4*)&As[k][ty * 4]; const float4 b = *(const float4*)&Bs[k][tx * 4];
            const float av[4] = {a.x, a.y, a.z, a.w}, bv[4] = {b.x, b.y, b.z, b.w};
#pragma unroll
            for (int i = 0; i < 4; ++i)
#pragma unroll
                for (int j = 0; j < 4; ++j) acc[i][j] += av[i] * bv[j]; }
        __syncthreads();
    }
#pragma unroll
    for (int i = 0; i < 4; ++i)
#pragma unroll
        for (int j = 0; j < 4; ++j) E(m0 + ty * 4 + i, n0 + tx * 4 + j, acc[i][j]);
}
struct EProj { bf16_t *XR, *AO, *KB, *VB, *GT;
    __device__ void operator()(int m, int n, float v) const { const bf16_t o = f2bf(v);
        if (n < 1024) XR[(size_t)m * 1024 + n] = o; else if (n < 2048) AO[(size_t)m * 2048 + n - 1024] = o; else if (n < 3072) AO[(size_t)m * 2048 + 1024 + n - 2048] = o;
        else if (n < 4096) KB[(size_t)m * 1024 + n - 3072] = o; else if (n < 5120) VB[(size_t)m * 1024 + n - 4096] = o; else GT[(size_t)m * 2048 + n - 5120] = o; } };
struct EMergeA { const bf16_t* GT; bf16_t* MG; __device__ void operator()(int m, int n, float v) const { MG[(size_t)m * 1024 + n] = f2bf(sigmoidf_(bf2f(GT[(size_t)m * 2048 + n])) * v); } };
struct EMergeB { const bf16_t* GT; bf16_t* MG; __device__ void operator()(int m, int n, float v) const { MG[(size_t)m * 1024 + n] = f2bf(bf2f(MG[(size_t)m * 1024 + n]) + sigmoidf_(bf2f(GT[(size_t)m * 2048 + 1024 + n])) * v); } };
struct EOut { const float* x; const float* mod; float* X1; __device__ void operator()(int m, int n, float v) const { X1[(size_t)m * 1024 + n] = x[(size_t)m * 1024 + n] + mod[(m / SEQ) * NMODC + 2048 + n] * v; } };
struct EUp { bf16_t* UP; __device__ void operator()(int m, int n, float v) const { UP[(size_t)m * 5632 + n] = f2bf(v); } };
struct EDown { float* X; const float* mod; __device__ void operator()(int m, int n, float v) const { X[(size_t)m * 1024 + n] += mod[(m / SEQ) * NMODC + 5120 + n] * v; } };

__global__ void __launch_bounds__(256) k_rope(bf16_t* __restrict__ AO, bf16_t* __restrict__ KB, const float* __restrict__ cs, const float* __restrict__ sn) {
    const int idx = blockIdx.x * 256 + threadIdx.x; const int row = idx >> 4, hc = idx & 15;
    bf16_t* q = AO + (size_t)row * 2048 + 1024 + hc * 64; bf16_t* k = KB + (size_t)row * 1024 + hc * 64;
    float qv[64];
#pragma unroll
    for (int d = 0; d < 64; ++d) qv[d] = bf2f(q[d]);
#pragma unroll
    for (int i = 0; i < 8; ++i) { const float c = cs[row * 8 + i], s = sn[row * 8 + i]; const float a = qv[i], b = qv[i + 8]; qv[i] = a * c - b * s; qv[i + 8] = b * c + a * s;
        const float ka = bf2f(k[i]), kb = bf2f(k[i + 8]); k[i] = f2bf(ka * c - kb * s); k[i + 8] = f2bf(kb * c + ka * s); }
#pragma unroll
    for (int d = 0; d < 64; ++d) q[d] = f2bf(qv[d] * C2);
}
__global__ void __launch_bounds__(64) nv_rglru(const bf16_t* __restrict__ XR, bf16_t* __restrict__ AO, bf16_t* __restrict__ HF, const float* __restrict__ cw, const float* __restrict__ cb,
                                               const float* __restrict__ w_a, const float* __restrict__ b_a, const float* __restrict__ w_i, const float* __restrict__ b_i, const float* __restrict__ lam) {
    __shared__ float wA[64][64]; __shared__ float wI[64][64]; __shared__ float xcs[64];
    const int j = threadIdx.x, n = blockIdx.x, b = blockIdx.y, ch = n * 64 + j;
    const float c0 = cw[0 * DM + ch], c1 = cw[1 * DM + ch], c2 = cw[2 * DM + ch], c3 = cw[3 * DM + ch], cbv = cb[ch];
    for (int d = 0; d < 2; ++d) {
        __syncthreads();
        for (int k = 0; k < 64; ++k) { wA[k][j] = w_a[(((size_t)d * 16 + n) * 64 + k) * 64 + j]; wI[k][j] = w_i[(((size_t)d * 16 + n) * 64 + k) * 64 + j]; }
        const float ba = b_a[d * DM + ch], bi = b_i[d * DM + ch], sp = log1pf(__expf(-lam[d * DM + ch]));
        float h = 0.f;
        for (int tt = 0; tt < SEQ; ++tt) {
            const int t = d == 0 ? tt : SEQ - 1 - tt; const size_t row = (size_t)b * SEQ + t;
            float xc = cbv;
            if (t >= 2) xc += c0 * bf2f(XR[(row - 2) * DM + ch]);
            if (t >= 1) xc += c1 * bf2f(XR[(row - 1) * DM + ch]);
            xc += c2 * bf2f(XR[row * DM + ch]);
            if (t + 1 < SEQ) xc += c3 * bf2f(XR[(row + 1) * DM + ch]);
            __syncthreads(); xcs[j] = xc; __syncthreads();
            float ga = ba, gi = bi;
#pragma unroll 16
            for (int k = 0; k < 64; ++k) { const float xv = xcs[k]; ga += xv * wA[k][j]; gi += xv * wI[k][j]; }
            const float r = sigmoidf_(ga), ig = sigmoidf_(gi), la = -8.f * r * sp, a = __expf(la), u = sqrtf(-expm1f(2.f * la)) * ig * xc;
            h = a * h + u;
            if (d == 0) HF[row * DM + ch] = f2bf(h);
            else { const float yr = bf2f(AO[row * 2048 + ch]); AO[row * 2048 + ch] = f2bf((h + bf2f(HF[row * DM + ch])) * gelu_tanh(yr)); }
        }
    }
}
__global__ void __launch_bounds__(256) nv_attn(bf16_t* __restrict__ AO, const bf16_t* __restrict__ KB, const bf16_t* __restrict__ VB, const float* __restrict__ subg, const float* __restrict__ scal) {
    __shared__ float Ks[64][64]; __shared__ float Vs[64][128];
    const int tid = threadIdx.x, qi = tid >> 3, chn = tid & 7, h = blockIdx.y, b = blockIdx.z;
    const size_t row = (size_t)b * SEQ + blockIdx.x * 32 + qi; const float lam = scal[0];
    float res[16];
    for (int c = 0; c < 2; ++c) {
        float q[64];
#pragma unroll
        for (int d = 0; d < 64; ++d) q[d] = bf2f(AO[row * 2048 + 1024 + h * 128 + c * 64 + d]);
        float m = -1e30f, l = 0.f, acc[16];
#pragma unroll
        for (int e = 0; e < 16; ++e) acc[e] = 0.f;
        for (int kt = 0; kt < SEQ / 64; ++kt) {
            __syncthreads();
            for (int i = 0; i < 16; ++i) { const int idx = tid + 256 * i, key = idx >> 6, d = idx & 63; Ks[key][d] = bf2f(KB[((size_t)b * SEQ + kt * 64 + key) * 1024 + h * 128 + c * 64 + d]); }
            for (int i = 0; i < 32; ++i) { const int idx = tid + 256 * i, key = idx >> 7, d = idx & 127; Vs[key][d] = bf2f(VB[((size_t)b * SEQ + kt * 64 + key) * 1024 + h * 128 + d]); }
            __syncthreads();
            for (int key = 0; key < 64; ++key) {
                float s = 0.f;
#pragma unroll
                for (int d = 0; d < 64; ++d) s += q[d] * Ks[key][d];
                const float mn = fmaxf(m, s), al = exp2f(m - mn), p = exp2f(s - mn); l = l * al + p; m = mn;
#pragma unroll
                for (int e = 0; e < 16; ++e) acc[e] = acc[e] * al + p * Vs[key][chn * 16 + e];
            }
        }
        const float inv = 1.f / l;
#pragma unroll
        for (int e = 0; e < 16; ++e) res[e] = c == 0 ? acc[e] * inv : res[e] - lam * acc[e] * inv;
    }
    float ss = 0.f;
#pragma unroll
    for (int e = 0; e < 16; ++e) ss += res[e] * res[e];
    ss += __shfl_xor(ss, 1); ss += __shfl_xor(ss, 2); ss += __shfl_xor(ss, 4);
    const float rstd = rsqrtf(ss * (1.f / 128.f) + EPS);
    __syncthreads();
#pragma unroll
    for (int e = 0; e < 16; ++e) AO[row * 2048 + 1024 + h * 128 + chn * 16 + e] = f2bf(res[e] * rstd * subg[chn * 16 + e] * 0.8f);
}
__global__ void __launch_bounds__(256) k_convact(const bf16_t* __restrict__ UP, int m0, const float* __restrict__ cw, const float* __restrict__ cb, bf16_t* __restrict__ ACT) {
    const int j = blockIdx.x * 256 + threadIdx.x, r = blockIdx.y; const int s = (m0 + r) % SEQ;
    float v = cb[j], g = cb[DFF + j];
#pragma unroll
    for (int k = 0; k < 3; ++k) { const int ss = s + k - 1; if (ss >= 0 && ss < SEQ) { v += cw[k * 2 * DFF + j] * bf2f(UP[(size_t)(r + k - 1) * 5632 + j]); g += cw[k * 2 * DFF + DFF + j] * bf2f(UP[(size_t)(r + k - 1) * 5632 + DFF + j]); } }
    ACT[(size_t)(m0 + r) * DFF + j] = f2bf(g / (1.f + __expf(-g)) * v);
}

extern "C" void kernel_launch(void* const* d_in, const int* in_sizes, int n_in, void* d_out, int out_size, void* d_ws, size_t ws_size, hipStream_t stream) {
    const float* x = (const float*)d_in[0]; const float* c = (const float*)d_in[1]; const int* pos = (const int*)d_in[2];
    const float* w_ada = (const float*)d_in[3]; const float* b_ada = (const float*)d_in[4]; const float* norm1_g = (const float*)d_in[5]; const float* w_in = (const float*)d_in[6];
    const float* conv_rnn_w = (const float*)d_in[7]; const float* conv_rnn_b = (const float*)d_in[8]; const float* w_rg_a = (const float*)d_in[9]; const float* b_rg_a = (const float*)d_in[10];
    const float* w_rg_i = (const float*)d_in[11]; const float* b_rg_i = (const float*)d_in[12]; const float* rg_lambda = (const float*)d_in[13]; const float* w_rnn_o = (const float*)d_in[14];
    const float* lq1 = (const float*)d_in[15]; const float* lk1 = (const float*)d_in[16]; const float* lq2 = (const float*)d_in[17]; const float* lk2 = (const float*)d_in[18];
    const float* subln_g = (const float*)d_in[19]; const float* w_attn_o = (const float*)d_in[20]; const float* w_out = (const float*)d_in[21]; const float* norm2_g = (const float*)d_in[22];
    const float* w_up = (const float*)d_in[23]; const float* conv_ffn_w = (const float*)d_in[24]; const float* conv_ffn_b = (const float*)d_in[25]; const float* w_down = (const float*)d_in[26];
    const float* final_g = (const float*)d_in[27];
    unsigned char* ws = (unsigned char*)d_ws; float* out = (float*)d_out;
    float* MOD = (float*)(ws + WS_MOD); float* COS = (float*)(ws + WS_COS); float* SIN = (float*)(ws + WS_SIN);
    bf16_t* H = (bf16_t*)(ws + WS_H); bf16_t* XR = (bf16_t*)(ws + WS_XR); bf16_t* AO = (bf16_t*)(ws + WS_AO); bf16_t* KB = (bf16_t*)(ws + WS_K); bf16_t* VB = (bf16_t*)(ws + WS_V);
    bf16_t* HF = (bf16_t*)(ws + WS_HF); bf16_t* GT = (bf16_t*)d_out; bf16_t* MG = XR; bf16_t* UP = (bf16_t*)(ws + WS_UP); bf16_t* ACT = (bf16_t*)(ws + WS_ACT);
    if (ws_size < 512 * MiB) { fprintf(stderr, "kernel_launch: ws too small %zu\n", ws_size); return; }

    k_mod<<<dim3(NMODC / 256, BATCH), 256, 0, stream>>>(c, w_ada, b_ada, MOD, lq1, lk1, lq2, lk2);
    k_rope_tab<<<M * 8 / 256, 256, 0, stream>>>(pos, COS, SIN);
    k_normmod<<<M / 4, 256, 0, stream>>>(x, norm1_g, MOD, 0, 1024, H);
    nv_gemm<EProj><<<dim3(INCOLS / 64, M / 64), 256, 0, stream>>>(H, DM, w_in, INCOLS, DM, EProj{XR, AO, KB, VB, GT});
    k_rope<<<M * 16 / 256, 256, 0, stream>>>(AO, KB, COS, SIN);
    nv_rglru<<<dim3(16, BATCH), 64, 0, stream>>>(XR, AO, HF, conv_rnn_w, conv_rnn_b, w_rg_a, b_rg_a, w_rg_i, b_rg_i, rg_lambda);
    nv_attn<<<dim3(SEQ / 32, 8, BATCH), 256, 0, stream>>>(AO, KB, VB, subln_g, MOD + BATCH * NMODC);
    nv_gemm<EMergeA><<<dim3(DM / 64, M / 64), 256, 0, stream>>>(AO, 2048, w_rnn_o, DM, DM, EMergeA{GT, MG});
    nv_gemm<EMergeB><<<dim3(DM / 64, M / 64), 256, 0, stream>>>(AO + 1024, 2048, w_attn_o, DM, DM, EMergeB{GT, MG});
    nv_gemm<EOut><<<dim3(DM / 64, M / 64), 256, 0, stream>>>(MG, DM, w_out, DM, DM, EOut{x, MOD, out});
    k_normmod<<<M / 4, 256, 0, stream>>>(out, norm2_g, MOD, 3072, 4096, H);
    for (int half = 0; half < 2; ++half) {
        const int m0 = half * (M / 2);
        nv_gemm<EUp><<<dim3(2 * DFF / 64, M / 2 / 64), 256, 0, stream>>>(H + (size_t)m0 * DM, DM, w_up, 2 * DFF, DM, EUp{UP});
        k_convact<<<dim3(DFF / 256, M / 2), 256, 0, stream>>>(UP, m0, conv_ffn_w, conv_ffn_b, ACT);
    }
    nv_gemm<EDown><<<dim3(DM / 64, M / 64), 256, 0, stream>>>(ACT, DFF, w_down, DM, DFF, EDown{out, MOD});
    k_final<<<M / 4, 256, 0, stream>>>(out, final_g);
}
```

```cpp
#include <hip/hip_runtime.h>
#include <hip/hip_bf16.h>
#include <cstdint>
#include <cstdio>
#include <cmath>

namespace pg8 {
#define PG8_LAS __attribute__((address_space(3)))
typedef unsigned short bf16_t;
typedef short bf16x8 __attribute__((ext_vector_type(8)));
typedef float f32x4 __attribute__((ext_vector_type(4)));
typedef unsigned u32x4 __attribute__((ext_vector_type(4)));
constexpr int BM = 256, BK = 64, HALF = 128, HTB = HALF * BK * 2  , STAGE_BYTES = 8 * HTB, NXCD = 8, WGM = 8;

__host__ __device__ __forceinline__ int lds_byte(int r, int c) { const int st = (r >> 4) * 2 + (c >> 5), rr = r & 15, cc = c & 31, ob = rr * 64 + cc * 2; return st * 1024 + (ob ^ (((ob >> 9) & 1) << 5)); }
__host__ __device__ __forceinline__ void stage_rc(int b, int& R, int& C) { const int st = b / 1024, sb = b % 1024, swz = sb ^ (((sb >> 9) & 1) << 5); R = (st >> 1) * 16 + swz / 64; C = (st & 1) * 32 + (swz % 64) / 2; }
__host__ __device__ __forceinline__ int perm32(int rho) { const int n = rho >> 4, i = rho & 15; return 8 * (i >> 2) + 4 * n + (i & 3); }

struct Unit { int pm, pn; };
struct Gemm { const bf16_t* A; const bf16_t* Bt; int M, N, K, lda; };

struct StaticOrder {
    int nM, nN, nwg, G, c;
    __host__ __device__ void init(int M, int N, int G_, int c_) { nM = M / BM; nN = N / BM; nwg = nM * nN; G = G_; c = c_; }
    __host__ __device__ bool next(int i, Unit& u) const {
        const long L = (long)i * G + c; if (L >= nwg) return false;
        int wgid = (int)L; { const int q = nwg / NXCD, r = nwg % NXCD, xcd = wgid % NXCD, off = wgid / NXCD; wgid = (xcd < r ? xcd * (q + 1) : r * (q + 1) + (xcd - r) * q) + off; }
        const int nig = WGM * nN, gid = wgid / nig, fm = gid * WGM, gsz = (nM - fm) < WGM ? (nM - fm) : WGM;
        u.pm = fm + ((wgid % nig) % gsz); u.pn = (wgid % nig) / gsz; return true;
    }
    __device__ __forceinline__ void a_ready(const Unit&) const {}
    __device__ __forceinline__ void done(const Unit&) const {}
};

__device__ __forceinline__ unsigned cvt_pk_bf16(float lo, float hi) { unsigned r; asm volatile("v_cvt_pk_bf16_f32 %0, %1, %2" : "=v"(r) : "v"(lo), "v"(hi)); return r; }
template <class Epi, class Sched, bool ALIGN_EPI = false, bool SP2 = false>
__device__ __forceinline__ void gemm_phase(PG8_LAS unsigned char* lds, const Gemm g, const Sched& S, const Epi& E) {
    const int tid = threadIdx.x, wid = __builtin_amdgcn_readfirstlane(tid >> 6), lane = tid & 63, wr = wid >> 2, wc = wid & 3, fr = lane & 15, fq = lane >> 4;
    const int K = g.K, nt = K / BK;
    unsigned voffA[2], voffB[2];
#pragma unroll
    for (int i = 0; i < 2; ++i) { int R, C; stage_rc(tid * 16 + i * 8192, R, C); const int Rb = Epi::PERM ? ((R & ~31) + perm32(R & 31)) : R;
        voffA[i] = (unsigned)(R * g.lda + C) * 2u; voffB[i] = (unsigned)(Rb * K + C) * 2u; }
    const size_t kstep = (size_t)(BK * 2);
    const size_t hstepB = (size_t)HALF * K * 2, hstepA = (size_t)HALF * g.lda * 2;
    const size_t tstepA = 2 * hstepA, tstepB = 2 * hstepB;
    const unsigned ldsw = (unsigned)wid * 1024u;
    const int aoff = lds_byte(wr * 64 + fr, fq * 8), boff = lds_byte(wc * 32 + fr, fq * 8);
#define PG8_SA(b, h) (((b) * 2 + (h)) * HTB)
#define PG8_SB(b, h) ((4 + (b) * 2 + (h)) * HTB)
#define PG8_STAGE(bufoff, gbase, voff) do { _Pragma("unroll") for (int _i = 0; _i < 2; ++_i) \
        __builtin_amdgcn_global_load_lds((const unsigned*)((const char*)(gbase) + (voff)[_i]), (PG8_LAS unsigned*)(lds + (bufoff) + ldsw + _i * 8192), 16, 0, 0); } while (0)
#define PG8_LDA(dst, b, h) do { _Pragma("unroll") for (int m = 0; m < 4; ++m) _Pragma("unroll") for (int k = 0; k < 2; ++k) dst[m][k] = *(const PG8_LAS bf16x8*)(lds + PG8_SA(b, h) + aoff + m * 2048 + k * 1024); } while (0)
#define PG8_LDB(dst, b, h) do { _Pragma("unroll") for (int n = 0; n < 2; ++n) _Pragma("unroll") for (int k = 0; k < 2; ++k) dst[n][k] = *(const PG8_LAS bf16x8*)(lds + PG8_SB(b, h) + boff + n * 2048 + k * 1024); } while (0)
#define PG8_MMA(ai, bj, At, Bt) do { __builtin_amdgcn_s_setprio(1); _Pragma("unroll") for (int m = 0; m < 4; ++m) _Pragma("unroll") for (int n = 0; n < 2; ++n) _Pragma("unroll") for (int k = 0; k < 2; ++k) \
        acc[ai][bj][m][n] = __builtin_amdgcn_mfma_f32_16x16x32_bf16(Bt[n][k], At[m][k], acc[ai][bj][m][n], 0, 0, 0); __builtin_amdgcn_s_setprio(0); } while (0)
#define PG8_WAIT_V(n) asm volatile("s_waitcnt vmcnt(" #n ")" ::: "memory")
#define PG8_WAIT_L(n) asm volatile("s_waitcnt lgkmcnt(" #n ")" ::: "memory")
#define PG8_BAR __builtin_amdgcn_s_barrier()
#define PG8_SCHED __builtin_amdgcn_sched_barrier(0)
    Unit cur, nxt; int ui = 0;
    if (!S.next(0, cur)) return;
    f32x4 acc[2][2][4][2];
#pragma unroll
    for (int a = 0; a < 2; ++a)
#pragma unroll
        for (int b = 0; b < 2; ++b)
#pragma unroll
            for (int m = 0; m < 4; ++m)
#pragma unroll
                for (int n = 0; n < 2; ++n) acc[a][b][m][n] = (f32x4){0.f, 0.f, 0.f, 0.f};
    bf16x8 At[4][2], B0[2][2], B1[2][2];
    const char* cA = (const char*)g.A + (size_t)cur.pm * tstepA; const char* cB = (const char*)g.Bt + (size_t)cur.pn * tstepB;
    S.a_ready(cur);
    if constexpr (SP2) {
        PG8_STAGE(PG8_SB(0, 0), cB, voffB); PG8_STAGE(PG8_SB(0, 1), cB + hstepB, voffB); PG8_STAGE(PG8_SA(0, 0), cA, voffA); PG8_STAGE(PG8_SA(0, 1), cA + hstepA, voffA);
        if (wr == 1) PG8_BAR;
        PG8_WAIT_V(2); PG8_BAR;
        PG8_STAGE(PG8_SB(1, 0), cB + kstep, voffB); PG8_STAGE(PG8_SA(1, 0), cA + kstep, voffA); PG8_STAGE(PG8_SB(1, 1), cB + hstepB + kstep, voffB);
        PG8_WAIT_V(6); PG8_BAR;
    } else {
        PG8_STAGE(PG8_SB(0, 0), cB, voffB); PG8_STAGE(PG8_SA(0, 0), cA, voffA); PG8_STAGE(PG8_SB(0, 1), cB + hstepB, voffB); PG8_STAGE(PG8_SA(0, 1), cA + hstepA, voffA);
        if (wr == 1) PG8_BAR;
        PG8_WAIT_V(4); PG8_BAR;
        PG8_STAGE(PG8_SB(1, 0), cB + kstep, voffB); PG8_STAGE(PG8_SA(1, 0), cA + kstep, voffA); PG8_STAGE(PG8_SB(1, 1), cB + hstepB + kstep, voffB);
        PG8_WAIT_V(6); PG8_BAR;
    }
    for (;;) {
        const bool has_next = S.next(ui + 1, nxt);
        const char* nA = has_next ? (const char*)g.A + (size_t)nxt.pm * tstepA : cA; const char* nB = has_next ? (const char*)g.Bt + (size_t)nxt.pn * tstepB : cB;
        for (int t = 0; t < nt; t += 2) {
            const bool last = (t == nt - 2);
            const char* a1 = cA + (size_t)(t + 1) * kstep;
            const char* a2 = last ? nA : cA + (size_t)(t + 2) * kstep; const char* b2 = last ? nB : cB + (size_t)(t + 2) * kstep;
            const char* a3 = a2 + kstep; const char* b3 = b2 + kstep;
            if (last && has_next) S.a_ready(nxt);
            if constexpr (SP2) {
            PG8_LDB(B0, 0, 0); PG8_LDB(B1, 0, 1); PG8_SCHED; PG8_LDA(At, 0, 0); PG8_STAGE(PG8_SA(1, 1), a1 + hstepA, voffA);
            PG8_WAIT_V(8); PG8_WAIT_L(0); PG8_BAR; PG8_MMA(0, 0, At, B0); PG8_MMA(0, 1, At, B1); PG8_BAR; PG8_SCHED;
            PG8_LDA(At, 0, 1); PG8_STAGE(PG8_SB(0, 0), b2, voffB); PG8_STAGE(PG8_SB(0, 1), b2 + hstepB, voffB); PG8_STAGE(PG8_SA(0, 0), a2, voffA);
            PG8_WAIT_V(8); PG8_WAIT_L(0); PG8_BAR; PG8_MMA(1, 0, At, B0); PG8_MMA(1, 1, At, B1); PG8_BAR; PG8_SCHED;
            PG8_LDB(B0, 1, 0); PG8_LDB(B1, 1, 1); PG8_SCHED; PG8_LDA(At, 1, 0); PG8_STAGE(PG8_SA(0, 1), a2 + hstepA, voffA);
            PG8_WAIT_V(8); PG8_WAIT_L(0); PG8_BAR; PG8_MMA(0, 0, At, B0); PG8_MMA(0, 1, At, B1); PG8_BAR; PG8_SCHED;
            PG8_LDA(At, 1, 1); PG8_STAGE(PG8_SB(1, 0), b3, voffB); PG8_STAGE(PG8_SB(1, 1), b3 + hstepB, voffB); PG8_STAGE(PG8_SA(1, 0), a3, voffA);
            PG8_WAIT_V(8); PG8_WAIT_L(0); PG8_BAR; PG8_MMA(1, 0, At, B0); PG8_MMA(1, 1, At, B1); PG8_BAR; PG8_SCHED;
            } else {
            PG8_LDB(B0, 0, 0); PG8_SCHED; PG8_LDA(At, 0, 0); PG8_STAGE(PG8_SA(1, 1), a1 + hstepA, voffA);
            PG8_WAIT_L(8); PG8_BAR; PG8_WAIT_L(0); PG8_MMA(0, 0, At, B0); PG8_BAR; PG8_SCHED;
            PG8_LDB(B1, 0, 1); PG8_STAGE(PG8_SB(0, 0), b2, voffB);
            PG8_BAR; PG8_WAIT_L(0); PG8_MMA(0, 1, At, B1); PG8_BAR;
            PG8_LDA(At, 0, 1); PG8_STAGE(PG8_SA(0, 0), a2, voffA);
            PG8_BAR; PG8_WAIT_L(0); PG8_MMA(1, 0, At, B0); PG8_BAR; PG8_SCHED;
            PG8_STAGE(PG8_SB(0, 1), b2 + hstepB, voffB);
            PG8_WAIT_V(6); PG8_BAR; PG8_MMA(1, 1, At, B1); PG8_BAR;
            PG8_LDB(B0, 1, 0); PG8_SCHED; PG8_LDA(At, 1, 0); PG8_STAGE(PG8_SA(0, 1), a2 + hstepA, voffA);
            PG8_WAIT_L(8); PG8_BAR; PG8_WAIT_L(0); PG8_MMA(0, 0, At, B0); PG8_BAR; PG8_SCHED;
            PG8_LDB(B1, 1, 1); PG8_STAGE(PG8_SB(1, 0), b3, voffB);
            PG8_BAR; PG8_WAIT_L(0); PG8_MMA(0, 1, At, B1); PG8_BAR;
            PG8_LDA(At, 1, 1); PG8_STAGE(PG8_SA(1, 0), a3, voffA);
            PG8_BAR; PG8_WAIT_L(0); PG8_MMA(1, 0, At, B0); PG8_BAR; PG8_SCHED;
            PG8_STAGE(PG8_SB(1, 1), b3 + hstepB, voffB);
            PG8_WAIT_V(6); PG8_BAR; PG8_MMA(1, 1, At, B1); PG8_BAR;
            }
        }
        if constexpr (ALIGN_EPI) { if (wr == 0) PG8_BAR; }
        if constexpr (!Epi::AFTER_DRAIN) { E(acc, cur, wr, wc, fr, fq); S.done(cur); }
        if (!has_next) break;
#pragma unroll
        for (int a = 0; a < 2; ++a)
#pragma unroll
            for (int b = 0; b < 2; ++b)
#pragma unroll
                for (int m = 0; m < 4; ++m)
#pragma unroll
                    for (int n = 0; n < 2; ++n) acc[a][b][m][n] = (f32x4){0.f, 0.f, 0.f, 0.f};
        cur = nxt; cA = nA; cB = nB; ++ui;
        if constexpr (ALIGN_EPI) { if (wr == 1) PG8_BAR; }
    }
    PG8_WAIT_V(0);
    if constexpr (!ALIGN_EPI) { if (wr == 0) PG8_BAR; }
    PG8_BAR;
    if constexpr (Epi::AFTER_DRAIN) { E.fused(acc, cur, wr, wc, fr, fq, lds, wid, lane); S.done(cur); }
#undef PG8_SA
#undef PG8_SB
#undef PG8_STAGE
#undef PG8_LDA
#undef PG8_LDB
#undef PG8_MMA
#undef PG8_WAIT_V
#undef PG8_WAIT_L
#undef PG8_BAR
#undef PG8_SCHED
}
}
#ifndef PG8_SP2
#define PG8_SP2 true
#endif
#ifndef PG8_ALIGN
#define PG8_ALIGN true
#endif

typedef unsigned short bf16_t;
constexpr int DM = 1024, BATCH = 16, SEQ = 2048, M = BATCH * SEQ, INCOLS = 7168, DFF = 2816, NMODC = 6 * DM;
constexpr float EPS = 1e-6f;
constexpr float C2 = 0.125f * 1.4426950408889634f;
constexpr size_t MiB = 1u << 20;
constexpr size_t WS_CTL = 0, CTL_ZERO_BYTES = 1 * MiB;
constexpr size_t WS_MOD = 1 * MiB, WS_COS = 2 * MiB, WS_SIN = 3 * MiB;
constexpr size_t WS_WIN = 4 * MiB, WS_WA = 18 * MiB, WS_WB = 20 * MiB, WS_WOUT = 22 * MiB, WS_WUP = 24 * MiB, WS_WDOWN = 35 * MiB;
constexpr size_t WS_H = 48 * MiB, WS_XR = 112 * MiB, WS_AO = 176 * MiB, WS_K = 304 * MiB, WS_V = 368 * MiB, WS_HF = 432 * MiB;
constexpr size_t WS_UP = 112 * MiB, WS_ACT = 288 * MiB, WS_EDGE = 112 * MiB;
constexpr size_t WS_NEED = 512 * MiB;
constexpr int CW_TMO = 0, CW_CODE = 1, CW_BAR = 4096;

constexpr int NWAVES = 8;
constexpr int RING_OFF = 0, RING_BYTES = 131072, LDSCTL_OFF = RING_BYTES, MISC_OFF = LDSCTL_OFF + 320, LDS_BYTES = 147456;

#define GAS __attribute__((address_space(1)))
#define LAS __attribute__((address_space(3)))
typedef unsigned v4u __attribute__((ext_vector_type(4)));
typedef unsigned v2u __attribute__((ext_vector_type(2)));
typedef float f32x4 __attribute__((ext_vector_type(4)));
typedef float f32x2 __attribute__((ext_vector_type(2)));
typedef short bf16x8 __attribute__((ext_vector_type(8)));
typedef GAS unsigned gu32;
#define RLX_AGENT __ATOMIC_RELAXED, __HIP_MEMORY_SCOPE_AGENT
#define LDS_WAIT() asm volatile("s_waitcnt lgkmcnt(0)" ::: "memory")
#define VM_WAIT() asm volatile("s_waitcnt vmcnt(0)" ::: "memory")

__device__ __forceinline__ float bf2f(bf16_t v) { return __uint_as_float((unsigned)v << 16); }
__device__ __forceinline__ unsigned f2bfu(float f) { unsigned u = __float_as_uint(f); return (u + 0x7fffu + ((u >> 16) & 1u)) >> 16; }
__device__ __forceinline__ bf16_t f2bf(float f) { return (bf16_t)f2bfu(f); }
__device__ __forceinline__ unsigned pk2(float lo, float hi) { return pg8::cvt_pk_bf16(lo, hi); }
__device__ __forceinline__ float lo_bf(unsigned w) { return __uint_as_float(w << 16); }
__device__ __forceinline__ float hi_bf(unsigned w) { return __uint_as_float(w & 0xffff0000u); }
__device__ __forceinline__ float fexp(float x) { return __builtin_amdgcn_exp2f(x * 1.4426950408889634f); }
__device__ __forceinline__ float frcp(float x) { return __builtin_amdgcn_rcpf(x); }
__device__ __forceinline__ float sigmoidf_(float x) { return frcp(1.f + fexp(-x)); }
__device__ __forceinline__ float gelu_tanh(float x) { const float u = 1.5957691216057308f * (x + 0.044715f * x * x * x); return x * frcp(1.f + fexp(-u)); }
__device__ __forceinline__ float wave_sum(float v) {
#pragma unroll
    for (int o = 1; o < 64; o <<= 1) v += __shfl_xor(v, o);
    return v;
}
typedef pg8::f32x4 (&AccRef)[2][2][4][2];
typedef const pg8::f32x4 (&AccCRef)[2][2][4][2];

struct EpiProj {
    static constexpr bool PERM = true, AFTER_DRAIN = false;
    bf16_t *XR, *AO, *KB, *VB, *GT; const float *COS, *SIN;
    __device__ __forceinline__ void operator()(AccCRef acc, const pg8::Unit& u, int wr, int wc, int fr, int fq) const {
        const int pn = u.pn; bf16_t* base; int ldc, colt; float sc = 1.f; bool rope = false;
        if (pn < 4) { base = XR; ldc = 1024; colt = pn * 256; }
        else if (pn < 8) { base = AO; ldc = 2048; colt = (pn - 4) * 256; }
        else if (pn < 12) { base = AO + 1024; ldc = 2048; colt = (pn - 8) * 256; sc = C2; rope = true; }
        else if (pn < 16) { base = KB; ldc = 1024; colt = (pn - 12) * 256; rope = true; }
        else if (pn < 20) { base = VB; ldc = 1024; colt = (pn - 16) * 256; }
        else { base = GT; ldc = 2048; colt = (pn - 20) * 256; }
        const bool dorope = rope && ((wc & 1) == 0);
        const int row0 = u.pm * 256 + wr * 64 + fr, col0 = colt + wc * 32 + 8 * fq;
#pragma unroll
        for (int ai = 0; ai < 2; ++ai)
#pragma unroll
            for (int m = 0; m < 4; ++m) {
                const int row = row0 + ai * 128 + m * 16;
                f32x4 c0 = {1.f, 1.f, 1.f, 1.f}, c1 = c0, s0 = {0.f, 0.f, 0.f, 0.f}, s1 = s0;
                if (dorope) { c0 = *(const f32x4*)(COS + (size_t)row * 8); c1 = *(const f32x4*)(COS + (size_t)row * 8 + 4); s0 = *(const f32x4*)(SIN + (size_t)row * 8); s1 = *(const f32x4*)(SIN + (size_t)row * 8 + 4);
                    if (fq == 0) { s0 = -s0; s1 = -s1; } if (fq >= 2) { c0 = (f32x4){1.f, 1.f, 1.f, 1.f}; c1 = c0; s0 = (f32x4){0.f, 0.f, 0.f, 0.f}; s1 = s0; } }
#pragma unroll
                for (int bj = 0; bj < 2; ++bj) {
                    f32x4 v0 = acc[ai][bj][m][0], v1 = acc[ai][bj][m][1];
                    if (dorope) { f32x4 p0, p1;
#pragma unroll
                        for (int e = 0; e < 4; ++e) { p0[e] = __shfl_xor(v0[e], 16); p1[e] = __shfl_xor(v1[e], 16); }
                        v0 = v0 * c0 + p0 * s0; v1 = v1 * c1 + p1 * s1; }
                    v0 = v0 * sc; v1 = v1 * sc;
                    v4u w; w.x = pk2(v0[0], v0[1]); w.y = pk2(v0[2], v0[3]); w.z = pk2(v1[0], v1[1]); w.w = pk2(v1[2], v1[3]);
                    *(v4u*)(base + (size_t)row * ldc + col0 + bj * 128) = w;
                }
            }
    }
};
template <int STEP> struct EpiMerge {
    static constexpr bool PERM = true, AFTER_DRAIN = false;
    const bf16_t* GT; bf16_t* MG;
    __device__ __forceinline__ void operator()(AccCRef acc, const pg8::Unit& u, int wr, int wc, int fr, int fq) const {
        const int row0 = u.pm * 256 + wr * 64 + fr, col0 = u.pn * 256 + wc * 32 + 8 * fq;
#pragma unroll
        for (int ai = 0; ai < 2; ++ai)
#pragma unroll
            for (int m = 0; m < 4; ++m) {
                const int row = row0 + ai * 128 + m * 16;
#pragma unroll
                for (int bj = 0; bj < 2; ++bj) {
                    const v4u g = *(const v4u*)(GT + (size_t)row * 2048 + STEP * 1024 + col0 + bj * 128);
                    const f32x4 v0 = acc[ai][bj][m][0], v1 = acc[ai][bj][m][1];
                    float o[8];
                    o[0] = sigmoidf_(lo_bf(g.x)) * v0[0]; o[1] = sigmoidf_(hi_bf(g.x)) * v0[1]; o[2] = sigmoidf_(lo_bf(g.y)) * v0[2]; o[3] = sigmoidf_(hi_bf(g.y)) * v0[3];
                    o[4] = sigmoidf_(lo_bf(g.z)) * v1[0]; o[5] = sigmoidf_(hi_bf(g.z)) * v1[1]; o[6] = sigmoidf_(lo_bf(g.w)) * v1[2]; o[7] = sigmoidf_(hi_bf(g.w)) * v1[3];
                    bf16_t* dst = MG + (size_t)row * 1024 + col0 + bj * 128;
                    if (STEP == 1) { const v4u p = *(const v4u*)dst; o[0] += lo_bf(p.x); o[1] += hi_bf(p.x); o[2] += lo_bf(p.y); o[3] += hi_bf(p.y); o[4] += lo_bf(p.z); o[5] += hi_bf(p.z); o[6] += lo_bf(p.w); o[7] += hi_bf(p.w); }
                    v4u w; w.x = pk2(o[0], o[1]); w.y = pk2(o[2], o[3]); w.z = pk2(o[4], o[5]); w.w = pk2(o[6], o[7]);
                    *(v4u*)dst = w;
                }
            }
    }
};
struct EpiResid {
    static constexpr bool PERM = false, AFTER_DRAIN = false;
    const float* RES; float* OUT; const float* gate;
    __device__ __forceinline__ void operator()(AccCRef acc, const pg8::Unit& u, int wr, int wc, int fr, int fq) const {
        const int row0 = u.pm * 256 + wr * 64 + fr, col0 = u.pn * 256 + wc * 32 + 4 * fq; const float* gb = gate + (size_t)(u.pm >> 3) * NMODC;
        f32x4 gv[2][2];
#pragma unroll
        for (int bj = 0; bj < 2; ++bj)
#pragma unroll
            for (int n = 0; n < 2; ++n) gv[bj][n] = *(const f32x4*)(gb + col0 + bj * 128 + n * 16);
#pragma unroll
        for (int ai = 0; ai < 2; ++ai)
#pragma unroll
            for (int m = 0; m < 4; ++m) { const size_t off = (size_t)(row0 + ai * 128 + m * 16) * 1024 + col0;
#pragma unroll
                for (int bj = 0; bj < 2; ++bj)
#pragma unroll
                    for (int n = 0; n < 2; ++n) { const f32x4 r = *(const f32x4*)(RES + off + bj * 128 + n * 16); *(f32x4*)(OUT + off + bj * 128 + n * 16) = r + gv[bj][n] * acc[ai][bj][m][n]; }
                if (m & 1) asm volatile("" ::: "memory"); }
    }
};
template <int CTRL> __device__ __forceinline__ float dpp_rot(float v) { return __uint_as_float((unsigned)__builtin_amdgcn_update_dpp(0, (int)__float_as_uint(v), CTRL, 0xf, 0xf, false)); }
struct EpiUpConv {
    static constexpr bool PERM = true, AFTER_DRAIN = false;
    bf16_t* ACT; float* EDGE; const float* cw; const float* cb;
    __device__ __forceinline__ void operator()(AccCRef acc, const pg8::Unit& u, int wr, int wc, int fr, int fq) const {
        const int jj = wc * 32 + 8 * fq, j = u.pn * 128 + jj;
        const int pc = u.pn * 256 + jj;
#pragma unroll
        for (int ai = 0; ai < 2; ++ai) {
            const int band = u.pm * 4 + ai * 2 + wr; const int rowb = band * 64;
            if (fr < 2) {
#pragma unroll
                for (int bj = 0; bj < 2; ++bj)
#pragma unroll
                    for (int n = 0; n < 2; ++n) *(f32x4*)(EDGE + ((size_t)band * 4 + fr) * 5632 + pc + bj * 128 + 4 * n) = acc[ai][bj][0][n];
            }
            if (fr >= 14) {
#pragma unroll
                for (int bj = 0; bj < 2; ++bj)
#pragma unroll
                    for (int n = 0; n < 2; ++n) *(f32x4*)(EDGE + ((size_t)band * 4 + fr - 12) * 5632 + pc + bj * 128 + 4 * n) = acc[ai][bj][3][n];
            }
#pragma unroll
            for (int n = 0; n < 2; ++n) {
                float oe[4][4];
#pragma unroll
                for (int e = 0; e < 4; ++e) {
                    float vv[4];
#pragma unroll
                    for (int bj = 0; bj < 2; ++bj) {
                        const int oc = bj * DFF + j + 4 * n + e;
                        const float w0 = cw[oc], w1 = cw[2 * DFF + oc], w2 = cw[4 * DFF + oc], bs = cb[oc];
#pragma unroll
                        for (int m = 0; m < 4; ++m) {
                            const float cur = acc[ai][bj][m][n][e], pvs = acc[ai][bj][m > 0 ? m - 1 : 0][n][e], nxs = acc[ai][bj][m < 3 ? m + 1 : 3][n][e];
                            const float a = dpp_rot<0x121>(cur), b = dpp_rot<0x121>(pvs), c = dpp_rot<0x12F>(cur), d = dpp_rot<0x12F>(nxs);
                            const float pv = fr == 0 ? b : a, nx = fr == 15 ? d : c;
                            const float r = bs + w0 * pv + w1 * cur + w2 * nx;
                            if (bj == 0) vv[m] = r; else oe[m][e] = r * frcp(1.f + fexp(-r)) * vv[m];
                        }
                    }
                }
#pragma unroll
                for (int m = 0; m < 4; ++m) {
                    const bool skip = (m == 0 && fr == 0) || (m == 3 && fr == 15);
                    v2u w; w.x = pk2(oe[m][0], oe[m][1]); w.y = pk2(oe[m][2], oe[m][3]);
                    if (!skip) *(v2u*)(ACT + (size_t)(rowb + m * 16 + fr) * DFF + j + 4 * n) = w;
                }
                asm volatile("" ::: "memory");
            }
        }
    }
};
namespace att {
using bf16x8 = __attribute__((ext_vector_type(8))) short;
using s16x4  = __attribute__((ext_vector_type(4))) short;
using f32x16 = __attribute__((ext_vector_type(16))) float;
using u32x4  = __attribute__((ext_vector_type(4))) unsigned;
constexpr int KVBLK = 64, LDK = 1024, LDQ = 2048;
constexpr int SHM_V = 64 * 128 * 2, SHM_K = 64 * 128 * 2, WS_OFF = 2 * SHM_V + 2 * SHM_K, LDS_BYTES = WS_OFF + 8 * 64 * 4;
constexpr float THR2 = 6.0f;
#define KSWZ(row, colB) ((row) * 256 + ((colB) ^ (((row) & 7) << 4)))
#define SBAR() __builtin_amdgcn_sched_barrier(0)
__device__ __forceinline__ int crow(int r, int hi) { return (r & 3) + 8 * (r >> 2) + 4 * hi; }
__device__ __forceinline__ unsigned cvtpk(float lo, float hi) { unsigned r; asm volatile("v_cvt_pk_bf16_f32 %0, %1, %2" : "=v"(r) : "v"(lo), "v"(hi)); return r; }
__device__ __forceinline__ void partialSM(f32x16& p0, f32x16& p1, float& m_reg, float& alpha) {
    float pmax = p0[0];
#pragma unroll
    for (int r = 1; r < 16; ++r) pmax = fmaxf(pmax, p0[r]);
#pragma unroll
    for (int r = 0; r < 16; ++r) pmax = fmaxf(pmax, p1[r]);
    { auto rr = __builtin_amdgcn_permlane32_swap(__float_as_uint(pmax), __float_as_uint(pmax), false, false); pmax = fmaxf(__uint_as_float(rr[0]), __uint_as_float(rr[1])); }
    float mn;
    if (__builtin_expect(__all(pmax - m_reg <= THR2), 1)) { mn = m_reg; alpha = 1.f; }
    else { mn = fmaxf(m_reg, pmax); alpha = __builtin_amdgcn_exp2f(m_reg - mn); m_reg = mn; }
#pragma unroll
    for (int r = 0; r < 16; ++r) { p0[r] -= mn; p1[r] -= mn; }
#pragma unroll
    for (int r = 0; r < 16; ++r) p0[r] = __builtin_amdgcn_exp2f(p0[r]);
}
__device__ __forceinline__ void finishSM(f32x16& p0, f32x16& p1, float alpha, float& l_reg, bf16x8& pa0, bf16x8& pa1, bf16x8& pa2, bf16x8& pa3) {
#pragma unroll
    for (int r = 0; r < 16; ++r) p1[r] = __builtin_amdgcn_exp2f(p1[r]);
    float ps = 0;
#pragma unroll
    for (int r = 0; r < 16; ++r) ps += p0[r];
#pragma unroll
    for (int r = 0; r < 16; ++r) ps += p1[r];
    { auto rr = __builtin_amdgcn_permlane32_swap(__float_as_uint(ps), __float_as_uint(ps), false, false); ps = __uint_as_float(rr[0]) + __uint_as_float(rr[1]); }
    l_reg = l_reg * alpha + ps;
#define PK4(P, BASE, OUT) do { unsigned a0 = cvtpk(P[BASE + 0], P[BASE + 1]), a1 = cvtpk(P[BASE + 2], P[BASE + 3]);   \
    unsigned b0 = cvtpk(P[BASE + 4], P[BASE + 5]), b1 = cvtpk(P[BASE + 6], P[BASE + 7]);                              \
    auto r0 = __builtin_amdgcn_permlane32_swap(a0, b0, false, false); auto r1 = __builtin_amdgcn_permlane32_swap(a1, b1, false, false); \
    u32x4 w = {r0[0], r1[0], r0[1], r1[1]}; OUT = *reinterpret_cast<bf16x8*>(&w); } while (0)
    PK4(p0, 0, pa0); PK4(p0, 8, pa1); PK4(p1, 0, pa2); PK4(p1, 8, pa3);
#undef PK4
}
__device__ __forceinline__ void qkt(f32x16& p0, f32x16& p1, const char* Ks, const bf16x8* qr, int c, int r32, int hi) {
    p0 = f32x16{}; p1 = f32x16{};
#pragma unroll
    for (int d0 = 0; d0 < 4; ++d0) { const int cb = ((c * 4 + d0) * 16 + hi * 8) * 2;
        const bf16x8 b0 = *reinterpret_cast<const bf16x8*>(Ks + KSWZ(r32, cb));
        const bf16x8 b1 = *reinterpret_cast<const bf16x8*>(Ks + KSWZ(32 + r32, cb));
        p0 = __builtin_amdgcn_mfma_f32_32x32x16_bf16(b0, qr[d0], p0, 0, 0, 0);
        p1 = __builtin_amdgcn_mfma_f32_32x32x16_bf16(b1, qr[d0], p1, 0, 0, 0); }
}
__device__ __forceinline__ int v_st(int k, int c) { const int kk = (k & ~0xC) | ((k & 4) << 1) | ((k & 8) >> 1); return ((kk >> 3) * 4 + (c >> 5)) * 512 + ((kk & 7) * 32 + (c & 31)) * 2; }
__device__ __forceinline__ int v_rd_base(int lane) { return ((lane & 3) << 3) | (((lane >> 2) & 3) << 6) | (((lane >> 4) & 1) << 5) | (((lane >> 5) & 1) << 8); }
constexpr int v_rd_off(int d0, int ks, int half) { return d0 * 512 + ks * 4096 + half * 2048; }
template <int OFF> __device__ __forceinline__ s16x4 tr_read(int vb) { s16x4 r; asm volatile("ds_read_b64_tr_b16 %0, %1 offset:%2" : "=&v"(r) : "v"(vb), "i"(OFF) : "memory"); return r; }
template <int D0> __device__ __forceinline__ void pv_one(f32x16& od, int vb, bf16x8 pa0, bf16x8 pa1, bf16x8 pa2, bf16x8 pa3) {
    const s16x4 l0 = tr_read<v_rd_off(D0, 0, 0)>(vb), h0 = tr_read<v_rd_off(D0, 0, 1)>(vb), l1 = tr_read<v_rd_off(D0, 1, 0)>(vb), h1 = tr_read<v_rd_off(D0, 1, 1)>(vb);
    const s16x4 l2 = tr_read<v_rd_off(D0, 2, 0)>(vb), h2 = tr_read<v_rd_off(D0, 2, 1)>(vb), l3 = tr_read<v_rd_off(D0, 3, 0)>(vb), h3 = tr_read<v_rd_off(D0, 3, 1)>(vb);
    asm volatile("s_waitcnt lgkmcnt(0)" ::: "memory"); SBAR();
#define PK(L, H) (bf16x8){L[0], L[1], L[2], L[3], H[0], H[1], H[2], H[3]}
    od = __builtin_amdgcn_mfma_f32_32x32x16_bf16(pa0, PK(l0, h0), od, 0, 0, 0);
    od = __builtin_amdgcn_mfma_f32_32x32x16_bf16(pa1, PK(l1, h1), od, 0, 0, 0);
    od = __builtin_amdgcn_mfma_f32_32x32x16_bf16(pa2, PK(l2, h2), od, 0, 0, 0);
    od = __builtin_amdgcn_mfma_f32_32x32x16_bf16(pa3, PK(l3, h3), od, 0, 0, 0);
#undef PK
}
__device__ __forceinline__ void pv_d0(f32x16* o, int vb, bf16x8 pa0, bf16x8 pa1, bf16x8 pa2, bf16x8 pa3) {
    pv_one<0>(o[0], vb, pa0, pa1, pa2, pa3); pv_one<1>(o[1], vb, pa0, pa1, pa2, pa3); pv_one<2>(o[2], vb, pa0, pa1, pa2, pa3); pv_one<3>(o[3], vb, pa0, pa1, pa2, pa3);
}
__device__ __forceinline__ void attn_unit(int b, int h, int qb, bf16_t* AO, const bf16_t* __restrict__ KB, const bf16_t* __restrict__ VB, float lam, const float* __restrict__ subg, char* lds) {
    const int tid = threadIdx.x, wid = tid >> 6, lane = tid & 63, r32 = lane & 31, hi = lane >> 5, c = wid >> 2, wq = wid & 3;
    char* V_lds = lds; char* K_lds = lds + 2 * SHM_V;
    float* ws = (float*)(lds + WS_OFF) + wid * 64; float* li_l = ws; float* al_l = ws + 32;
    const size_t rowbase = (size_t)b * SEQ; const int q0 = qb * 128;
    float m_reg = -1e30f, l_reg = 0; f32x16 o[4] = {}; bf16x8 qr[4];
    bf16_t* Qrow = AO + (rowbase + q0 + wq * 32) * LDQ + 1024 + h * 128;
    { const bf16_t* Qw = Qrow + (size_t)r32 * LDQ + c * 64 + hi * 8;
#pragma unroll
      for (int d0 = 0; d0 < 4; ++d0) qr[d0] = *reinterpret_cast<const bf16x8*>(Qw + d0 * 16); }
    const bf16_t* Kh = KB + rowbase * LDK + h * 128; const bf16_t* Vh = VB + rowbase * LDK + h * 128;
    const int sr = tid >> 4, sc = (tid & 15) * 8, vst0 = v_st(sr, sc), vst1 = v_st(32 + sr, sc);
    const int vb0 = (int)(uintptr_t)V_lds + v_rd_base(lane);
    struct { bf16x8 vs0, vs1, ks0, ks1; } sr_[1];
#define SLOAD(i, k0) do { sr_[i].vs0 = *reinterpret_cast<const bf16x8*>(&Vh[(size_t)((k0) + sr) * LDK + sc]); sr_[i].vs1 = *reinterpret_cast<const bf16x8*>(&Vh[(size_t)((k0) + 32 + sr) * LDK + sc]); \
    sr_[i].ks0 = *reinterpret_cast<const bf16x8*>(&Kh[(size_t)((k0) + sr) * LDK + sc]); sr_[i].ks1 = *reinterpret_cast<const bf16x8*>(&Kh[(size_t)((k0) + 32 + sr) * LDK + sc]); } while (0)
#define SWRITE(bf, i) do { *(bf16x8*)(V_lds + (bf) * SHM_V + vst0) = sr_[i].vs0; *(bf16x8*)(V_lds + (bf) * SHM_V + vst1) = sr_[i].vs1; const int kc = sc * 2; \
    *(bf16x8*)(K_lds + (bf) * SHM_K + KSWZ(sr, kc)) = sr_[i].ks0; *(bf16x8*)(K_lds + (bf) * SHM_K + KSWZ(32 + sr, kc)) = sr_[i].ks1; } while (0)
#define SWAIT() asm volatile("s_waitcnt vmcnt(0)" ::: "memory")
#define RESC(a) do { if (__any((a) < 1.f)) { if (hi == 0) al_l[r32] = (a); asm volatile("s_waitcnt lgkmcnt(0)" ::: "memory"); \
    _Pragma("unroll") for (int d = 0; d < 4; ++d) _Pragma("unroll") for (int r = 0; r < 16; ++r) o[d][r] *= al_l[crow(r, hi)]; } } while (0)
    f32x16 pA0, pA1, pB0, pB1; float alA, alB; bf16x8 pa0, pa1, pa2, pa3; constexpr int NT = SEQ / KVBLK;
    constexpr int SE = 0, SO = 0;
    SLOAD(SE, 0); asm volatile("s_waitcnt vmcnt(0)" ::: "memory"); SWRITE(0, SE); __syncthreads();
    qkt(pA0, pA1, K_lds, qr, c, r32, hi); partialSM(pA0, pA1, m_reg, alA);
    SLOAD(SO, KVBLK);
    SWAIT(); SWRITE(1, SO); __syncthreads();
    for (int j = 1; j + 1 < NT; j += 2) {
        SBAR(); qkt(pB0, pB1, K_lds + SHM_K, qr, c, r32, hi);
        finishSM(pA0, pA1, alA, l_reg, pa0, pa1, pa2, pa3); SBAR();
        SLOAD(SO, (j + 1) * KVBLK); SBAR();
        pv_d0(o, vb0, pa0, pa1, pa2, pa3); partialSM(pB0, pB1, m_reg, alB);
        __syncthreads(); SWAIT(); SWRITE(0, SE);
        RESC(alB); __syncthreads();
        SBAR(); qkt(pA0, pA1, K_lds, qr, c, r32, hi);
        finishSM(pB0, pB1, alB, l_reg, pa0, pa1, pa2, pa3); SBAR();
        SLOAD(SE, (j + 2) * KVBLK); SBAR();
        pv_d0(o, vb0 + SHM_V, pa0, pa1, pa2, pa3); partialSM(pA0, pA1, m_reg, alA);
        __syncthreads(); SWAIT(); SWRITE(1, SO);
        RESC(alA); __syncthreads();
    }
    SBAR(); qkt(pB0, pB1, K_lds + SHM_K, qr, c, r32, hi);
    finishSM(pA0, pA1, alA, l_reg, pa0, pa1, pa2, pa3); SBAR();
    pv_d0(o, vb0, pa0, pa1, pa2, pa3); partialSM(pB0, pB1, m_reg, alB);
    __syncthreads(); RESC(alB);
    finishSM(pB0, pB1, alB, l_reg, pa0, pa1, pa2, pa3); SBAR();
    pv_d0(o, vb0 + SHM_V, pa0, pa1, pa2, pa3);
    if (hi == 0) li_l[r32] = l_reg; asm volatile("s_waitcnt lgkmcnt(0)" ::: "memory");
    float rli[16];
#pragma unroll
    for (int r = 0; r < 16; ++r) rli[r] = __builtin_amdgcn_rcpf(li_l[crow(r, hi)]);
    __syncthreads();
    float* X = (float*)lds + wq * 4096;
    if (c == 1) {
#pragma unroll
        for (int r = 0; r < 16; ++r)
#pragma unroll
            for (int d0 = 0; d0 < 4; ++d0) X[crow(r, hi) * 128 + d0 * 32 + r32] = o[d0][r] * rli[r];
    }
    __syncthreads();
    if (c == 0) {
        float g4[4];
#pragma unroll
        for (int d0 = 0; d0 < 4; ++d0) g4[d0] = subg[d0 * 32 + r32] * 0.8f;
#pragma unroll
        for (int r = 0; r < 16; ++r) {
            float v[4], ss = 0.f;
#pragma unroll
            for (int d0 = 0; d0 < 4; ++d0) { v[d0] = o[d0][r] * rli[r] - lam * X[crow(r, hi) * 128 + d0 * 32 + r32]; ss += v[d0] * v[d0]; }
            ss += __shfl_xor(ss, 1); ss += __shfl_xor(ss, 2); ss += __shfl_xor(ss, 4); ss += __shfl_xor(ss, 8); ss += __shfl_xor(ss, 16);
            const float rstd = rsqrtf(ss * (1.f / 128.f) + EPS);
            bf16_t* Or = Qrow + (size_t)crow(r, hi) * LDQ + r32;
#pragma unroll
            for (int d0 = 0; d0 < 4; ++d0) Or[d0 * 32] = f2bf(v[d0] * rstd * g4[d0]);
        }
    }
    __syncthreads();
#undef SLOAD
#undef SWRITE
#undef SWAIT
#undef RESC
}
#undef KSWZ
#undef SBAR
}
namespace rg {
typedef float f32x4v __attribute__((ext_vector_type(4)));
typedef short bf16x8v __attribute__((ext_vector_type(8)));
constexpr int T = 128, XS = 72, FS = 68;
constexpr int L_XRAW = 0, L_XCF = 16896, L_XCB = L_XCF + T * FS * 4, L_WA = L_XCB + T * XS * 2, L_WI = L_WA + 64 * XS * 2, L_SUM = L_WI + 64 * XS * 2, L_CAR = L_SUM + 8 * 64 * 2 * 4, L_END = L_CAR + 2 * 64 * 4;
static_assert(L_END <= 131072, "rg lds");
template <int DIR> __device__ __forceinline__ void sweep(int b, int n, const bf16_t* __restrict__ XR, bf16_t* AO, bf16_t* HF, const float* __restrict__ cw, const float* __restrict__ cb,
        const float* __restrict__ w_a, const float* __restrict__ b_a, const float* __restrict__ w_i, const float* __restrict__ b_i, const float* __restrict__ lam, LAS unsigned char* lds) {
    const int tid = threadIdx.x, wid = __builtin_amdgcn_readfirstlane(tid >> 6), lane = tid & 63, fr = lane & 15, fq = lane >> 4;
    LAS bf16_t* XRAW = (LAS bf16_t*)(lds + L_XRAW); LAS float* XCF = (LAS float*)(lds + L_XCF); LAS bf16_t* XCB = (LAS bf16_t*)(lds + L_XCB);
    LAS bf16_t* WA = (LAS bf16_t*)(lds + L_WA); LAS bf16_t* WI = (LAS bf16_t*)(lds + L_WI); LAS float* SUM = (LAS float*)(lds + L_SUM); LAS float* CAR = (LAS float*)(lds + L_CAR);
    const size_t rowbase = (size_t)b * SEQ;
    __syncthreads();
    { const float* wa = w_a + ((size_t)DIR * 16 + n) * 4096; const float* wi = w_i + ((size_t)DIR * 16 + n) * 4096;
#pragma unroll
      for (int i = 0; i < 8; ++i) { const int idx = tid + 512 * i, k = idx >> 6, j = idx & 63; WA[j * XS + k] = f2bf(wa[idx]); WI[j * XS + k] = f2bf(wi[idx]); }
      if (tid < 128) CAR[tid] = 0.f; }
    float ba[4], bi[4], sp[4];
#pragma unroll
    for (int nf = 0; nf < 4; ++nf) { const int ch = n * 64 + nf * 16 + fr; ba[nf] = b_a[DIR * DM + ch]; bi[nf] = b_i[DIR * DM + ch]; sp[nf] = -8.f * log1pf(__expf(-lam[DIR * DM + ch])); }
    const int p2 = (tid & 31) * 2; const int chp = n * 64 + p2;
    const float k00 = cw[0 * DM + chp], k01 = cw[0 * DM + chp + 1], k10 = cw[1 * DM + chp], k11 = cw[1 * DM + chp + 1], k20 = cw[2 * DM + chp], k21 = cw[2 * DM + chp + 1], k30 = cw[3 * DM + chp], k31 = cw[3 * DM + chp + 1];
    const float cb0 = cb[chp], cb1 = cb[chp + 1];
    v4u pre[3];
#define RG_LOAD(t0_) do { _Pragma("unroll") for (int i = 0; i < 3; ++i) { const int pidx = tid + 512 * i; const int rr = pidx >> 3, cc = pidx & 7; const int t = (t0_) - 2 + rr; \
        pre[i] = (v4u){0u, 0u, 0u, 0u}; if (pidx < (T + 3) * 8 && t >= 0 && t < SEQ) pre[i] = *(const v4u*)(XR + (rowbase + t) * DM + n * 64 + cc * 8); } } while (0)
    RG_LOAD(DIR == 0 ? 0 : SEQ - T);
    for (int ci = 0; ci < SEQ / T; ++ci) {
        const int chunk = DIR == 0 ? ci : SEQ / T - 1 - ci; const int t0 = chunk * T; const int cur = ci & 1;
        __syncthreads();
#pragma unroll
        for (int i = 0; i < 3; ++i) { const int pidx = tid + 512 * i; if (pidx < (T + 3) * 8) *(LAS v4u*)(XRAW + pidx * 8) = pre[i]; }
        __syncthreads();
        if (ci + 1 < SEQ / T) RG_LOAD(DIR == 0 ? t0 + T : t0 - T);
#pragma unroll
        for (int i = 0; i < 8; ++i) { const int r = (tid >> 5) + 16 * i;
            const unsigned x0 = *(LAS unsigned*)(XRAW + (r + 0) * 64 + p2), x1 = *(LAS unsigned*)(XRAW + (r + 1) * 64 + p2), x2 = *(LAS unsigned*)(XRAW + (r + 2) * 64 + p2), x3 = *(LAS unsigned*)(XRAW + (r + 3) * 64 + p2);
            const float v0 = cb0 + k00 * lo_bf(x0) + k10 * lo_bf(x1) + k20 * lo_bf(x2) + k30 * lo_bf(x3);
            const float v1 = cb1 + k01 * hi_bf(x0) + k11 * hi_bf(x1) + k21 * hi_bf(x2) + k31 * hi_bf(x3);
            *(LAS f32x2*)(XCF + r * FS + p2) = (f32x2){v0, v1}; *(LAS unsigned*)(XCB + r * XS + p2) = pk2(v0, v1); }
        __syncthreads();
        bf16x8v a0 = *(LAS bf16x8v*)(XCB + (wid * 16 + fr) * XS + fq * 8), a1 = *(LAS bf16x8v*)(XCB + (wid * 16 + fr) * XS + 32 + fq * 8);
        f32x4v ga[4], gi[4];
#pragma unroll
        for (int nf = 0; nf < 4; ++nf) {
            const bf16x8v wa0 = *(LAS bf16x8v*)(WA + (nf * 16 + fr) * XS + fq * 8), wa1 = *(LAS bf16x8v*)(WA + (nf * 16 + fr) * XS + 32 + fq * 8);
            const bf16x8v wi0 = *(LAS bf16x8v*)(WI + (nf * 16 + fr) * XS + fq * 8), wi1 = *(LAS bf16x8v*)(WI + (nf * 16 + fr) * XS + 32 + fq * 8);
            ga[nf] = __builtin_amdgcn_mfma_f32_16x16x32_bf16(a0, wa0, (f32x4v){0.f, 0.f, 0.f, 0.f}, 0, 0, 0); ga[nf] = __builtin_amdgcn_mfma_f32_16x16x32_bf16(a1, wa1, ga[nf], 0, 0, 0);
            gi[nf] = __builtin_amdgcn_mfma_f32_16x16x32_bf16(a0, wi0, (f32x4v){0.f, 0.f, 0.f, 0.f}, 0, 0, 0); gi[nf] = __builtin_amdgcn_mfma_f32_16x16x32_bf16(a1, wi1, gi[nf], 0, 0, 0);
        }
        float hl[4][4], P[4][4], Ain[4], Hin[4], Aex[4], Hex[4];
#pragma unroll
        for (int nf = 0; nf < 4; ++nf) {
            float av[4], uv[4];
#pragma unroll
            for (int g = 0; g < 4; ++g) {
                const float r = sigmoidf_(ga[nf][g] + ba[nf]), ig = sigmoidf_(gi[nf][g] + bi[nf]);
                const float la = sp[nf] * r, a = fexp(la), x2 = 2.f * la;
                const float poly = -x2 * (1.f + x2 * (0.5f + x2 * (0.16666667f + x2 * (0.041666668f + x2 * (0.0083333333f + x2 * 0.0013888889f)))));
                const float om = x2 > -0.25f ? poly : 1.f - a * a;
                const float xc = XCF[(wid * 16 + fq * 4 + g) * FS + nf * 16 + fr];
                av[g] = a; uv[g] = __builtin_amdgcn_sqrtf(om) * ig * xc;
            }
            if (DIR == 0) { hl[nf][0] = uv[0]; P[nf][0] = av[0];
#pragma unroll
                for (int g = 1; g < 4; ++g) { hl[nf][g] = av[g] * hl[nf][g - 1] + uv[g]; P[nf][g] = av[g] * P[nf][g - 1]; } }
            else { hl[nf][3] = uv[3]; P[nf][3] = av[3];
#pragma unroll
                for (int g = 2; g >= 0; --g) { hl[nf][g] = av[g] * hl[nf][g + 1] + uv[g]; P[nf][g] = av[g] * P[nf][g + 1]; } }
            float A = DIR == 0 ? P[nf][3] : P[nf][0], H = DIR == 0 ? hl[nf][3] : hl[nf][0];
            { const float Ap = DIR == 0 ? __shfl_up(A, 16) : __shfl_down(A, 16), Hp = DIR == 0 ? __shfl_up(H, 16) : __shfl_down(H, 16);
              if (DIR == 0 ? fq >= 1 : fq <= 2) { H = A * Hp + H; A = A * Ap; } }
            { const float Ap = DIR == 0 ? __shfl_up(A, 32) : __shfl_down(A, 32), Hp = DIR == 0 ? __shfl_up(H, 32) : __shfl_down(H, 32);
              if (DIR == 0 ? fq >= 2 : fq <= 1) { H = A * Hp + H; A = A * Ap; } }
            Ain[nf] = A; Hin[nf] = H;
            { const float Ae = DIR == 0 ? __shfl_up(A, 16) : __shfl_down(A, 16), He = DIR == 0 ? __shfl_up(H, 16) : __shfl_down(H, 16);
              const bool first = DIR == 0 ? fq == 0 : fq == 3; Aex[nf] = first ? 1.f : Ae; Hex[nf] = first ? 0.f : He; }
            if (DIR == 0 ? fq == 3 : fq == 0) { SUM[(wid * 64 + nf * 16 + fr) * 2] = A; SUM[(wid * 64 + nf * 16 + fr) * 2 + 1] = H; }
        }
        __syncthreads();
#pragma unroll
        for (int nf = 0; nf < 4; ++nf) {
            const int chl = nf * 16 + fr;
            float cwv = CAR[cur * 64 + chl];
            if (DIR == 0) { for (int w2 = 0; w2 < wid; ++w2) cwv = SUM[(w2 * 64 + chl) * 2] * cwv + SUM[(w2 * 64 + chl) * 2 + 1]; }
            else { for (int w2 = 7; w2 > wid; --w2) cwv = SUM[(w2 * 64 + chl) * 2] * cwv + SUM[(w2 * 64 + chl) * 2 + 1]; }
            if ((DIR == 0 ? wid == 7 && fq == 3 : wid == 0 && fq == 0)) CAR[(cur ^ 1) * 64 + chl] = Ain[nf] * cwv + Hin[nf];
            const float cl = Aex[nf] * cwv + Hex[nf];
#pragma unroll
            for (int g = 0; g < 4; ++g) {
                const float hv = hl[nf][g] + P[nf][g] * cl;
                const size_t row = rowbase + t0 + wid * 16 + fq * 4 + g; const int ch = n * 64 + chl;
                if (DIR == 0) HF[row * DM + ch] = f2bf(hv);
                else { const float yr = bf2f(AO[row * 2048 + ch]); AO[row * 2048 + ch] = f2bf((hv + bf2f(HF[row * DM + ch])) * gelu_tanh(yr)); }
            }
        }
    }
#undef RG_LOAD
}
}
#define XB_TMO      128
#define XB_XCNT(j)  (256  + 64 * (j))
#define XB_XSUB(j)  (1280 + 64 * (j))
#define XB_XGEN(j)  (2304 + 64 * (j))
#define XB_TOP      3328
#define XB_TOPGEN   3392
#define XCD_BAR_WORDS 3456
#define XB_SPIN_CAP (1u << 18)

__device__ __forceinline__ unsigned xb_ld(unsigned* p)              { return __hip_atomic_load(p, __ATOMIC_RELAXED, __HIP_MEMORY_SCOPE_AGENT); }
__device__ __forceinline__ unsigned xb_add(unsigned* p, unsigned v) { return __hip_atomic_fetch_add(p, v, __ATOMIC_RELAXED, __HIP_MEMORY_SCOPE_AGENT); }
__device__ __forceinline__ unsigned xb_xcc_id() { return (unsigned)__builtin_amdgcn_s_getreg((3 << 11) | 20) & 0xFu; }
#define XB_SPIN(cond, bar) do { unsigned _sp = 0; while (cond) { __builtin_amdgcn_s_sleep(1); \
    if ((++_sp & 255u) == 0u) { if (xb_ld(&(bar)[XB_TMO])) break; if (_sp > XB_SPIN_CAP) { atomicAdd(&(bar)[XB_TMO], 1u); break; } } } } while (0)

struct XcdBarrier {
    unsigned* bar; unsigned x;
    volatile LAS unsigned* st;
};

__device__ __forceinline__ XcdBarrier xcd_barrier_post(unsigned* bar, volatile LAS unsigned* st) {
    XcdBarrier b; b.bar = bar; b.x = xb_xcc_id(); b.st = st;
    if (threadIdx.x == 0) (void)xb_add(&bar[XB_XCNT(b.x)], 1u);
    return b;
}
__device__ __forceinline__ void xcd_barrier_complete(unsigned* bar, unsigned x, unsigned& nloc, unsigned& nx) {
    const unsigned G = gridDim.x * gridDim.y * gridDim.z;
    unsigned sum, cnt, mine, sp = 0u;
    for (;;) {
        sum = 0u; cnt = 0u; mine = 0u;
#pragma unroll
        for (unsigned j = 0; j < 16; ++j) { const unsigned c = xb_ld(&bar[XB_XCNT(j)]); sum += c; cnt += (c > 0u) ? 1u : 0u; mine = (j == x) ? c : mine; }
        if (sum == G) break;
        __builtin_amdgcn_s_sleep(1);
        if ((++sp & 255u) == 0u) { if (xb_ld(&bar[XB_TMO])) break; if (sp > XB_SPIN_CAP) { atomicAdd(&bar[XB_TMO], 1u); break; } }
    }
    nloc = mine > 0u ? mine : 1u; nx = cnt > 0u ? cnt : 1u;
}

__device__ __forceinline__ void xcd_barrier(const XcdBarrier& b) {
    asm volatile("s_waitcnt vmcnt(0)" ::: "memory");
    __syncthreads();
    if (threadIdx.x == 0) {
        unsigned* bar = b.bar;
        __builtin_amdgcn_s_waitcnt(0);
        unsigned nloc = b.st[0], nx = b.st[1];
        if (nloc == 0u) { xcd_barrier_complete(bar, b.x, nloc, nx); b.st[0] = nloc; b.st[1] = nx; }
        const unsigned old = xb_add(&bar[XB_XSUB(b.x)], 1u);
        const unsigned gen = old / nloc;
        if (old + 1u == (gen + 1u) * nloc) {
            __builtin_amdgcn_fence(__ATOMIC_RELEASE, "agent");
            asm volatile("s_waitcnt vmcnt(0)" ::: "memory");
            const unsigned og = xb_add(&bar[XB_TOP], 1u);
            const unsigned tg = og / nx;
            if (og + 1u == (tg + 1u) * nx) xb_add(&bar[XB_TOPGEN], 1u);
            else XB_SPIN(xb_ld(&bar[XB_TOPGEN]) == tg, bar);
            __builtin_amdgcn_fence(__ATOMIC_ACQUIRE, "agent");
            xb_add(&bar[XB_XGEN(b.x)], 1u);
            asm volatile("s_waitcnt vmcnt(0)" ::: "memory");
        } else {
            XB_SPIN(xb_ld(&bar[XB_XGEN(b.x)]) == gen, bar);
            __builtin_amdgcn_fence(__ATOMIC_ACQUIRE, "agent");
            asm volatile("s_waitcnt vmcnt(0)" ::: "memory");
        }
    }
    __syncthreads();
}
struct Frame {
    LAS unsigned char* lds;
    int tid, lane, wave, vcu, G;
};
__device__ __forceinline__ void p0_transpose_item(const float* W, int K, int N, bf16_t* WT, int row_off, LAS float* scr, int kb, int nb, int lane) {
    const int k0 = 64 * kb, n0 = 32 * nb;
#pragma unroll 8
    for (int i = 0; i < 32; ++i) { const int kk = 2 * i + (lane >> 5); scr[kk * 33 + (lane & 31)] = W[(size_t)(k0 + kk) * N + n0 + (lane & 31)]; }
    LDS_WAIT(); asm volatile("" ::: "memory");
    const int c = lane & 7;
#pragma unroll
    for (int j = 0; j < 4; ++j) { const int n = (lane >> 3) + 8 * j; const LAS float* s = scr + (8 * c) * 33 + n;
        v4u o; o.x = pk2(s[0 * 33], s[1 * 33]); o.y = pk2(s[2 * 33], s[3 * 33]); o.z = pk2(s[4 * 33], s[5 * 33]); o.w = pk2(s[6 * 33], s[7 * 33]);
        *(GAS v4u*)(WT + (size_t)(row_off + n0 + n) * K + k0 + 8 * c) = o; }
    LDS_WAIT(); asm volatile("" ::: "memory");
}
__device__ __forceinline__ void normmod_row(const float* xrow, const float* g, const float* sc, const float* sh, bf16_t* orow, int lane) {
    f32x4 v[4]; float s = 0.f;
#pragma unroll
    for (int j = 0; j < 4; ++j) { v[j] = *((const f32x4*)xrow + lane + 64 * j); s += (v[j].x * v[j].x + v[j].y * v[j].y) + (v[j].z * v[j].z + v[j].w * v[j].w); }
    const float rstd = rsqrtf(wave_sum(s) * (1.f / DM) + EPS);
#pragma unroll
    for (int j = 0; j < 4; ++j) { const f32x4 gg = *((const f32x4*)g + lane + 64 * j), cc = *((const f32x4*)sc + lane + 64 * j), hh = *((const f32x4*)sh + lane + 64 * j);
        const f32x4 y = v[j] * rstd * gg * (cc + 1.f) + hh; v2u w; w.x = pk2(y.x, y.y); w.y = pk2(y.z, y.w); *((v2u*)orow + lane + 64 * j) = w; }
}

#ifndef MIX_SEL
#define MIX_SEL 3
#endif
#ifndef PH_MASK
#define PH_MASK 0x7ff
#endif
struct Args { const void* in[28]; float* out; unsigned char* ws; int ph_lo, ph_hi, li, pad; };
typedef const __attribute__((address_space(4))) Args KArgs;
__device__ __forceinline__ KArgs* ka_ptr() { auto p = __builtin_amdgcn_kernarg_segment_ptr(); asm volatile("" : "+s"(p)); return (KArgs*)p; }
enum { P_PRO = 0, P_NORM1, P_PROJ, P_MIX, P_MERGE, P_OUT, P_NORM2, P_UP, P_FIX, P_DOWN, P_FINAL, N_PHASES };

__global__ void __launch_bounds__(NWAVES * 64, 2) mk_fwd(Args args) {
    extern __shared__ __attribute__((aligned(16))) unsigned char lds[];
    for (int u = threadIdx.x; u < (LDS_BYTES - LDSCTL_OFF) / 4; u += NWAVES * 64) ((LAS unsigned*)((LAS unsigned char*)lds + LDSCTL_OFF))[u] = 0u;
    __syncthreads();
    { KArgs* KA = ka_ptr(); if (KA->ph_hi - KA->ph_lo > 1) (void)xcd_barrier_post((unsigned*)(KA->ws + WS_CTL) + CW_BAR + KA->li * XCD_BAR_WORDS, (volatile LAS unsigned*)((LAS unsigned char*)lds + MISC_OFF) + 8); }
#define INP(k) ((const float*)KA->in[k])
#define WSP(T, off) ((T*)(KA->ws + (off)))
#define IN(k) (((PH_MASK >> (k)) & 1) && ka_ptr()->ph_lo <= (k) && (k) < ka_ptr()->ph_hi)
#define SEAM(k) do { KArgs* KB_ = ka_ptr(); if (KB_->ph_lo <= (k) && (k) + 1 < KB_->ph_hi) { XcdBarrier bar; bar.bar = (unsigned*)(KB_->ws + WS_CTL) + CW_BAR + KB_->li * XCD_BAR_WORDS; bar.x = xb_xcc_id(); \
        bar.st = (volatile LAS unsigned*)((LAS unsigned char*)lds + MISC_OFF) + 8; xcd_barrier(bar); } } while (0)
#define FRAME() Frame F; F.lds = (LAS unsigned char*)lds; F.tid = threadIdx.x; F.lane = F.tid & 63; F.wave = __builtin_amdgcn_readfirstlane(F.tid >> 6); F.G = gridDim.x; \
        { const int bx = blockIdx.x; F.vcu = (F.G % 8 == 0) ? (bx % 8) * (F.G / 8) + bx / 8 : bx; } const int gw = F.vcu * NWAVES + F.wave, NGW = F.G * NWAVES; (void)gw; (void)NGW;

    if (IN(P_PRO)) {
        KArgs* KA = ka_ptr(); FRAME(); const float* cvec = INP(1); const int* pos = (const int*)KA->in[2]; const float* w_ada = INP(3); const float* b_ada = INP(4);
        float* MOD = WSP(float, WS_MOD); float* COS = WSP(float, WS_COS); float* SIN = WSP(float, WS_SIN);
        if (F.vcu < 24) {
            LAS float* SC = (LAS float*)F.lds;
            for (int i = F.tid; i < BATCH * DM; i += NWAVES * 64) { const float cv = cvec[i]; SC[i] = cv * sigmoidf_(cv); }
            __syncthreads();
            const int j = F.vcu * 256 + F.lane * 4; f32x4 acc[16];
#pragma unroll
            for (int b = 0; b < 16; ++b) acc[b] = (f32x4){0.f, 0.f, 0.f, 0.f};
            for (int kk = 0; kk < 128; kk += 8) {
                f32x4 wv[8];
#pragma unroll
                for (int q = 0; q < 8; ++q) wv[q] = *(const f32x4*)(w_ada + (size_t)(F.wave * 128 + kk + q) * NMODC + j);
#pragma unroll
                for (int q = 0; q < 8; ++q)
#pragma unroll
                    for (int b = 0; b < 16; ++b) acc[b] += wv[q] * SC[b * DM + F.wave * 128 + kk + q];
            }
            __syncthreads();
            LAS f32x4* RED = (LAS f32x4*)F.lds;
#pragma unroll
            for (int b = 0; b < 16; ++b) RED[(F.wave * 16 + b) * 64 + F.lane] = acc[b];
            __syncthreads();
            for (int o = F.tid; o < 16 * 64; o += NWAVES * 64) { const int b = o >> 6, l4 = o & 63; f32x4 s = *(const f32x4*)(b_ada + F.vcu * 256 + l4 * 4);
#pragma unroll
                for (int w = 0; w < 8; ++w) s += RED[(w * 16 + b) * 64 + l4];
                *(f32x4*)(MOD + (size_t)b * NMODC + F.vcu * 256 + l4 * 4) = s; }
            __syncthreads();
        }
        for (int idx = F.vcu * 512 + F.tid; idx < M * 8; idx += F.G * 512) {
            const int row = idx >> 3, i = idx & 7;
            const float invf = powf(500000.0f, -(float)i / 8.0f);
            const float ang = (float)pos[row] * invf;
            const double rev = (double)ang * 0.15915494309189535; const double fr = rev - rint(rev);
            COS[idx] = __builtin_amdgcn_cosf((float)fr); SIN[idx] = __builtin_amdgcn_sinf((float)fr);
        }
        {
            const float* w_in = INP(6); const float* w_rnn_o = INP(14); const float* w_attn_o = INP(20); const float* w_out = INP(21); const float* w_up = INP(23); const float* w_down = INP(26);
            bf16_t* WIN_T = WSP(bf16_t, WS_WIN); bf16_t* WA_T = WSP(bf16_t, WS_WA); bf16_t* WB_T = WSP(bf16_t, WS_WB); bf16_t* WOUT_T = WSP(bf16_t, WS_WOUT); bf16_t* WUP_T = WSP(bf16_t, WS_WUP); bf16_t* WDOWN_T = WSP(bf16_t, WS_WDOWN);
            LAS float* scr = (LAS float*)(F.lds + F.wave * 16384);
            constexpr int I_IN = 16 * (INCOLS / 32), I_SQ = 16 * 32, I_UP = 16 * (2 * DFF / 32), I_DN = (DFF / 64) * 32;
            constexpr int NITEMS = I_IN + 3 * I_SQ + I_UP + I_DN;
            for (int it = gw; it < NITEMS; it += NGW) {
                int r = it;
                if (r < I_IN) { p0_transpose_item(w_in, DM, INCOLS, WIN_T, 0, scr, r / (INCOLS / 32), r % (INCOLS / 32), F.lane); continue; } r -= I_IN;
                if (r < I_SQ) { p0_transpose_item(w_rnn_o, DM, DM, WA_T, 0, scr, r / 32, r % 32, F.lane); continue; } r -= I_SQ;
                if (r < I_SQ) { p0_transpose_item(w_attn_o, DM, DM, WB_T, 0, scr, r / 32, r % 32, F.lane); continue; } r -= I_SQ;
                if (r < I_SQ) { p0_transpose_item(w_out, DM, DM, WOUT_T, 0, scr, r / 32, r % 32, F.lane); continue; } r -= I_SQ;
                if (r < I_UP) { const int kb = r / (2 * DFF / 32), nb = r % (2 * DFF / 32), n0 = nb * 32; const int jn = n0 < DFF ? n0 : n0 - DFF; const int mapped = (jn / 128) * 256 + (n0 < DFF ? 0 : 128) + (jn % 128);
                    p0_transpose_item(w_up, DM, 2 * DFF, WUP_T, mapped - n0, scr, kb, nb, F.lane); continue; } r -= I_UP;
                p0_transpose_item(w_down, DFF, DM, WDOWN_T, 0, scr, r / 32, r % 32, F.lane);
            }
        }
        if (gw == 0) {
            const float* lq1 = INP(15); const float* lk1 = INP(16); const float* lq2 = INP(17); const float* lk2 = INP(18);
            const float s1 = wave_sum(lq1[F.lane] * lk1[F.lane]), s2 = wave_sum(lq2[F.lane] * lk2[F.lane]);
            if (F.lane == 0) MOD[BATCH * NMODC] = fexp(s1) - fexp(s2) + 0.2f;
        }
    }
    SEAM(P_PRO);
    if (IN(P_NORM1)) { KArgs* KA = ka_ptr(); FRAME(); const float* x = INP(0); const float* norm1_g = INP(5); const float* MOD = WSP(float, WS_MOD); bf16_t* H = WSP(bf16_t, WS_H); for (int m = gw; m < M; m += NGW) { const float* mb = MOD + (size_t)(m / SEQ) * NMODC; normmod_row(x + (size_t)m * DM, norm1_g, mb + 1024, mb, H + (size_t)m * DM, F.lane); } }
    SEAM(P_NORM1);
    if (IN(P_PROJ)) {
        KArgs* KA = ka_ptr(); FRAME(); bf16_t* H = WSP(bf16_t, WS_H); bf16_t* WIN_T = WSP(bf16_t, WS_WIN); bf16_t* XR = WSP(bf16_t, WS_XR); bf16_t* AO = WSP(bf16_t, WS_AO); bf16_t* KB = WSP(bf16_t, WS_K); bf16_t* VB = WSP(bf16_t, WS_V);
        bf16_t* GT = (bf16_t*)KA->out; const float* COS = WSP(float, WS_COS); const float* SIN = WSP(float, WS_SIN);
        pg8::Gemm g{H, WIN_T, M, INCOLS, DM, DM}; pg8::StaticOrder S; S.init(M, INCOLS, F.G, (int)blockIdx.x);
        EpiProj E{XR, AO, KB, VB, GT, COS, SIN};
        pg8::gemm_phase<EpiProj, pg8::StaticOrder, PG8_ALIGN, PG8_SP2>(F.lds + RING_OFF, g, S, E);
    }
    SEAM(P_PROJ);
    if (IN(P_MIX)) {
        KArgs* KA = ka_ptr(); FRAME(); bf16_t* XR = WSP(bf16_t, WS_XR); bf16_t* AO = WSP(bf16_t, WS_AO); bf16_t* KB = WSP(bf16_t, WS_K); bf16_t* VB = WSP(bf16_t, WS_V); bf16_t* HF = WSP(bf16_t, WS_HF); const float* MOD = WSP(float, WS_MOD);
        const float* conv_rnn_w = INP(7); const float* conv_rnn_b = INP(8); const float* w_rg_a = INP(9); const float* b_rg_a = INP(10); const float* w_rg_i = INP(11); const float* b_rg_i = INP(12); const float* rg_lambda = INP(13); const float* subln_g = INP(19);
        if ((MIX_SEL & 1) && (KA->pad & 1) && F.vcu < 256) { const int b = F.vcu >> 4, n = F.vcu & 15;
            rg::sweep<0>(b, n, XR, AO, HF, conv_rnn_w, conv_rnn_b, w_rg_a, b_rg_a, w_rg_i, b_rg_i, rg_lambda, F.lds);
            rg::sweep<1>(b, n, XR, AO, HF, conv_rnn_w, conv_rnn_b, w_rg_a, b_rg_a, w_rg_i, b_rg_i, rg_lambda, F.lds);
            __syncthreads(); }
        const float lam = MOD[BATCH * NMODC];
        if ((MIX_SEL & 2) && (KA->pad & 2)) for (int uidx = F.vcu * 8; uidx < BATCH * 8 * 16; uidx += F.G * 8) {
#pragma unroll 1
            for (int q = 0; q < 8; ++q) { const int un = uidx + q; const int bh = un >> 4, qb = un & 15;
                att::attn_unit(bh >> 3, bh & 7, qb, AO, KB, VB, lam, subln_g, (char*)lds); }
        }
    }
    SEAM(P_MIX);
    if (IN(P_MERGE)) {
        KArgs* KA = ka_ptr(); FRAME(); bf16_t* AO = WSP(bf16_t, WS_AO); bf16_t* WA_T = WSP(bf16_t, WS_WA); bf16_t* WB_T = WSP(bf16_t, WS_WB); bf16_t* GT = (bf16_t*)KA->out; bf16_t* MG = WSP(bf16_t, WS_XR);
        pg8::StaticOrder S; S.init(M, DM, F.G, (int)blockIdx.x);
        { pg8::Gemm g{AO, WA_T, M, DM, DM, 2048}; EpiMerge<0> E{GT, MG}; pg8::gemm_phase<EpiMerge<0>, pg8::StaticOrder, PG8_ALIGN, PG8_SP2>(F.lds + RING_OFF, g, S, E); }
        VM_WAIT(); __builtin_amdgcn_fence(__ATOMIC_ACQUIRE, "agent"); VM_WAIT(); __syncthreads();
        { pg8::Gemm g{AO + 1024, WB_T, M, DM, DM, 2048}; EpiMerge<1> E{GT, MG}; pg8::gemm_phase<EpiMerge<1>, pg8::StaticOrder, PG8_ALIGN, PG8_SP2>(F.lds + RING_OFF, g, S, E); }
    }
    SEAM(P_MERGE);
    if (IN(P_OUT)) {
        KArgs* KA = ka_ptr(); FRAME(); bf16_t* MG = WSP(bf16_t, WS_XR); bf16_t* WOUT_T = WSP(bf16_t, WS_WOUT); const float* x = INP(0); float* out = KA->out; const float* MOD = WSP(float, WS_MOD);
        pg8::Gemm g{MG, WOUT_T, M, DM, DM, DM}; pg8::StaticOrder S; S.init(M, DM, F.G, (int)blockIdx.x);
        EpiResid E{x, out, MOD + 2048}; pg8::gemm_phase<EpiResid, pg8::StaticOrder, PG8_ALIGN, PG8_SP2>(F.lds + RING_OFF, g, S, E);
    }
    SEAM(P_OUT);
    if (IN(P_NORM2)) { KArgs* KA = ka_ptr(); FRAME(); const float* out = KA->out; const float* norm2_g = INP(22); const float* MOD = WSP(float, WS_MOD); bf16_t* H = WSP(bf16_t, WS_H); for (int m = gw; m < M; m += NGW) { const float* mb = MOD + (size_t)(m / SEQ) * NMODC; normmod_row(out + (size_t)m * DM, norm2_g, mb + 4096, mb + 3072, H + (size_t)m * DM, F.lane); } }
    SEAM(P_NORM2);
    if (IN(P_UP)) {
        KArgs* KA = ka_ptr(); FRAME(); bf16_t* H = WSP(bf16_t, WS_H); bf16_t* WUP_T = WSP(bf16_t, WS_WUP); bf16_t* ACT = WSP(bf16_t, WS_ACT); float* EDGE = WSP(float, WS_EDGE); const float* conv_ffn_w = INP(24); const float* conv_ffn_b = INP(25);
        pg8::Gemm g{H, WUP_T, M, 2 * DFF, DM, DM}; pg8::StaticOrder S; S.init(M, 2 * DFF, F.G, (int)blockIdx.x);
        EpiUpConv E{ACT, EDGE, conv_ffn_w, conv_ffn_b}; pg8::gemm_phase<EpiUpConv, pg8::StaticOrder, PG8_ALIGN, PG8_SP2>(F.lds + RING_OFF, g, S, E);
    }
    SEAM(P_UP);
    if (IN(P_FIX)) {
        KArgs* KA = ka_ptr(); FRAME(); bf16_t* ACT = WSP(bf16_t, WS_ACT); const float* EDGE = WSP(float, WS_EDGE); const float* conv_ffn_w = INP(24); const float* conv_ffn_b = INP(25);
        for (int idx = F.vcu * 512 + F.tid; idx < 512 * 2 * DFF; idx += F.G * 512) {
            const int j = idx % DFF, ge = idx / DFF, e = ge & 1, gband = ge >> 1;
            const int pc = (j / 128) * 256 + (j % 128);
            const float* Eb = EDGE + (size_t)gband * 4 * 5632;
            float pv, pg, cv, cg, nv, ng;
            if (e == 0) { const bool z = (gband % 32) == 0; pv = z ? 0.f : Eb[-5632 + pc]; pg = z ? 0.f : Eb[-5632 + pc + 128]; cv = Eb[pc]; cg = Eb[pc + 128]; nv = Eb[5632 + pc]; ng = Eb[5632 + pc + 128]; }
            else { const bool z = ((gband + 1) % 32) == 0; pv = Eb[2 * 5632 + pc]; pg = Eb[2 * 5632 + pc + 128]; cv = Eb[3 * 5632 + pc]; cg = Eb[3 * 5632 + pc + 128]; nv = z ? 0.f : Eb[4 * 5632 + pc]; ng = z ? 0.f : Eb[4 * 5632 + pc + 128]; }
            const float vcv = conv_ffn_b[j] + conv_ffn_w[j] * pv + conv_ffn_w[2 * DFF + j] * cv + conv_ffn_w[4 * DFF + j] * nv;
            const float gcv = conv_ffn_b[DFF + j] + conv_ffn_w[DFF + j] * pg + conv_ffn_w[3 * DFF + j] * cg + conv_ffn_w[5 * DFF + j] * ng;
            ACT[(size_t)(gband * 64 + (e ? 63 : 0)) * DFF + j] = f2bf(gcv * sigmoidf_(gcv) * vcv);
        }
    }
    SEAM(P_FIX);
    if (IN(P_DOWN)) {
        KArgs* KA = ka_ptr(); FRAME(); bf16_t* ACT = WSP(bf16_t, WS_ACT); bf16_t* WDOWN_T = WSP(bf16_t, WS_WDOWN); float* out = KA->out; const float* MOD = WSP(float, WS_MOD);
        pg8::Gemm g{ACT, WDOWN_T, M, DM, DFF, DFF}; pg8::StaticOrder S; S.init(M, DM, F.G, (int)blockIdx.x);
        EpiResid E{out, out, MOD + 5120}; pg8::gemm_phase<EpiResid, pg8::StaticOrder, PG8_ALIGN, PG8_SP2>(F.lds + RING_OFF, g, S, E);
    }
    SEAM(P_DOWN);
    if (IN(P_FINAL)) {
        KArgs* KA = ka_ptr(); FRAME(); float* out = KA->out; const float* final_g = INP(27);
        for (int m = gw; m < M; m += NGW) { float* xr = out + (size_t)m * DM; f32x4 v[4]; float s = 0.f;
#pragma unroll
            for (int j = 0; j < 4; ++j) { v[j] = *((const f32x4*)xr + F.lane + 64 * j); s += (v[j].x * v[j].x + v[j].y * v[j].y) + (v[j].z * v[j].z + v[j].w * v[j].w); }
            const float rstd = rsqrtf(wave_sum(s) * (1.f / DM) + EPS);
#pragma unroll
            for (int j = 0; j < 4; ++j) { const f32x4 gg = *((const f32x4*)final_g + F.lane + 64 * j); *((f32x4*)xr + F.lane + 64 * j) = v[j] * rstd * gg; } }
    }
#undef IN
#undef SEAM
#undef INP
#undef WSP
#undef FRAME
}
__device__ __forceinline__ float nv_sigmoid(float x) { return 1.f / (1.f + __expf(-x)); }
__device__ __forceinline__ float nv_gelu(float x) { const float u = 1.5957691216057308f * (x + 0.044715f * x * x * x); return x / (1.f + __expf(-u)); }
__global__ void __launch_bounds__(256) k_mod(const float* __restrict__ c, const float* __restrict__ w_ada, const float* __restrict__ b_ada, float* __restrict__ mod,
                                             const float* lq1, const float* lk1, const float* lq2, const float* lk2) {
    const int j = blockIdx.x * 256 + threadIdx.x, b = blockIdx.y;
    float acc = b_ada[j];
    for (int k = 0; k < DM; ++k) { const float cv = c[b * DM + k]; acc += (cv / (1.f + __expf(-cv))) * w_ada[(size_t)k * NMODC + j]; }
    mod[b * NMODC + j] = acc;
    if (blockIdx.x == 0 && blockIdx.y == 0 && threadIdx.x == 0) {
        float s1 = 0.f, s2 = 0.f;
        for (int i = 0; i < 64; ++i) { s1 += lq1[i] * lk1[i]; s2 += lq2[i] * lk2[i]; }
        mod[BATCH * NMODC] = __expf(s1) - __expf(s2) + 0.2f;
    }
}
__global__ void __launch_bounds__(256) k_rope_tab(const int* __restrict__ pos, float* __restrict__ cs, float* __restrict__ sn) {
    const int idx = blockIdx.x * 256 + threadIdx.x; if (idx >= M * 8) return;
    const int row = idx >> 3, i = idx & 7;
    const float invf = powf(500000.0f, -(float)i / 8.0f);
    const float ang = (float)pos[row] * invf;
    const double rev = (double)ang * 0.15915494309189535;
    const double fr = rev - rint(rev);
    cs[idx] = __builtin_amdgcn_cosf((float)fr); sn[idx] = __builtin_amdgcn_sinf((float)fr);
}
__global__ void __launch_bounds__(256) k_normmod(const float* __restrict__ x, const float* __restrict__ g, const float* __restrict__ mod, int sh_off, int sc_off, bf16_t* __restrict__ out) {
    const int row = blockIdx.x * 4 + (threadIdx.x >> 6), lane = threadIdx.x & 63, b = row / SEQ;
    const float* xr = x + (size_t)row * DM; float v[16]; float ss = 0.f;
#pragma unroll
    for (int j = 0; j < 16; ++j) { v[j] = xr[lane + 64 * j]; ss += v[j] * v[j]; }
#pragma unroll
    for (int o = 1; o < 64; o <<= 1) ss += __shfl_xor(ss, o);
    const float rstd = rsqrtf(ss * (1.f / DM) + EPS);
#pragma unroll
    for (int j = 0; j < 16; ++j) { const int k = lane + 64 * j; out[(size_t)row * DM + k] = f2bf(v[j] * rstd * g[k] * (1.f + mod[b * NMODC + sc_off + k]) + mod[b * NMODC + sh_off + k]); }
}
__global__ void __launch_bounds__(256) k_final(float* __restrict__ x, const float* __restrict__ g) {
    const int row = blockIdx.x * 4 + (threadIdx.x >> 6), lane = threadIdx.x & 63;
    float* xr = x + (size_t)row * DM; float v[16]; float ss = 0.f;
#pragma unroll
    for (int j = 0; j < 16; ++j) { v[j] = xr[lane + 64 * j]; ss += v[j] * v[j]; }
#pragma unroll
    for (int o = 1; o < 64; o <<= 1) ss += __shfl_xor(ss, o);
    const float rstd = rsqrtf(ss * (1.f / DM) + EPS);
#pragma unroll
    for (int j = 0; j < 16; ++j) { const int k = lane + 64 * j; xr[k] = v[j] * rstd * g[k]; }
}
template <class Epi> __global__ void __launch_bounds__(256) nv_gemm(const bf16_t* __restrict__ A, int lda, const float* __restrict__ W, int N, int K, Epi E) {
    __shared__ float As[16][68]; __shared__ float Bs[16][64];
    const int tid = threadIdx.x, tx = tid & 15, ty = tid >> 4, m0 = blockIdx.y * 64, n0 = blockIdx.x * 64;
    float acc[4][4] = {};
    for (int k0 = 0; k0 < K; k0 += 16) {
        { const int r = tid >> 2, kk = (tid & 3) * 4; const bf16_t* ap = A + (size_t)(m0 + r) * lda + k0 + kk;
          As[kk + 0][r] = bf2f(ap[0]); As[kk + 1][r] = bf2f(ap[1]); As[kk + 2][r] = bf2f(ap[2]); As[kk + 3][r] = bf2f(ap[3]); }
        { const int kk = tid >> 4, n = (tid & 15) * 4; const float4 w = *(const float4*)(W + (size_t)(k0 + kk) * N + n0 + n); *(float4*)&Bs[kk][n] = w; }
        __syncthreads();
#pragma unroll
        for (int k = 0; k < 16; ++k) { const float4 a = *(const float4*)&As[k][ty * 4]; const float4 b = *(const float4*)&Bs[k][tx * 4];
            const float av[4] = {a.x, a.y, a.z, a.w}, bv[4] = {b.x, b.y, b.z, b.w};
#pragma unroll
            for (int i = 0; i < 4; ++i)
#pragma unroll
                for (int j = 0; j < 4; ++j) acc[i][j] += av[i] * bv[j]; }
        __syncthreads();
    }
#pragma unroll
    for (int i = 0; i < 4; ++i)
#pragma unroll
        for (int j = 0; j < 4; ++j) E(m0 + ty * 4 + i, n0 + tx * 4 + j, acc[i][j]);
}
struct EProj { bf16_t *XR, *AO, *KB, *VB, *GT;
    __device__ void operator()(int m, int n, float v) const { const bf16_t o = f2bf(v);
        if (n < 1024) XR[(size_t)m * 1024 + n] = o; else if (n < 2048) AO[(size_t)m * 2048 + n - 1024] = o; else if (n < 3072) AO[(size_t)m * 2048 + 1024 + n - 2048] = o;
        else if (n < 4096) KB[(size_t)m * 1024 + n - 3072] = o; else if (n < 5120) VB[(size_t)m * 1024 + n - 4096] = o; else GT[(size_t)m * 2048 + n - 5120] = o; } };
struct EMergeA { const bf16_t* GT; bf16_t* MG; __device__ void operator()(int m, int n, float v) const { MG[(size_t)m * 1024 + n] = f2bf(nv_sigmoid(bf2f(GT[(size_t)m * 2048 + n])) * v); } };
struct EMergeB { const bf16_t* GT; bf16_t* MG; __device__ void operator()(int m, int n, float v) const { MG[(size_t)m * 1024 + n] = f2bf(bf2f(MG[(size_t)m * 1024 + n]) + nv_sigmoid(bf2f(GT[(size_t)m * 2048 + 1024 + n])) * v); } };
struct EOut { const float* x; const float* mod; float* X1; __device__ void operator()(int m, int n, float v) const { X1[(size_t)m * 1024 + n] = x[(size_t)m * 1024 + n] + mod[(m / SEQ) * NMODC + 2048 + n] * v; } };
struct EUp { bf16_t* UP; __device__ void operator()(int m, int n, float v) const { UP[(size_t)m * 5632 + n] = f2bf(v); } };
struct EDown { float* X; const float* mod; __device__ void operator()(int m, int n, float v) const { X[(size_t)m * 1024 + n] += mod[(m / SEQ) * NMODC + 5120 + n] * v; } };

__global__ void __launch_bounds__(256) k_rope(bf16_t* __restrict__ AO, bf16_t* __restrict__ KB, const float* __restrict__ cs, const float* __restrict__ sn) {
    const int idx = blockIdx.x * 256 + threadIdx.x; const int row = idx >> 4, hc = idx & 15;
    bf16_t* q = AO + (size_t)row * 2048 + 1024 + hc * 64; bf16_t* k = KB + (size_t)row * 1024 + hc * 64;
    float qv[64];
#pragma unroll
    for (int d = 0; d < 64; ++d) qv[d] = bf2f(q[d]);
#pragma unroll
    for (int i = 0; i < 8; ++i) { const float c = cs[row * 8 + i], s = sn[row * 8 + i]; const float a = qv[i], b = qv[i + 8]; qv[i] = a * c - b * s; qv[i + 8] = b * c + a * s;
        const float ka = bf2f(k[i]), kb = bf2f(k[i + 8]); k[i] = f2bf(ka * c - kb * s); k[i + 8] = f2bf(kb * c + ka * s); }
#pragma unroll
    for (int d = 0; d < 64; ++d) q[d] = f2bf(qv[d] * C2);
}
__global__ void __launch_bounds__(64) nv_rglru(const bf16_t* __restrict__ XR, bf16_t* __restrict__ AO, bf16_t* __restrict__ HF, const float* __restrict__ cw, const float* __restrict__ cb,
                                               const float* __restrict__ w_a, const float* __restrict__ b_a, const float* __restrict__ w_i, const float* __restrict__ b_i, const float* __restrict__ lam) {
    __shared__ float wA[64][64]; __shared__ float wI[64][64]; __shared__ float xcs[64];
    const int j = threadIdx.x, n = blockIdx.x, b = blockIdx.y, ch = n * 64 + j;
    const float c0 = cw[0 * DM + ch], c1 = cw[1 * DM + ch], c2 = cw[2 * DM + ch], c3 = cw[3 * DM + ch], cbv = cb[ch];
    for (int d = 0; d < 2; ++d) {
        __syncthreads();
        for (int k = 0; k < 64; ++k) { wA[k][j] = w_a[(((size_t)d * 16 + n) * 64 + k) * 64 + j]; wI[k][j] = w_i[(((size_t)d * 16 + n) * 64 + k) * 64 + j]; }
        const float ba = b_a[d * DM + ch], bi = b_i[d * DM + ch], sp = log1pf(__expf(-lam[d * DM + ch]));
        float h = 0.f;
        for (int tt = 0; tt < SEQ; ++tt) {
            const int t = d == 0 ? tt : SEQ - 1 - tt; const size_t row = (size_t)b * SEQ + t;
            float xc = cbv;
            if (t >= 2) xc += c0 * bf2f(XR[(row - 2) * DM + ch]);
            if (t >= 1) xc += c1 * bf2f(XR[(row - 1) * DM + ch]);
            xc += c2 * bf2f(XR[row * DM + ch]);
            if (t + 1 < SEQ) xc += c3 * bf2f(XR[(row + 1) * DM + ch]);
            __syncthreads(); xcs[j] = xc; __syncthreads();
            float ga = ba, gi = bi;
#pragma unroll 16
            for (int k = 0; k < 64; ++k) { const float xv = xcs[k]; ga += xv * wA[k][j]; gi += xv * wI[k][j]; }
            const float r = nv_sigmoid(ga), ig = nv_sigmoid(gi), la = -8.f * r * sp, a = __expf(la), u = sqrtf(-expm1f(2.f * la)) * ig * xc;
            h = a * h + u;
            if (d == 0) HF[row * DM + ch] = f2bf(h);
            else { const float yr = bf2f(AO[row * 2048 + ch]); AO[row * 2048 + ch] = f2bf((h + bf2f(HF[row * DM + ch])) * nv_gelu(yr)); }
        }
    }
}
__global__ void __launch_bounds__(256) nv_attn(bf16_t* __restrict__ AO, const bf16_t* __restrict__ KB, const bf16_t* __restrict__ VB, const float* __restrict__ subg, const float* __restrict__ scal) {
    __shared__ float Ks[64][64]; __shared__ float Vs[64][128];
    const int tid = threadIdx.x, qi = tid >> 3, chn = tid & 7, h = blockIdx.y, b = blockIdx.z;
    const size_t row = (size_t)b * SEQ + blockIdx.x * 32 + qi; const float lam = scal[0];
    float res[16];
    for (int c = 0; c < 2; ++c) {
        float q[64];
#pragma unroll
        for (int d = 0; d < 64; ++d) q[d] = bf2f(AO[row * 2048 + 1024 + h * 128 + c * 64 + d]);
        float m = -1e30f, l = 0.f, acc[16];
#pragma unroll
        for (int e = 0; e < 16; ++e) acc[e] = 0.f;
        for (int kt = 0; kt < SEQ / 64; ++kt) {
            __syncthreads();
            for (int i = 0; i < 16; ++i) { const int idx = tid + 256 * i, key = idx >> 6, d = idx & 63; Ks[key][d] = bf2f(KB[((size_t)b * SEQ + kt * 64 + key) * 1024 + h * 128 + c * 64 + d]); }
            for (int i = 0; i < 32; ++i) { const int idx = tid + 256 * i, key = idx >> 7, d = idx & 127; Vs[key][d] = bf2f(VB[((size_t)b * SEQ + kt * 64 + key) * 1024 + h * 128 + d]); }
            __syncthreads();
            for (int key = 0; key < 64; ++key) {
                float s = 0.f;
#pragma unroll
                for (int d = 0; d < 64; ++d) s += q[d] * Ks[key][d];
                const float mn = fmaxf(m, s), al = exp2f(m - mn), p = exp2f(s - mn); l = l * al + p; m = mn;
#pragma unroll
                for (int e = 0; e < 16; ++e) acc[e] = acc[e] * al + p * Vs[key][chn * 16 + e];
            }
        }
        const float inv = 1.f / l;
#pragma unroll
        for (int e = 0; e < 16; ++e) res[e] = c == 0 ? acc[e] * inv : res[e] - lam * acc[e] * inv;
    }
    float ss = 0.f;
#pragma unroll
    for (int e = 0; e < 16; ++e) ss += res[e] * res[e];
    ss += __shfl_xor(ss, 1); ss += __shfl_xor(ss, 2); ss += __shfl_xor(ss, 4);
    const float rstd = rsqrtf(ss * (1.f / 128.f) + EPS);
    __syncthreads();
#pragma unroll
    for (int e = 0; e < 16; ++e) AO[row * 2048 + 1024 + h * 128 + chn * 16 + e] = f2bf(res[e] * rstd * subg[chn * 16 + e] * 0.8f);
}
__global__ void __launch_bounds__(256) k_convact(const bf16_t* __restrict__ UP, int m0, const float* __restrict__ cw, const float* __restrict__ cb, bf16_t* __restrict__ ACT) {
    const int j = blockIdx.x * 256 + threadIdx.x, r = blockIdx.y; const int s = (m0 + r) % SEQ;
    float v = cb[j], g = cb[DFF + j];
#pragma unroll
    for (int k = 0; k < 3; ++k) { const int ss = s + k - 1; if (ss >= 0 && ss < SEQ) { v += cw[k * 2 * DFF + j] * bf2f(UP[(size_t)(r + k - 1) * 5632 + j]); g += cw[k * 2 * DFF + DFF + j] * bf2f(UP[(size_t)(r + k - 1) * 5632 + DFF + j]); } }
    ACT[(size_t)(m0 + r) * DFF + j] = f2bf(g / (1.f + __expf(-g)) * v);
}

#ifndef NAIVE_MASK
#define NAIVE_MASK 0x0
#endif
#ifndef ONE_LAUNCH
#define ONE_LAUNCH 0
#endif
extern "C" void kernel_launch(void* const* d_in, const int* in_sizes, int n_in, void* d_out, int out_size, void* d_ws, size_t ws_size, hipStream_t stream) {
    static int grid = 0;
    if (grid == 0) {
        if (n_in != 28 || in_sizes[0] != M * DM || out_size != M * DM || ws_size < WS_NEED) { fprintf(stderr, "kernel_launch: unexpected shapes (n_in %d, in0 %d, out %d, ws %zu); nothing launched\n", n_in, n_in > 0 ? in_sizes[0] : -1, out_size, ws_size); grid = -1; return; }
        int dev = 0, cus = 0, per_cu = 0;
        if (hipGetDevice(&dev) != hipSuccess || hipDeviceGetAttribute(&cus, hipDeviceAttributeMultiprocessorCount, dev) != hipSuccess) { grid = -1; return; }
        if (hipFuncSetAttribute((const void*)mk_fwd, hipFuncAttributeMaxDynamicSharedMemorySize, LDS_BYTES) != hipSuccess) { fprintf(stderr, "kernel_launch: hipFuncSetAttribute failed\n"); grid = -1; return; }
        if (hipOccupancyMaxActiveBlocksPerMultiprocessor(&per_cu, (const void*)mk_fwd, NWAVES * 64, LDS_BYTES) != hipSuccess || per_cu < 1) fprintf(stderr, "kernel_launch: occupancy query says %d\n", per_cu);
        (void)hipGetLastError();
        grid = cus;
        if (grid != 256) fprintf(stderr, "kernel_launch: %d CUs; built for 256\n", grid);
    }
    if (grid < 0) return;
    (void)hipMemsetAsync((char*)d_ws + WS_CTL, 0, CTL_ZERO_BYTES, stream);
    Args a{};
    for (int i = 0; i < 28; ++i) a.in[i] = d_in[i];
    a.out = (float*)d_out; a.ws = (unsigned char*)d_ws;
    int li = 0;
    auto L = [&](int lo, int hi, int flags) { a.ph_lo = lo; a.ph_hi = hi; a.li = li++; a.pad = flags; hipLaunchKernelGGL(mk_fwd, dim3(grid), dim3(NWAVES * 64), LDS_BYTES, stream, a); };
#if ONE_LAUNCH && (NAIVE_MASK == 0)
    L(0, N_PHASES, 3);
#else
    const float* x = (const float*)d_in[0]; const float* c = (const float*)d_in[1]; const int* pos = (const int*)d_in[2];
    const float* w_ada = (const float*)d_in[3]; const float* b_ada = (const float*)d_in[4]; const float* norm1_g = (const float*)d_in[5]; const float* w_in = (const float*)d_in[6];
    const float* conv_rnn_w = (const float*)d_in[7]; const float* conv_rnn_b = (const float*)d_in[8]; const float* w_rg_a = (const float*)d_in[9]; const float* b_rg_a = (const float*)d_in[10];
    const float* w_rg_i = (const float*)d_in[11]; const float* b_rg_i = (const float*)d_in[12]; const float* rg_lambda = (const float*)d_in[13]; const float* w_rnn_o = (const float*)d_in[14];
    const float* lq1 = (const float*)d_in[15]; const float* lk1 = (const float*)d_in[16]; const float* lq2 = (const float*)d_in[17]; const float* lk2 = (const float*)d_in[18];
    const float* subln_g = (const float*)d_in[19]; const float* w_attn_o = (const float*)d_in[20]; const float* w_out = (const float*)d_in[21]; const float* norm2_g = (const float*)d_in[22];
    const float* w_up = (const float*)d_in[23]; const float* conv_ffn_w = (const float*)d_in[24]; const float* conv_ffn_b = (const float*)d_in[25]; const float* w_down = (const float*)d_in[26];
    const float* final_g = (const float*)d_in[27];
    unsigned char* ws = (unsigned char*)d_ws; float* out = (float*)d_out;
    float* MOD = (float*)(ws + WS_MOD); float* COS = (float*)(ws + WS_COS); float* SIN = (float*)(ws + WS_SIN);
    bf16_t* H = (bf16_t*)(ws + WS_H); bf16_t* XR = (bf16_t*)(ws + WS_XR); bf16_t* AO = (bf16_t*)(ws + WS_AO); bf16_t* KB = (bf16_t*)(ws + WS_K); bf16_t* VB = (bf16_t*)(ws + WS_V);
    bf16_t* HF = (bf16_t*)(ws + WS_HF); bf16_t* GT = (bf16_t*)d_out; bf16_t* MG = XR; bf16_t* UP = (bf16_t*)(ws + WS_UP); bf16_t* ACT = (bf16_t*)(ws + WS_ACT);
    constexpr int NM = NAIVE_MASK;
    L(P_PRO, P_PRO + 1, 3);
    if (NM & 1) { k_mod<<<dim3(NMODC / 256, BATCH), 256, 0, stream>>>(c, w_ada, b_ada, MOD, lq1, lk1, lq2, lk2); k_rope_tab<<<M * 8 / 256, 256, 0, stream>>>(pos, COS, SIN); }
    if (NM & 2) k_normmod<<<M / 4, 256, 0, stream>>>(x, norm1_g, MOD, 0, 1024, H); else L(P_NORM1, P_NORM1 + 1, 3);
    if (NM & 4) { nv_gemm<EProj><<<dim3(INCOLS / 64, M / 64), 256, 0, stream>>>(H, DM, w_in, INCOLS, DM, EProj{XR, AO, KB, VB, GT}); k_rope<<<M * 16 / 256, 256, 0, stream>>>(AO, KB, COS, SIN); }
    else L(P_PROJ, P_PROJ + 1, 3);
    if (NM & 8) nv_rglru<<<dim3(16, BATCH), 64, 0, stream>>>(XR, AO, HF, conv_rnn_w, conv_rnn_b, w_rg_a, b_rg_a, w_rg_i, b_rg_i, rg_lambda); else L(P_MIX, P_MIX + 1, 1);
    if (NM & 16) nv_attn<<<dim3(SEQ / 32, 8, BATCH), 256, 0, stream>>>(AO, KB, VB, subln_g, MOD + BATCH * NMODC); else L(P_MIX, P_MIX + 1, 2);
    if (NM & 32) { nv_gemm<EMergeA><<<dim3(DM / 64, M / 64), 256, 0, stream>>>(AO, 2048, w_rnn_o, DM, DM, EMergeA{GT, MG}); nv_gemm<EMergeB><<<dim3(DM / 64, M / 64), 256, 0, stream>>>(AO + 1024, 2048, w_attn_o, DM, DM, EMergeB{GT, MG}); }
    else L(P_MERGE, P_MERGE + 1, 3);
    if (NM & 64) nv_gemm<EOut><<<dim3(DM / 64, M / 64), 256, 0, stream>>>(MG, DM, w_out, DM, DM, EOut{x, MOD, out}); else L(P_OUT, P_OUT + 1, 3);
    if (NM & 128) k_normmod<<<M / 4, 256, 0, stream>>>(out, norm2_g, MOD, 3072, 4096, H); else L(P_NORM2, P_NORM2 + 1, 3);
    if (NM & 256) { for (int half = 0; half < 2; ++half) { const int m0 = half * (M / 2);
            nv_gemm<EUp><<<dim3(2 * DFF / 64, M / 2 / 64), 256, 0, stream>>>(H + (size_t)m0 * DM, DM, w_up, 2 * DFF, DM, EUp{UP});
            k_convact<<<dim3(DFF / 256, M / 2), 256, 0, stream>>>(UP, m0, conv_ffn_w, conv_ffn_b, ACT); } }
    else { L(P_UP, P_UP + 1, 3); L(P_FIX, P_FIX + 1, 3); }
    if (NM & 512) nv_gemm<EDown><<<dim3(DM / 64, M / 64), 256, 0, stream>>>(ACT, DFF, w_down, DM, DFF, EDown{out, MOD}); else L(P_DOWN, P_DOWN + 1, 3);
    if (NM & 1024) k_final<<<M / 4, 256, 0, stream>>>(out, final_g); else L(P_FINAL, P_FINAL + 1, 3);
#endif
}
```

```cpp
#include <hip/hip_runtime.h>
#include <hip/hip_bf16.h>
#include <cstdint>
#include <cstdio>
#include <cmath>

namespace pg8 {
#define PG8_LAS __attribute__((address_space(3)))
typedef unsigned short bf16_t;
typedef short bf16x8 __attribute__((ext_vector_type(8)));
typedef float f32x4 __attribute__((ext_vector_type(4)));
typedef unsigned u32x4 __attribute__((ext_vector_type(4)));
constexpr int BM = 256, BK = 64, HALF = 128, HTB = HALF * BK * 2  , STAGE_BYTES = 8 * HTB, NXCD = 8, WGM = 8;

__host__ __device__ __forceinline__ int lds_byte(int r, int c) { const int st = (r >> 4) * 2 + (c >> 5), rr = r & 15, cc = c & 31, ob = rr * 64 + cc * 2; return st * 1024 + (ob ^ (((ob >> 9) & 1) << 5)); }
__host__ __device__ __forceinline__ void stage_rc(int b, int& R, int& C) { const int st = b / 1024, sb = b % 1024, swz = sb ^ (((sb >> 9) & 1) << 5); R = (st >> 1) * 16 + swz / 64; C = (st & 1) * 32 + (swz % 64) / 2; }
__host__ __device__ __forceinline__ int perm32(int rho) { const int n = rho >> 4, i = rho & 15; return 8 * (i >> 2) + 4 * n + (i & 3); }

struct Unit { int pm, pn; };
struct Gemm { const bf16_t* A; const bf16_t* Bt; int M, N, K, lda; };

struct StaticOrder {
    int nM, nN, nwg, G, c;
    __host__ __device__ void init(int M, int N, int G_, int c_) { nM = M / BM; nN = N / BM; nwg = nM * nN; G = G_; c = c_; }
    __host__ __device__ bool next(int i, Unit& u) const {
        const long L = (long)i * G + c; if (L >= nwg) return false;
        int wgid = (int)L; { const int q = nwg / NXCD, r = nwg % NXCD, xcd = wgid % NXCD, off = wgid / NXCD; wgid = (xcd < r ? xcd * (q + 1) : r * (q + 1) + (xcd - r) * q) + off; }
        const int nig = WGM * nN, gid = wgid / nig, fm = gid * WGM, gsz = (nM - fm) < WGM ? (nM - fm) : WGM;
        u.pm = fm + ((wgid % nig) % gsz); u.pn = (wgid % nig) / gsz; return true;
    }
    __device__ __forceinline__ void a_ready(const Unit&) const {}
    __device__ __forceinline__ void done(const Unit&) const {}
};

__device__ __forceinline__ unsigned cvt_pk_bf16(float lo, float hi) { unsigned r; asm volatile("v_cvt_pk_bf16_f32 %0, %1, %2" : "=v"(r) : "v"(lo), "v"(hi)); return r; }
template <class Epi, class Sched, bool ALIGN_EPI = false, bool SP2 = false>
__device__ __forceinline__ void gemm_phase(PG8_LAS unsigned char* lds, const Gemm g, const Sched& S, const Epi& E) {
    const int tid = threadIdx.x, wid = __builtin_amdgcn_readfirstlane(tid >> 6), lane = tid & 63, wr = wid >> 2, wc = wid & 3, fr = lane & 15, fq = lane >> 4;
    const int K = g.K, nt = K / BK;
    unsigned voffA[2], voffB[2];
#pragma unroll
    for (int i = 0; i < 2; ++i) { int R, C; stage_rc(tid * 16 + i * 8192, R, C); const int Rb = Epi::PERM ? ((R & ~31) + perm32(R & 31)) : R;
        voffA[i] = (unsigned)(R * g.lda + C) * 2u; voffB[i] = (unsigned)(Rb * K + C) * 2u; }
    const size_t kstep = (size_t)(BK * 2);
    const size_t hstepB = (size_t)HALF * K * 2, hstepA = (size_t)HALF * g.lda * 2;
    const size_t tstepA = 2 * hstepA, tstepB = 2 * hstepB;
    const unsigned ldsw = (unsigned)wid * 1024u;
    const int aoff = lds_byte(wr * 64 + fr, fq * 8), boff = lds_byte(wc * 32 + fr, fq * 8);
#define PG8_SA(b, h) (((b) * 2 + (h)) * HTB)
#define PG8_SB(b, h) ((4 + (b) * 2 + (h)) * HTB)
#define PG8_STAGE(bufoff, gbase, voff) do { _Pragma("unroll") for (int _i = 0; _i < 2; ++_i) \
        __builtin_amdgcn_global_load_lds((const unsigned*)((const char*)(gbase) + (voff)[_i]), (PG8_LAS unsigned*)(lds + (bufoff) + ldsw + _i * 8192), 16, 0, 0); } while (0)
#define PG8_LDA(dst, b, h) do { _Pragma("unroll") for (int m = 0; m < 4; ++m) _Pragma("unroll") for (int k = 0; k < 2; ++k) dst[m][k] = *(const PG8_LAS bf16x8*)(lds + PG8_SA(b, h) + aoff + m * 2048 + k * 1024); } while (0)
#define PG8_LDB(dst, b, h) do { _Pragma("unroll") for (int n = 0; n < 2; ++n) _Pragma("unroll") for (int k = 0; k < 2; ++k) dst[n][k] = *(const PG8_LAS bf16x8*)(lds + PG8_SB(b, h) + boff + n * 2048 + k * 1024); } while (0)
#define PG8_MMA(ai, bj, At, Bt) do { __builtin_amdgcn_s_setprio(1); _Pragma("unroll") for (int m = 0; m < 4; ++m) _Pragma("unroll") for (int n = 0; n < 2; ++n) _Pragma("unroll") for (int k = 0; k < 2; ++k) \
        acc[ai][bj][m][n] = __builtin_amdgcn_mfma_f32_16x16x32_bf16(Bt[n][k], At[m][k], acc[ai][bj][m][n], 0, 0, 0); __builtin_amdgcn_s_setprio(0); } while (0)
#define PG8_WAIT_V(n) asm volatile("s_waitcnt vmcnt(" #n ")" ::: "memory")
#define PG8_WAIT_L(n) asm volatile("s_waitcnt lgkmcnt(" #n ")" ::: "memory")
#define PG8_BAR __builtin_amdgcn_s_barrier()
#define PG8_SCHED __builtin_amdgcn_sched_barrier(0)
    Unit cur, nxt; int ui = 0;
    if (!S.next(0, cur)) return;
    f32x4 acc[2][2][4][2];
#pragma unroll
    for (int a = 0; a < 2; ++a)
#pragma unroll
        for (int b = 0; b < 2; ++b)
#pragma unroll
            for (int m = 0; m < 4; ++m)
#pragma unroll
                for (int n = 0; n < 2; ++n) acc[a][b][m][n] = (f32x4){0.f, 0.f, 0.f, 0.f};
    bf16x8 At[4][2], B0[2][2], B1[2][2];
    const char* cA = (const char*)g.A + (size_t)cur.pm * tstepA; const char* cB = (const char*)g.Bt + (size_t)cur.pn * tstepB;
    S.a_ready(cur);
    if constexpr (SP2) {
        PG8_STAGE(PG8_SB(0, 0), cB, voffB); PG8_STAGE(PG8_SB(0, 1), cB + hstepB, voffB); PG8_STAGE(PG8_SA(0, 0), cA, voffA); PG8_STAGE(PG8_SA(0, 1), cA + hstepA, voffA);
        if (wr == 1) PG8_BAR;
        PG8_WAIT_V(2); PG8_BAR;
        PG8_STAGE(PG8_SB(1, 0), cB + kstep, voffB); PG8_STAGE(PG8_SA(1, 0), cA + kstep, voffA); PG8_STAGE(PG8_SB(1, 1), cB + hstepB + kstep, voffB);
        PG8_WAIT_V(6); PG8_BAR;
    } else {
        PG8_STAGE(PG8_SB(0, 0), cB, voffB); PG8_STAGE(PG8_SA(0, 0), cA, voffA); PG8_STAGE(PG8_SB(0, 1), cB + hstepB, voffB); PG8_STAGE(PG8_SA(0, 1), cA + hstepA, voffA);
        if (wr == 1) PG8_BAR;
        PG8_WAIT_V(4); PG8_BAR;
        PG8_STAGE(PG8_SB(1, 0), cB + kstep, voffB); PG8_STAGE(PG8_SA(1, 0), cA + kstep, voffA); PG8_STAGE(PG8_SB(1, 1), cB + hstepB + kstep, voffB);
        PG8_WAIT_V(6); PG8_BAR;
    }
    for (;;) {
        const bool has_next = S.next(ui + 1, nxt);
        const char* nA = has_next ? (const char*)g.A + (size_t)nxt.pm * tstepA : cA; const char* nB = has_next ? (const char*)g.Bt + (size_t)nxt.pn * tstepB : cB;
        for (int t = 0; t < nt; t += 2) {
            const bool last = (t == nt - 2);
            const char* a1 = cA + (size_t)(t + 1) * kstep;
            const char* a2 = last ? nA : cA + (size_t)(t + 2) * kstep; const char* b2 = last ? nB : cB + (size_t)(t + 2) * kstep;
            const char* a3 = a2 + kstep; const char* b3 = b2 + kstep;
            if (last && has_next) S.a_ready(nxt);
            if constexpr (SP2) {
            PG8_LDB(B0, 0, 0); PG8_LDB(B1, 0, 1); PG8_SCHED; PG8_LDA(At, 0, 0); PG8_STAGE(PG8_SA(1, 1), a1 + hstepA, voffA);
            PG8_WAIT_V(8); PG8_WAIT_L(0); PG8_BAR; PG8_MMA(0, 0, At, B0); PG8_MMA(0, 1, At, B1); PG8_BAR; PG8_SCHED;
            PG8_LDA(At, 0, 1); PG8_STAGE(PG8_SB(0, 0), b2, voffB); PG8_STAGE(PG8_SB(0, 1), b2 + hstepB, voffB); PG8_STAGE(PG8_SA(0, 0), a2, voffA);
            PG8_WAIT_V(8); PG8_WAIT_L(0); PG8_BAR; PG8_MMA(1, 0, At, B0); PG8_MMA(1, 1, At, B1); PG8_BAR; PG8_SCHED;
            PG8_LDB(B0, 1, 0); PG8_LDB(B1, 1, 1); PG8_SCHED; PG8_LDA(At, 1, 0); PG8_STAGE(PG8_SA(0, 1), a2 + hstepA, voffA);
            PG8_WAIT_V(8); PG8_WAIT_L(0); PG8_BAR; PG8_MMA(0, 0, At, B0); PG8_MMA(0, 1, At, B1); PG8_BAR; PG8_SCHED;
            PG8_LDA(At, 1, 1); PG8_STAGE(PG8_SB(1, 0), b3, voffB); PG8_STAGE(PG8_SB(1, 1), b3 + hstepB, voffB); PG8_STAGE(PG8_SA(1, 0), a3, voffA);
            PG8_WAIT_V(8); PG8_WAIT_L(0); PG8_BAR; PG8_MMA(1, 0, At, B0); PG8_MMA(1, 1, At, B1); PG8_BAR; PG8_SCHED;
            } else {
            PG8_LDB(B0, 0, 0); PG8_SCHED; PG8_LDA(At, 0, 0); PG8_STAGE(PG8_SA(1, 1), a1 + hstepA, voffA);
            PG8_WAIT_L(8); PG8_BAR; PG8_WAIT_L(0); PG8_MMA(0, 0, At, B0); PG8_BAR; PG8_SCHED;
            PG8_LDB(B1, 0, 1); PG8_STAGE(PG8_SB(0, 0), b2, voffB);
            PG8_BAR; PG8_WAIT_L(0); PG8_MMA(0, 1, At, B1); PG8_BAR;
            PG8_LDA(At, 0, 1); PG8_STAGE(PG8_SA(0, 0), a2, voffA);
            PG8_BAR; PG8_WAIT_L(0); PG8_MMA(1, 0, At, B0); PG8_BAR; PG8_SCHED;
            PG8_STAGE(PG8_SB(0, 1), b2 + hstepB, voffB);
            PG8_WAIT_V(6); PG8_BAR; PG8_MMA(1, 1, At, B1); PG8_BAR;
            PG8_LDB(B0, 1, 0); PG8_SCHED; PG8_LDA(At, 1, 0); PG8_STAGE(PG8_SA(0, 1), a2 + hstepA, voffA);
            PG8_WAIT_L(8); PG8_BAR; PG8_WAIT_L(0); PG8_MMA(0, 0, At, B0); PG8_BAR; PG8_SCHED;
            PG8_LDB(B1, 1, 1); PG8_STAGE(PG8_SB(1, 0), b3, voffB);
            PG8_BAR; PG8_WAIT_L(0); PG8_MMA(0, 1, At, B1); PG8_BAR;
            PG8_LDA(At, 1, 1); PG8_STAGE(PG8_SA(1, 0), a3, voffA);
            PG8_BAR; PG8_WAIT_L(0); PG8_MMA(1, 0, At, B0); PG8_BAR; PG8_SCHED;
            PG8_STAGE(PG8_SB(1, 1), b3 + hstepB, voffB);
            PG8_WAIT_V(6); PG8_BAR; PG8_MMA(1, 1, At, B1); PG8_BAR;
            }
        }
        if constexpr (ALIGN_EPI) { if (wr == 0) PG8_BAR; }
        if constexpr (!Epi::AFTER_DRAIN) { E(acc, cur, wr, wc, fr, fq); S.done(cur); }
        if (!has_next) break;
#pragma unroll
        for (int a = 0; a < 2; ++a)
#pragma unroll
            for (int b = 0; b < 2; ++b)
#pragma unroll
                for (int m = 0; m < 4; ++m)
#pragma unroll
                    for (int n = 0; n < 2; ++n) acc[a][b][m][n] = (f32x4){0.f, 0.f, 0.f, 0.f};
        cur = nxt; cA = nA; cB = nB; ++ui;
        if constexpr (ALIGN_EPI) { if (wr == 1) PG8_BAR; }
    }
    PG8_WAIT_V(0);
    if constexpr (!ALIGN_EPI) { if (wr == 0) PG8_BAR; }
    PG8_BAR;
    if constexpr (Epi::AFTER_DRAIN) { E.fused(acc, cur, wr, wc, fr, fq, lds, wid, lane); S.done(cur); }
#undef PG8_SA
#undef PG8_SB
#undef PG8_STAGE
#undef PG8_LDA
#undef PG8_LDB
#undef PG8_MMA
#undef PG8_WAIT_V
#undef PG8_WAIT_L
#undef PG8_BAR
#undef PG8_SCHED
}
}
#ifndef PG8_SP2
#define PG8_SP2 true
#endif
#ifndef PG8_ALIGN
#define PG8_ALIGN true
#endif

typedef unsigned short bf16_t;
constexpr int DM = 1024, BATCH = 16, SEQ = 2048, M = BATCH * SEQ, INCOLS = 7168, DFF = 2816, NMODC = 6 * DM;
constexpr float EPS = 1e-6f;
constexpr float C2 = 0.125f * 1.4426950408889634f;
constexpr size_t MiB = 1u << 20;
constexpr size_t WS_CTL = 0, CTL_ZERO_BYTES = 1 * MiB;
constexpr size_t WS_MOD = 1 * MiB, WS_COS = 2 * MiB, WS_SIN = 3 * MiB;
constexpr size_t WS_WIN = 4 * MiB, WS_WA = 18 * MiB, WS_WB = 20 * MiB, WS_WOUT = 22 * MiB, WS_WUP = 24 * MiB, WS_WDOWN = 35 * MiB;
constexpr size_t WS_H = 48 * MiB, WS_XR = 112 * MiB, WS_AO = 176 * MiB, WS_K = 304 * MiB, WS_V = 368 * MiB, WS_HF = 432 * MiB;
constexpr size_t WS_UP = 112 * MiB, WS_ACT = 288 * MiB, WS_EDGE = 112 * MiB;
constexpr size_t WS_NEED = 512 * MiB;
constexpr int CW_TMO = 0, CW_CODE = 1, CW_BAR = 4096;

constexpr int NWAVES = 8;
constexpr int RING_OFF = 0, RING_BYTES = 131072, LDSCTL_OFF = RING_BYTES, MISC_OFF = LDSCTL_OFF + 320, LDS_BYTES = 147456;

#define GAS __attribute__((address_space(1)))
#define LAS __attribute__((address_space(3)))
typedef unsigned v4u __attribute__((ext_vector_type(4)));
typedef unsigned v2u __attribute__((ext_vector_type(2)));
typedef float f32x4 __attribute__((ext_vector_type(4)));
typedef float f32x2 __attribute__((ext_vector_type(2)));
typedef short bf16x8 __attribute__((ext_vector_type(8)));
typedef GAS unsigned gu32;
#define RLX_AGENT __ATOMIC_RELAXED, __HIP_MEMORY_SCOPE_AGENT
#define LDS_WAIT() asm volatile("s_waitcnt lgkmcnt(0)" ::: "memory")
#define VM_WAIT() asm volatile("s_waitcnt vmcnt(0)" ::: "memory")

__device__ __forceinline__ float bf2f(bf16_t v) { return __uint_as_float((unsigned)v << 16); }
__device__ __forceinline__ unsigned f2bfu(float f) { unsigned u = __float_as_uint(f); return (u + 0x7fffu + ((u >> 16) & 1u)) >> 16; }
__device__ __forceinline__ bf16_t f2bf(float f) { return (bf16_t)f2bfu(f); }
__device__ __forceinline__ unsigned pk2(float lo, float hi) { return pg8::cvt_pk_bf16(lo, hi); }
__device__ __forceinline__ float lo_bf(unsigned w) { return __uint_as_float(w << 16); }
__device__ __forceinline__ float hi_bf(unsigned w) { return __uint_as_float(w & 0xffff0000u); }
__device__ __forceinline__ float fexp(float x) { return __builtin_amdgcn_exp2f(x * 1.4426950408889634f); }
__device__ __forceinline__ float frcp(float x) { return __builtin_amdgcn_rcpf(x); }
__device__ __forceinline__ float sigmoidf_(float x) { return frcp(1.f + fexp(-x)); }
__device__ __forceinline__ float gelu_tanh(float x) { const float u = 1.5957691216057308f * (x + 0.044715f * x * x * x); return x * frcp(1.f + fexp(-u)); }
__device__ __forceinline__ float wave_sum(float v) {
#pragma unroll
    for (int o = 1; o < 64; o <<= 1) v += __shfl_xor(v, o);
    return v;
}
typedef pg8::f32x4 (&AccRef)[2][2][4][2];
typedef const pg8::f32x4 (&AccCRef)[2][2][4][2];

struct EpiProj {
    static constexpr bool PERM = true, AFTER_DRAIN = false;
    bf16_t *XR, *AO, *KB, *VB, *GT; const float *COS, *SIN;
    __device__ __forceinline__ void operator()(AccCRef acc, const pg8::Unit& u, int wr, int wc, int fr, int fq) const {
        const int pn = u.pn; bf16_t* base; int ldc, colt; float sc = 1.f; bool rope = false;
        if (pn < 4) { base = XR; ldc = 1024; colt = pn * 256; }
        else if (pn < 8) { base = AO; ldc = 2048; colt = (pn - 4) * 256; }
        else if (pn < 12) { base = AO + 1024; ldc = 2048; colt = (pn - 8) * 256; sc = C2; rope = true; }
        else if (pn < 16) { base = KB; ldc = 1024; colt = (pn - 12) * 256; rope = true; }
        else if (pn < 20) { base = VB; ldc = 1024; colt = (pn - 16) * 256; }
        else { base = GT; ldc = 2048; colt = (pn - 20) * 256; }
        const bool dorope = rope && ((wc & 1) == 0);
        const int row0 = u.pm * 256 + wr * 64 + fr, col0 = colt + wc * 32 + 8 * fq;
#pragma unroll
        for (int ai = 0; ai < 2; ++ai)
#pragma unroll
            for (int m = 0; m < 4; ++m) {
                const int row = row0 + ai * 128 + m * 16;
                f32x4 c0 = {1.f, 1.f, 1.f, 1.f}, c1 = c0, s0 = {0.f, 0.f, 0.f, 0.f}, s1 = s0;
                if (dorope) { c0 = *(const f32x4*)(COS + (size_t)row * 8); c1 = *(const f32x4*)(COS + (size_t)row * 8 + 4); s0 = *(const f32x4*)(SIN + (size_t)row * 8); s1 = *(const f32x4*)(SIN + (size_t)row * 8 + 4);
                    if (fq == 0) { s0 = -s0; s1 = -s1; } if (fq >= 2) { c0 = (f32x4){1.f, 1.f, 1.f, 1.f}; c1 = c0; s0 = (f32x4){0.f, 0.f, 0.f, 0.f}; s1 = s0; } }
#pragma unroll
                for (int bj = 0; bj < 2; ++bj) {
                    f32x4 v0 = acc[ai][bj][m][0], v1 = acc[ai][bj][m][1];
                    if (dorope) { f32x4 p0, p1;
#pragma unroll
                        for (int e = 0; e < 4; ++e) { p0[e] = __shfl_xor(v0[e], 16); p1[e] = __shfl_xor(v1[e], 16); }
                        v0 = v0 * c0 + p0 * s0; v1 = v1 * c1 + p1 * s1; }
                    v0 = v0 * sc; v1 = v1 * sc;
                    v4u w; w.x = pk2(v0[0], v0[1]); w.y = pk2(v0[2], v0[3]); w.z = pk2(v1[0], v1[1]); w.w = pk2(v1[2], v1[3]);
                    *(v4u*)(base + (size_t)row * ldc + col0 + bj * 128) = w;
                }
            }
    }
};
template <int STEP> struct EpiMerge {
    static constexpr bool PERM = true, AFTER_DRAIN = false;
    const bf16_t* GT; bf16_t* MG;
    __device__ __forceinline__ void operator()(AccCRef acc, const pg8::Unit& u, int wr, int wc, int fr, int fq) const {
        const int row0 = u.pm * 256 + wr * 64 + fr, col0 = u.pn * 256 + wc * 32 + 8 * fq;
#pragma unroll
        for (int ai = 0; ai < 2; ++ai)
#pragma unroll
            for (int m = 0; m < 4; ++m) {
                const int row = row0 + ai * 128 + m * 16;
#pragma unroll
                for (int bj = 0; bj < 2; ++bj) {
                    const v4u g = *(const v4u*)(GT + (size_t)row * 2048 + STEP * 1024 + col0 + bj * 128);
                    const f32x4 v0 = acc[ai][bj][m][0], v1 = acc[ai][bj][m][1];
                    float o[8];
                    o[0] = sigmoidf_(lo_bf(g.x)) * v0[0]; o[1] = sigmoidf_(hi_bf(g.x)) * v0[1]; o[2] = sigmoidf_(lo_bf(g.y)) * v0[2]; o[3] = sigmoidf_(hi_bf(g.y)) * v0[3];
                    o[4] = sigmoidf_(lo_bf(g.z)) * v1[0]; o[5] = sigmoidf_(hi_bf(g.z)) * v1[1]; o[6] = sigmoidf_(lo_bf(g.w)) * v1[2]; o[7] = sigmoidf_(hi_bf(g.w)) * v1[3];
                    bf16_t* dst = MG + (size_t)row * 1024 + col0 + bj * 128;
                    if (STEP == 1) { const v4u p = *(const v4u*)dst; o[0] += lo_bf(p.x); o[1] += hi_bf(p.x); o[2] += lo_bf(p.y); o[3] += hi_bf(p.y); o[4] += lo_bf(p.z); o[5] += hi_bf(p.z); o[6] += lo_bf(p.w); o[7] += hi_bf(p.w); }
                    v4u w; w.x = pk2(o[0], o[1]); w.y = pk2(o[2], o[3]); w.z = pk2(o[4], o[5]); w.w = pk2(o[6], o[7]);
                    *(v4u*)dst = w;
                }
            }
    }
};
struct EpiResid {
    static constexpr bool PERM = false, AFTER_DRAIN = false;
    const float* RES; float* OUT; const float* gate;
    __device__ __forceinline__ void operator()(AccCRef acc, const pg8::Unit& u, int wr, int wc, int fr, int fq) const {
        const int row0 = u.pm * 256 + wr * 64 + fr, col0 = u.pn * 256 + wc * 32 + 4 * fq; const float* gb = gate + (size_t)(u.pm >> 3) * NMODC;
        f32x4 gv[2][2];
#pragma unroll
        for (int bj = 0; bj < 2; ++bj)
#pragma unroll
            for (int n = 0; n < 2; ++n) gv[bj][n] = *(const f32x4*)(gb + col0 + bj * 128 + n * 16);
#pragma unroll
        for (int ai = 0; ai < 2; ++ai)
#pragma unroll
            for (int m = 0; m < 4; ++m) { const size_t off = (size_t)(row0 + ai * 128 + m * 16) * 1024 + col0;
#pragma unroll
                for (int bj = 0; bj < 2; ++bj)
#pragma unroll
                    for (int n = 0; n < 2; ++n) { const f32x4 r = *(const f32x4*)(RES + off + bj * 128 + n * 16); *(f32x4*)(OUT + off + bj * 128 + n * 16) = r + gv[bj][n] * acc[ai][bj][m][n]; }
                if (m & 1) asm volatile("" ::: "memory"); }
    }
};
template <int CTRL> __device__ __forceinline__ float dpp_rot(float v) { return __uint_as_float((unsigned)__builtin_amdgcn_update_dpp(0, (int)__float_as_uint(v), CTRL, 0xf, 0xf, false)); }
struct EpiUpConv {
    static constexpr bool PERM = true, AFTER_DRAIN = false;
    bf16_t* ACT; float* EDGE; const float* cw; const float* cb;
    __device__ __forceinline__ void operator()(AccCRef acc, const pg8::Unit& u, int wr, int wc, int fr, int fq) const {
        const int jj = wc * 32 + 8 * fq, j = u.pn * 128 + jj;
        const int pc = u.pn * 256 + jj;
#pragma unroll
        for (int ai = 0; ai < 2; ++ai) {
            const int band = u.pm * 4 + ai * 2 + wr; const int rowb = band * 64;
            if (fr < 2) {
#pragma unroll
                for (int bj = 0; bj < 2; ++bj)
#pragma unroll
                    for (int n = 0; n < 2; ++n) *(f32x4*)(EDGE + ((size_t)band * 4 + fr) * 5632 + pc + bj * 128 + 4 * n) = acc[ai][bj][0][n];
            }
            if (fr >= 14) {
#pragma unroll
                for (int bj = 0; bj < 2; ++bj)
#pragma unroll
                    for (int n = 0; n < 2; ++n) *(f32x4*)(EDGE + ((size_t)band * 4 + fr - 12) * 5632 + pc + bj * 128 + 4 * n) = acc[ai][bj][3][n];
            }
#pragma unroll
            for (int n = 0; n < 2; ++n) {
                float oe[4][4];
#pragma unroll
                for (int e = 0; e < 4; ++e) {
                    float vv[4];
#pragma unroll
                    for (int bj = 0; bj < 2; ++bj) {
                        const int oc = bj * DFF + j + 4 * n + e;
                        const float w0 = cw[oc], w1 = cw[2 * DFF + oc], w2 = cw[4 * DFF + oc], bs = cb[oc];
#pragma unroll
                        for (int m = 0; m < 4; ++m) {
                            const float cur = acc[ai][bj][m][n][e], pvs = acc[ai][bj][m > 0 ? m - 1 : 0][n][e], nxs = acc[ai][bj][m < 3 ? m + 1 : 3][n][e];
                            const float a = dpp_rot<0x121>(cur), b = dpp_rot<0x121>(pvs), c = dpp_rot<0x12F>(cur), d = dpp_rot<0x12F>(nxs);
                            const float pv = fr == 0 ? b : a, nx = fr == 15 ? d : c;
                            const float r = bs + w0 * pv + w1 * cur + w2 * nx;
                            if (bj == 0) vv[m] = r; else oe[m][e] = r * frcp(1.f + fexp(-r)) * vv[m];
                        }
                    }
                }
#pragma unroll
                for (int m = 0; m < 4; ++m) {
                    const bool skip = (m == 0 && fr == 0) || (m == 3 && fr == 15);
                    v2u w; w.x = pk2(oe[m][0], oe[m][1]); w.y = pk2(oe[m][2], oe[m][3]);
                    if (!skip) *(v2u*)(ACT + (size_t)(rowb + m * 16 + fr) * DFF + j + 4 * n) = w;
                }
                asm volatile("" ::: "memory");
            }
        }
    }
};
namespace att {
using bf16x8 = __attribute__((ext_vector_type(8))) short;
using s16x4  = __attribute__((ext_vector_type(4))) short;
using f32x16 = __attribute__((ext_vector_type(16))) float;
using u32x4  = __attribute__((ext_vector_type(4))) unsigned;
constexpr int KVBLK = 64, LDK = 1024, LDQ = 2048;
constexpr int SHM_V = 64 * 128 * 2, SHM_K = 64 * 128 * 2, WS_OFF = 2 * SHM_V + 2 * SHM_K, LDS_BYTES = WS_OFF + 8 * 64 * 4;
constexpr float THR2 = 6.0f;
#define KSWZ(row, colB) ((row) * 256 + ((colB) ^ (((row) & 7) << 4)))
#define SBAR() __builtin_amdgcn_sched_barrier(0)
__device__ __forceinline__ int crow(int r, int hi) { return (r & 3) + 8 * (r >> 2) + 4 * hi; }
__device__ __forceinline__ unsigned cvtpk(float lo, float hi) { unsigned r; asm volatile("v_cvt_pk_bf16_f32 %0, %1, %2" : "=v"(r) : "v"(lo), "v"(hi)); return r; }
__device__ __forceinline__ void partialSM(f32x16& p0, f32x16& p1, float& m_reg, float& alpha) {
    float pmax = p0[0];
#pragma unroll
    for (int r = 1; r < 16; ++r) pmax = fmaxf(pmax, p0[r]);
#pragma unroll
    for (int r = 0; r < 16; ++r) pmax = fmaxf(pmax, p1[r]);
    { auto rr = __builtin_amdgcn_permlane32_swap(__float_as_uint(pmax), __float_as_uint(pmax), false, false); pmax = fmaxf(__uint_as_float(rr[0]), __uint_as_float(rr[1])); }
    float mn;
    if (__builtin_expect(__all(pmax - m_reg <= THR2), 1)) { mn = m_reg; alpha = 1.f; }
    else { mn = fmaxf(m_reg, pmax); alpha = __builtin_amdgcn_exp2f(m_reg - mn); m_reg = mn; }
#pragma unroll
    for (int r = 0; r < 16; ++r) { p0[r] -= mn; p1[r] -= mn; }
#pragma unroll
    for (int r = 0; r < 16; ++r) p0[r] = __builtin_amdgcn_exp2f(p0[r]);
}
__device__ __forceinline__ void finishSM(f32x16& p0, f32x16& p1, float alpha, float& l_reg, bf16x8& pa0, bf16x8& pa1, bf16x8& pa2, bf16x8& pa3) {
#pragma unroll
    for (int r = 0; r < 16; ++r) p1[r] = __builtin_amdgcn_exp2f(p1[r]);
    float ps = 0;
#pragma unroll
    for (int r = 0; r < 16; ++r) ps += p0[r];
#pragma unroll
    for (int r = 0; r < 16; ++r) ps += p1[r];
    { auto rr = __builtin_amdgcn_permlane32_swap(__float_as_uint(ps), __float_as_uint(ps), false, false); ps = __uint_as_float(rr[0]) + __uint_as_float(rr[1]); }
    l_reg = l_reg * alpha + ps;
#define PK4(P, BASE, OUT) do { unsigned a0 = cvtpk(P[BASE + 0], P[BASE + 1]), a1 = cvtpk(P[BASE + 2], P[BASE + 3]);   \
    unsigned b0 = cvtpk(P[BASE + 4], P[BASE + 5]), b1 = cvtpk(P[BASE + 6], P[BASE + 7]);                              \
    auto r0 = __builtin_amdgcn_permlane32_swap(a0, b0, false, false); auto r1 = __builtin_amdgcn_permlane32_swap(a1, b1, false, false); \
    u32x4 w = {r0[0], r1[0], r0[1], r1[1]}; OUT = *reinterpret_cast<bf16x8*>(&w); } while (0)
    PK4(p0, 0, pa0); PK4(p0, 8, pa1); PK4(p1, 0, pa2); PK4(p1, 8, pa3);
#undef PK4
}
__device__ __forceinline__ void qkt(f32x16& p0, f32x16& p1, const char* Ks, const bf16x8* qr, int c, int r32, int hi) {
    p0 = f32x16{}; p1 = f32x16{};
#pragma unroll
    for (int d0 = 0; d0 < 4; ++d0) { const int cb = ((c * 4 + d0) * 16 + hi * 8) * 2;
        const bf16x8 b0 = *reinterpret_cast<const bf16x8*>(Ks + KSWZ(r32, cb));
        const bf16x8 b1 = *reinterpret_cast<const bf16x8*>(Ks + KSWZ(32 + r32, cb));
        p0 = __builtin_amdgcn_mfma_f32_32x32x16_bf16(b0, qr[d0], p0, 0, 0, 0);
        p1 = __builtin_amdgcn_mfma_f32_32x32x16_bf16(b1, qr[d0], p1, 0, 0, 0); }
}
__device__ __forceinline__ int v_st(int k, int c) { const int kk = (k & ~0xC) | ((k & 4) << 1) | ((k & 8) >> 1); return ((kk >> 3) * 4 + (c >> 5)) * 512 + ((kk & 7) * 32 + (c & 31)) * 2; }
__device__ __forceinline__ int v_rd_base(int lane) { return ((lane & 3) << 3) | (((lane >> 2) & 3) << 6) | (((lane >> 4) & 1) << 5) | (((lane >> 5) & 1) << 8); }
constexpr int v_rd_off(int d0, int ks, int half) { return d0 * 512 + ks * 4096 + half * 2048; }
template <int OFF> __device__ __forceinline__ s16x4 tr_read(int vb) { s16x4 r; asm volatile("ds_read_b64_tr_b16 %0, %1 offset:%2" : "=&v"(r) : "v"(vb), "i"(OFF) : "memory"); return r; }
template <int D0> __device__ __forceinline__ void pv_one(f32x16& od, int vb, bf16x8 pa0, bf16x8 pa1, bf16x8 pa2, bf16x8 pa3) {
    const s16x4 l0 = tr_read<v_rd_off(D0, 0, 0)>(vb), h0 = tr_read<v_rd_off(D0, 0, 1)>(vb), l1 = tr_read<v_rd_off(D0, 1, 0)>(vb), h1 = tr_read<v_rd_off(D0, 1, 1)>(vb);
    const s16x4 l2 = tr_read<v_rd_off(D0, 2, 0)>(vb), h2 = tr_read<v_rd_off(D0, 2, 1)>(vb), l3 = tr_read<v_rd_off(D0, 3, 0)>(vb), h3 = tr_read<v_rd_off(D0, 3, 1)>(vb);
    asm volatile("s_waitcnt lgkmcnt(0)" ::: "memory"); SBAR();
#define PK(L, H) (bf16x8){L[0], L[1], L[2], L[3], H[0], H[1], H[2], H[3]}
    od = __builtin_amdgcn_mfma_f32_32x32x16_bf16(pa0, PK(l0, h0), od, 0, 0, 0);
    od = __builtin_amdgcn_mfma_f32_32x32x16_bf16(pa1, PK(l1, h1), od, 0, 0, 0);
    od = __builtin_amdgcn_mfma_f32_32x32x16_bf16(pa2, PK(l2, h2), od, 0, 0, 0);
    od = __builtin_amdgcn_mfma_f32_32x32x16_bf16(pa3, PK(l3, h3), od, 0, 0, 0);
#undef PK
}
__device__ __forceinline__ void pv_d0(f32x16* o, int vb, bf16x8 pa0, bf16x8 pa1, bf16x8 pa2, bf16x8 pa3) {
    pv_one<0>(o[0], vb, pa0, pa1, pa2, pa3); pv_one<1>(o[1], vb, pa0, pa1, pa2, pa3); pv_one<2>(o[2], vb, pa0, pa1, pa2, pa3); pv_one<3>(o[3], vb, pa0, pa1, pa2, pa3);
}
__device__ __forceinline__ void attn_unit(int b, int h, int qb, bf16_t* AO, const bf16_t* __restrict__ KB, const bf16_t* __restrict__ VB, float lam, const float* __restrict__ subg, char* lds) {
    const int tid = threadIdx.x, wid = tid >> 6, lane = tid & 63, r32 = lane & 31, hi = lane >> 5, c = wid >> 2, wq = wid & 3;
    char* V_lds = lds; char* K_lds = lds + 2 * SHM_V;
    float* ws = (float*)(lds + WS_OFF) + wid * 64; float* li_l = ws; float* al_l = ws + 32;
    const size_t rowbase = (size_t)b * SEQ; const int q0 = qb * 128;
    float m_reg = -1e30f, l_reg = 0; f32x16 o[4] = {}; bf16x8 qr[4];
    bf16_t* Qrow = AO + (rowbase + q0 + wq * 32) * LDQ + 1024 + h * 128;
    { const bf16_t* Qw = Qrow + (size_t)r32 * LDQ + c * 64 + hi * 8;
#pragma unroll
      for (int d0 = 0; d0 < 4; ++d0) qr[d0] = *reinterpret_cast<const bf16x8*>(Qw + d0 * 16); }
    const bf16_t* Kh = KB + rowbase * LDK + h * 128; const bf16_t* Vh = VB + rowbase * LDK + h * 128;
    const int sr = tid >> 4, sc = (tid & 15) * 8, vst0 = v_st(sr, sc), vst1 = v_st(32 + sr, sc);
    const int vb0 = (int)(uintptr_t)V_lds + v_rd_base(lane);
    struct { bf16x8 vs0, vs1, ks0, ks1; } sr_[1];
#define SLOAD(i, k0) do { sr_[i].vs0 = *reinterpret_cast<const bf16x8*>(&Vh[(size_t)((k0) + sr) * LDK + sc]); sr_[i].vs1 = *reinterpret_cast<const bf16x8*>(&Vh[(size_t)((k0) + 32 + sr) * LDK + sc]); \
    sr_[i].ks0 = *reinterpret_cast<const bf16x8*>(&Kh[(size_t)((k0) + sr) * LDK + sc]); sr_[i].ks1 = *reinterpret_cast<const bf16x8*>(&Kh[(size_t)((k0) + 32 + sr) * LDK + sc]); } while (0)
#define SWRITE(bf, i) do { *(bf16x8*)(V_lds + (bf) * SHM_V + vst0) = sr_[i].vs0; *(bf16x8*)(V_lds + (bf) * SHM_V + vst1) = sr_[i].vs1; const int kc = sc * 2; \
    *(bf16x8*)(K_lds + (bf) * SHM_K + KSWZ(sr, kc)) = sr_[i].ks0; *(bf16x8*)(K_lds + (bf) * SHM_K + KSWZ(32 + sr, kc)) = sr_[i].ks1; } while (0)
#define SWAIT() asm volatile("s_waitcnt vmcnt(0)" ::: "memory")
#define RESC(a) do { if (__any((a) < 1.f)) { if (hi == 0) al_l[r32] = (a); asm volatile("s_waitcnt lgkmcnt(0)" ::: "memory"); \
    _Pragma("unroll") for (int d = 0; d < 4; ++d) _Pragma("unroll") for (int r = 0; r < 16; ++r) o[d][r] *= al_l[crow(r, hi)]; } } while (0)
    f32x16 pA0, pA1, pB0, pB1; float alA, alB; bf16x8 pa0, pa1, pa2, pa3; constexpr int NT = SEQ / KVBLK;
    constexpr int SE = 0, SO = 0;
    SLOAD(SE, 0); asm volatile("s_waitcnt vmcnt(0)" ::: "memory"); SWRITE(0, SE); __syncthreads();
    qkt(pA0, pA1, K_lds, qr, c, r32, hi); partialSM(pA0, pA1, m_reg, alA);
    SLOAD(SO, KVBLK);
    SWAIT(); SWRITE(1, SO); __syncthreads();
    for (int j = 1; j + 1 < NT; j += 2) {
        SBAR(); qkt(pB0, pB1, K_lds + SHM_K, qr, c, r32, hi);
        finishSM(pA0, pA1, alA, l_reg, pa0, pa1, pa2, pa3); SBAR();
        SLOAD(SO, (j + 1) * KVBLK); SBAR();
        pv_d0(o, vb0, pa0, pa1, pa2, pa3); partialSM(pB0, pB1, m_reg, alB);
        __syncthreads(); SWAIT(); SWRITE(0, SE);
        RESC(alB); __syncthreads();
        SBAR(); qkt(pA0, pA1, K_lds, qr, c, r32, hi);
        finishSM(pB0, pB1, alB, l_reg, pa0, pa1, pa2, pa3); SBAR();
        SLOAD(SE, (j + 2) * KVBLK); SBAR();
        pv_d0(o, vb0 + SHM_V, pa0, pa1, pa2, pa3); partialSM(pA0, pA1, m_reg, alA);
        __syncthreads(); SWAIT(); SWRITE(1, SO);
        RESC(alA); __syncthreads();
    }
    SBAR(); qkt(pB0, pB1, K_lds + SHM_K, qr, c, r32, hi);
    finishSM(pA0, pA1, alA, l_reg, pa0, pa1, pa2, pa3); SBAR();
    pv_d0(o, vb0, pa0, pa1, pa2, pa3); partialSM(pB0, pB1, m_reg, alB);
    __syncthreads(); RESC(alB);
    finishSM(pB0, pB1, alB, l_reg, pa0, pa1, pa2, pa3); SBAR();
    pv_d0(o, vb0 + SHM_V, pa0, pa1, pa2, pa3);
    if (hi == 0) li_l[r32] = l_reg; asm volatile("s_waitcnt lgkmcnt(0)" ::: "memory");
    float rli[16];
#pragma unroll
    for (int r = 0; r < 16; ++r) rli[r] = __builtin_amdgcn_rcpf(li_l[crow(r, hi)]);
    __syncthreads();
    float* X = (float*)lds + wq * 4096;
    if (c == 1) {
#pragma unroll
        for (int r = 0; r < 16; ++r)
#pragma unroll
            for (int d0 = 0; d0 < 4; ++d0) X[crow(r, hi) * 128 + d0 * 32 + r32] = o[d0][r] * rli[r];
    }
    __syncthreads();
    if (c == 0) {
        float g4[4];
#pragma unroll
        for (int d0 = 0; d0 < 4; ++d0) g4[d0] = subg[d0 * 32 + r32] * 0.8f;
#pragma unroll
        for (int r = 0; r < 16; ++r) {
            float v[4], ss = 0.f;
#pragma unroll
            for (int d0 = 0; d0 < 4; ++d0) { v[d0] = o[d0][r] * rli[r] - lam * X[crow(r, hi) * 128 + d0 * 32 + r32]; ss += v[d0] * v[d0]; }
            ss += __shfl_xor(ss, 1); ss += __shfl_xor(ss, 2); ss += __shfl_xor(ss, 4); ss += __shfl_xor(ss, 8); ss += __shfl_xor(ss, 16);
            const float rstd = rsqrtf(ss * (1.f / 128.f) + EPS);
            bf16_t* Or = Qrow + (size_t)crow(r, hi) * LDQ + r32;
#pragma unroll
            for (int d0 = 0; d0 < 4; ++d0) Or[d0 * 32] = f2bf(v[d0] * rstd * g4[d0]);
        }
    }
    __syncthreads();
#undef SLOAD
#undef SWRITE
#undef SWAIT
#undef RESC
}
#undef KSWZ
#undef SBAR
}
namespace rg {
typedef float f32x4v __attribute__((ext_vector_type(4)));
typedef short bf16x8v __attribute__((ext_vector_type(8)));
constexpr int T = 128, XS = 72, FS = 68;
constexpr int L_XRAW = 0, L_XCF = 16896, L_XCB = L_XCF + T * FS * 4, L_WA = L_XCB + T * XS * 2, L_WI = L_WA + 64 * XS * 2, L_SUM = L_WI + 64 * XS * 2, L_CAR = L_SUM + 8 * 64 * 2 * 4, L_END = L_CAR + 2 * 64 * 4;
static_assert(L_END <= 131072, "rg lds");
template <int DIR> __device__ __forceinline__ void sweep(int b, int n, const bf16_t* __restrict__ XR, bf16_t* AO, bf16_t* HF, const float* __restrict__ cw, const float* __restrict__ cb,
        const float* __restrict__ w_a, const float* __restrict__ b_a, const float* __restrict__ w_i, const float* __restrict__ b_i, const float* __restrict__ lam, LAS unsigned char* lds) {
    const int tid = threadIdx.x, wid = __builtin_amdgcn_readfirstlane(tid >> 6), lane = tid & 63, fr = lane & 15, fq = lane >> 4;
    LAS bf16_t* XRAW = (LAS bf16_t*)(lds + L_XRAW); LAS float* XCF = (LAS float*)(lds + L_XCF); LAS bf16_t* XCB = (LAS bf16_t*)(lds + L_XCB);
    LAS bf16_t* WA = (LAS bf16_t*)(lds + L_WA); LAS bf16_t* WI = (LAS bf16_t*)(lds + L_WI); LAS float* SUM = (LAS float*)(lds + L_SUM); LAS float* CAR = (LAS float*)(lds + L_CAR);
    const size_t rowbase = (size_t)b * SEQ;
    __syncthreads();
    { const float* wa = w_a + ((size_t)DIR * 16 + n) * 4096; const float* wi = w_i + ((size_t)DIR * 16 + n) * 4096;
#pragma unroll
      for (int i = 0; i < 8; ++i) { const int idx = tid + 512 * i, k = idx >> 6, j = idx & 63; WA[j * XS + k] = f2bf(wa[idx]); WI[j * XS + k] = f2bf(wi[idx]); }
      if (tid < 128) CAR[tid] = 0.f; }
    float ba[4], bi[4], sp[4];
#pragma unroll
    for (int nf = 0; nf < 4; ++nf) { const int ch = n * 64 + nf * 16 + fr; ba[nf] = b_a[DIR * DM + ch]; bi[nf] = b_i[DIR * DM + ch]; sp[nf] = -8.f * log1pf(__expf(-lam[DIR * DM + ch])); }
    const int p2 = (tid & 31) * 2; const int chp = n * 64 + p2;
    const float k00 = cw[0 * DM + chp], k01 = cw[0 * DM + chp + 1], k10 = cw[1 * DM + chp], k11 = cw[1 * DM + chp + 1], k20 = cw[2 * DM + chp], k21 = cw[2 * DM + chp + 1], k30 = cw[3 * DM + chp], k31 = cw[3 * DM + chp + 1];
    const float cb0 = cb[chp], cb1 = cb[chp + 1];
    v4u pre[3];
#define RG_LOAD(t0_) do { _Pragma("unroll") for (int i = 0; i < 3; ++i) { const int pidx = tid + 512 * i; const int rr = pidx >> 3, cc = pidx & 7; const int t = (t0_) - 2 + rr; \
        pre[i] = (v4u){0u, 0u, 0u, 0u}; if (pidx < (T + 3) * 8 && t >= 0 && t < SEQ) pre[i] = *(const v4u*)(XR + (rowbase + t) * DM + n * 64 + cc * 8); } } while (0)
    RG_LOAD(DIR == 0 ? 0 : SEQ - T);
    for (int ci = 0; ci < SEQ / T; ++ci) {
        const int chunk = DIR == 0 ? ci : SEQ / T - 1 - ci; const int t0 = chunk * T; const int cur = ci & 1;
        __syncthreads();
#pragma unroll
        for (int i = 0; i < 3; ++i) { const int pidx = tid + 512 * i; if (pidx < (T + 3) * 8) *(LAS v4u*)(XRAW + pidx * 8) = pre[i]; }
        __syncthreads();
        if (ci + 1 < SEQ / T) RG_LOAD(DIR == 0 ? t0 + T : t0 - T);
#pragma unroll
        for (int i = 0; i < 8; ++i) { const int r = (tid >> 5) + 16 * i;
            const unsigned x0 = *(LAS unsigned*)(XRAW + (r + 0) * 64 + p2), x1 = *(LAS unsigned*)(XRAW + (r + 1) * 64 + p2), x2 = *(LAS unsigned*)(XRAW + (r + 2) * 64 + p2), x3 = *(LAS unsigned*)(XRAW + (r + 3) * 64 + p2);
            const float v0 = cb0 + k00 * lo_bf(x0) + k10 * lo_bf(x1) + k20 * lo_bf(x2) + k30 * lo_bf(x3);
            const float v1 = cb1 + k01 * hi_bf(x0) + k11 * hi_bf(x1) + k21 * hi_bf(x2) + k31 * hi_bf(x3);
            *(LAS f32x2*)(XCF + r * FS + p2) = (f32x2){v0, v1}; *(LAS unsigned*)(XCB + r * XS + p2) = pk2(v0, v1); }
        __syncthreads();
        bf16x8v a0 = *(LAS bf16x8v*)(XCB + (wid * 16 + fr) * XS + fq * 8), a1 = *(LAS bf16x8v*)(XCB + (wid * 16 + fr) * XS + 32 + fq * 8);
        f32x4v ga[4], gi[4];
#pragma unroll
        for (int nf = 0; nf < 4; ++nf) {
            const bf16x8v wa0 = *(LAS bf16x8v*)(WA + (nf * 16 + fr) * XS + fq * 8), wa1 = *(LAS bf16x8v*)(WA + (nf * 16 + fr) * XS + 32 + fq * 8);
            const bf16x8v wi0 = *(LAS bf16x8v*)(WI + (nf * 16 + fr) * XS + fq * 8), wi1 = *(LAS bf16x8v*)(WI + (nf * 16 + fr) * XS + 32 + fq * 8);
            ga[nf] = __builtin_amdgcn_mfma_f32_16x16x32_bf16(a0, wa0, (f32x4v){0.f, 0.f, 0.f, 0.f}, 0, 0, 0); ga[nf] = __builtin_amdgcn_mfma_f32_16x16x32_bf16(a1, wa1, ga[nf], 0, 0, 0);
            gi[nf] = __builtin_amdgcn_mfma_f32_16x16x32_bf16(a0, wi0, (f32x4v){0.f, 0.f, 0.f, 0.f}, 0, 0, 0); gi[nf] = __builtin_amdgcn_mfma_f32_16x16x32_bf16(a1, wi1, gi[nf], 0, 0, 0);
        }
        float hl[4][4], P[4][4], Ain[4], Hin[4], Aex[4], Hex[4];
#pragma unroll
        for (int nf = 0; nf < 4; ++nf) {
            float av[4], uv[4];
#pragma unroll
            for (int g = 0; g < 4; ++g) {
                const float r = sigmoidf_(ga[nf][g] + ba[nf]), ig = sigmoidf_(gi[nf][g] + bi[nf]);
                const float la = sp[nf] * r, a = fexp(la), x2 = 2.f * la;
                const float poly = -x2 * (1.f + x2 * (0.5f + x2 * (0.16666667f + x2 * (0.041666668f + x2 * (0.0083333333f + x2 * 0.0013888889f)))));
                const float om = x2 > -0.25f ? poly : 1.f - a * a;
                const float xc = XCF[(wid * 16 + fq * 4 + g) * FS + nf * 16 + fr];
                av[g] = a; uv[g] = __builtin_amdgcn_sqrtf(om) * ig * xc;
            }
            if (DIR == 0) { hl[nf][0] = uv[0]; P[nf][0] = av[0];
#pragma unroll
                for (int g = 1; g < 4; ++g) { hl[nf][g] = av[g] * hl[nf][g - 1] + uv[g]; P[nf][g] = av[g] * P[nf][g - 1]; } }
            else { hl[nf][3] = uv[3]; P[nf][3] = av[3];
#pragma unroll
                for (int g = 2; g >= 0; --g) { hl[nf][g] = av[g] * hl[nf][g + 1] + uv[g]; P[nf][g] = av[g] * P[nf][g + 1]; } }
            float A = DIR == 0 ? P[nf][3] : P[nf][0], H = DIR == 0 ? hl[nf][3] : hl[nf][0];
            { const float Ap = DIR == 0 ? __shfl_up(A, 16) : __shfl_down(A, 16), Hp = DIR == 0 ? __shfl_up(H, 16) : __shfl_down(H, 16);
              if (DIR == 0 ? fq >= 1 : fq <= 2) { H = A * Hp + H; A = A * Ap; } }
            { const float Ap = DIR == 0 ? __shfl_up(A, 32) : __shfl_down(A, 32), Hp = DIR == 0 ? __shfl_up(H, 32) : __shfl_down(H, 32);
              if (DIR == 0 ? fq >= 2 : fq <= 1) { H = A * Hp + H; A = A * Ap; } }
            Ain[nf] = A; Hin[nf] = H;
            { const float Ae = DIR == 0 ? __shfl_up(A, 16) : __shfl_down(A, 16), He = DIR == 0 ? __shfl_up(H, 16) : __shfl_down(H, 16);
              const bool first = DIR == 0 ? fq == 0 : fq == 3; Aex[nf] = first ? 1.f : Ae; Hex[nf] = first ? 0.f : He; }
            if (DIR == 0 ? fq == 3 : fq == 0) { SUM[(wid * 64 + nf * 16 + fr) * 2] = A; SUM[(wid * 64 + nf * 16 + fr) * 2 + 1] = H; }
        }
        __syncthreads();
#pragma unroll
        for (int nf = 0; nf < 4; ++nf) {
            const int chl = nf * 16 + fr;
            float cwv = CAR[cur * 64 + chl];
            if (DIR == 0) { for (int w2 = 0; w2 < wid; ++w2) cwv = SUM[(w2 * 64 + chl) * 2] * cwv + SUM[(w2 * 64 + chl) * 2 + 1]; }
            else { for (int w2 = 7; w2 > wid; --w2) cwv = SUM[(w2 * 64 + chl) * 2] * cwv + SUM[(w2 * 64 + chl) * 2 + 1]; }
            if ((DIR == 0 ? wid == 7 && fq == 3 : wid == 0 && fq == 0)) CAR[(cur ^ 1) * 64 + chl] = Ain[nf] * cwv + Hin[nf];
            const float cl = Aex[nf] * cwv + Hex[nf];
#pragma unroll
            for (int g = 0; g < 4; ++g) {
                const float hv = hl[nf][g] + P[nf][g] * cl;
                const size_t row = rowbase + t0 + wid * 16 + fq * 4 + g; const int ch = n * 64 + chl;
                if (DIR == 0) HF[row * DM + ch] = f2bf(hv);
                else { const float yr = bf2f(AO[row * 2048 + ch]); AO[row * 2048 + ch] = f2bf((hv + bf2f(HF[row * DM + ch])) * gelu_tanh(yr)); }
            }
        }
    }
#undef RG_LOAD
}
}
#define XB_TMO      128
#define XB_XCNT(j)  (256  + 64 * (j))
#define XB_XSUB(j)  (1280 + 64 * (j))
#define XB_XGEN(j)  (2304 + 64 * (j))
#define XB_TOP      3328
#define XB_TOPGEN   3392
#define XCD_BAR_WORDS 3456
#define XB_SPIN_CAP (1u << 18)

__device__ __forceinline__ unsigned xb_ld(unsigned* p)              { return __hip_atomic_load(p, __ATOMIC_RELAXED, __HIP_MEMORY_SCOPE_AGENT); }
__device__ __forceinline__ unsigned xb_add(unsigned* p, unsigned v) { return __hip_atomic_fetch_add(p, v, __ATOMIC_RELAXED, __HIP_MEMORY_SCOPE_AGENT); }
__device__ __forceinline__ unsigned xb_xcc_id() { return (unsigned)__builtin_amdgcn_s_getreg((3 << 11) | 20) & 0xFu; }
#define XB_SPIN(cond, bar) do { unsigned _sp = 0; while (cond) { __builtin_amdgcn_s_sleep(1); \
    if ((++_sp & 255u) == 0u) { if (xb_ld(&(bar)[XB_TMO])) break; if (_sp > XB_SPIN_CAP) { atomicAdd(&(bar)[XB_TMO], 1u); break; } } } } while (0)

struct XcdBarrier {
    unsigned* bar; unsigned x;
    volatile LAS unsigned* st;
};

__device__ __forceinline__ XcdBarrier xcd_barrier_post(unsigned* bar, volatile LAS unsigned* st) {
    XcdBarrier b; b.bar = bar; b.x = xb_xcc_id(); b.st = st;
    if (threadIdx.x == 0) (void)xb_add(&bar[XB_XCNT(b.x)], 1u);
    return b;
}
__device__ __forceinline__ void xcd_barrier_complete(unsigned* bar, unsigned x, unsigned& nloc, unsigned& nx) {
    const unsigned G = gridDim.x * gridDim.y * gridDim.z;
    unsigned sum, cnt, mine, sp = 0u;
    for (;;) {
        sum = 0u; cnt = 0u; mine = 0u;
#pragma unroll
        for (unsigned j = 0; j < 16; ++j) { const unsigned c = xb_ld(&bar[XB_XCNT(j)]); sum += c; cnt += (c > 0u) ? 1u : 0u; mine = (j == x) ? c : mine; }
        if (sum == G) break;
        __builtin_amdgcn_s_sleep(1);
        if ((++sp & 255u) == 0u) { if (xb_ld(&bar[XB_TMO])) break; if (sp > XB_SPIN_CAP) { atomicAdd(&bar[XB_TMO], 1u); break; } }
    }
    nloc = mine > 0u ? mine : 1u; nx = cnt > 0u ? cnt : 1u;
}

__device__ __forceinline__ void xcd_barrier(const XcdBarrier& b) {
    asm volatile("s_waitcnt vmcnt(0)" ::: "memory");
    __syncthreads();
    if (threadIdx.x == 0) {
        unsigned* bar = b.bar;
        __builtin_amdgcn_s_waitcnt(0);
        unsigned nloc = b.st[0], nx = b.st[1];
        if (nloc == 0u) { xcd_barrier_complete(bar, b.x, nloc, nx); b.st[0] = nloc; b.st[1] = nx; }
        const unsigned old = xb_add(&bar[XB_XSUB(b.x)], 1u);
        const unsigned gen = old / nloc;
        if (old + 1u == (gen + 1u) * nloc) {
            __builtin_amdgcn_fence(__ATOMIC_RELEASE, "agent");
            asm volatile("s_waitcnt vmcnt(0)" ::: "memory");
            const unsigned og = xb_add(&bar[XB_TOP], 1u);
            const unsigned tg = og / nx;
            if (og + 1u == (tg + 1u) * nx) xb_add(&bar[XB_TOPGEN], 1u);
            else XB_SPIN(xb_ld(&bar[XB_TOPGEN]) == tg, bar);
            __builtin_amdgcn_fence(__ATOMIC_ACQUIRE, "agent");
            xb_add(&bar[XB_XGEN(b.x)], 1u);
            asm volatile("s_waitcnt vmcnt(0)" ::: "memory");
        } else {
            XB_SPIN(xb_ld(&bar[XB_XGEN(b.x)]) == gen, bar);
            __builtin_amdgcn_fence(__ATOMIC_ACQUIRE, "agent");
            asm volatile("s_waitcnt vmcnt(0)" ::: "memory");
        }
    }
    __syncthreads();
}
struct Frame {
    LAS unsigned char* lds;
    int tid, lane, wave, vcu, G;
};
__device__ __forceinline__ void p0_transpose_item(const float* W, int K, int N, bf16_t* WT, int row_off, LAS float* scr, int kb, int nb, int lane) {
    const int k0 = 64 * kb, n0 = 32 * nb;
#pragma unroll 8
    for (int i = 0; i < 32; ++i) { const int kk = 2 * i + (lane >> 5); scr[kk * 33 + (lane & 31)] = W[(size_t)(k0 + kk) * N + n0 + (lane & 31)]; }
    LDS_WAIT(); asm volatile("" ::: "memory");
    const int c = lane & 7;
#pragma unroll
    for (int j = 0; j < 4; ++j) { const int n = (lane >> 3) + 8 * j; const LAS float* s = scr + (8 * c) * 33 + n;
        v4u o; o.x = pk2(s[0 * 33], s[1 * 33]); o.y = pk2(s[2 * 33], s[3 * 33]); o.z = pk2(s[4 * 33], s[5 * 33]); o.w = pk2(s[6 * 33], s[7 * 33]);
        *(GAS v4u*)(WT + (size_t)(row_off + n0 + n) * K + k0 + 8 * c) = o; }
    LDS_WAIT(); asm volatile("" ::: "memory");
}
__device__ __forceinline__ void normmod_row(const float* xrow, const float* g, const float* sc, const float* sh, bf16_t* orow, int lane) {
    f32x4 v[4]; float s = 0.f;
#pragma unroll
    for (int j = 0; j < 4; ++j) { v[j] = *((const f32x4*)xrow + lane + 64 * j); s += (v[j].x * v[j].x + v[j].y * v[j].y) + (v[j].z * v[j].z + v[j].w * v[j].w); }
    const float rstd = rsqrtf(wave_sum(s) * (1.f / DM) + EPS);
#pragma unroll
    for (int j = 0; j < 4; ++j) { const f32x4 gg = *((const f32x4*)g + lane + 64 * j), cc = *((const f32x4*)sc + lane + 64 * j), hh = *((const f32x4*)sh + lane + 64 * j);
        const f32x4 y = v[j] * rstd * gg * (cc + 1.f) + hh; v2u w; w.x = pk2(y.x, y.y); w.y = pk2(y.z, y.w); *((v2u*)orow + lane + 64 * j) = w; }
}

#ifndef MIX_SEL
#define MIX_SEL 3
#endif
#ifndef PH_MASK
#define PH_MASK 0x7ff
#endif
struct Args { const void* in[28]; float* out; unsigned char* ws; int ph_lo, ph_hi, li, pad; };
typedef const __attribute__((address_space(4))) Args KArgs;
__device__ __forceinline__ KArgs* ka_ptr() { auto p = __builtin_amdgcn_kernarg_segment_ptr(); asm volatile("" : "+s"(p)); return (KArgs*)p; }
enum { P_PRO = 0, P_NORM1, P_PROJ, P_MIX, P_MERGE, P_OUT, P_NORM2, P_UP, P_FIX, P_DOWN, P_FINAL, N_PHASES };

__global__ void __launch_bounds__(NWAVES * 64, 2) mk_fwd(Args args) {
    extern __shared__ __attribute__((aligned(16))) unsigned char lds[];
    for (int u = threadIdx.x; u < (LDS_BYTES - LDSCTL_OFF) / 4; u += NWAVES * 64) ((LAS unsigned*)((LAS unsigned char*)lds + LDSCTL_OFF))[u] = 0u;
    __syncthreads();
    { KArgs* KA = ka_ptr(); if (KA->ph_hi - KA->ph_lo > 1) (void)xcd_barrier_post((unsigned*)(KA->ws + WS_CTL) + CW_BAR + KA->li * XCD_BAR_WORDS, (volatile LAS unsigned*)((LAS unsigned char*)lds + MISC_OFF) + 8); }
#define INP(k) ((const float*)KA->in[k])
#define WSP(T, off) ((T*)(KA->ws + (off)))
#define IN(k) (((PH_MASK >> (k)) & 1) && ka_ptr()->ph_lo <= (k) && (k) < ka_ptr()->ph_hi)
#define SEAM(k) do { KArgs* KB_ = ka_ptr(); if (KB_->ph_lo <= (k) && (k) + 1 < KB_->ph_hi) { XcdBarrier bar; bar.bar = (unsigned*)(KB_->ws + WS_CTL) + CW_BAR + KB_->li * XCD_BAR_WORDS; bar.x = xb_xcc_id(); \
        bar.st = (volatile LAS unsigned*)((LAS unsigned char*)lds + MISC_OFF) + 8; xcd_barrier(bar); } } while (0)
#define FRAME() Frame F; F.lds = (LAS unsigned char*)lds; F.tid = threadIdx.x; F.lane = F.tid & 63; F.wave = __builtin_amdgcn_readfirstlane(F.tid >> 6); F.G = gridDim.x; \
        { const int bx = blockIdx.x; F.vcu = (F.G % 8 == 0) ? (bx % 8) * (F.G / 8) + bx / 8 : bx; } const int gw = F.vcu * NWAVES + F.wave, NGW = F.G * NWAVES; (void)gw; (void)NGW;

    if (IN(P_PRO)) {
        KArgs* KA = ka_ptr(); FRAME(); const float* cvec = INP(1); const int* pos = (const int*)KA->in[2]; const float* w_ada = INP(3); const float* b_ada = INP(4);
        float* MOD = WSP(float, WS_MOD); float* COS = WSP(float, WS_COS); float* SIN = WSP(float, WS_SIN);
        if (F.vcu < 24) {
            LAS float* SC = (LAS float*)F.lds;
            for (int i = F.tid; i < BATCH * DM; i += NWAVES * 64) { const float cv = cvec[i]; SC[i] = cv * sigmoidf_(cv); }
            __syncthreads();
            const int j = F.vcu * 256 + F.lane * 4; f32x4 acc[16];
#pragma unroll
            for (int b = 0; b < 16; ++b) acc[b] = (f32x4){0.f, 0.f, 0.f, 0.f};
            for (int kk = 0; kk < 128; kk += 8) {
                f32x4 wv[8];
#pragma unroll
                for (int q = 0; q < 8; ++q) wv[q] = *(const f32x4*)(w_ada + (size_t)(F.wave * 128 + kk + q) * NMODC + j);
#pragma unroll
                for (int q = 0; q < 8; ++q)
#pragma unroll
                    for (int b = 0; b < 16; ++b) acc[b] += wv[q] * SC[b * DM + F.wave * 128 + kk + q];
            }
            __syncthreads();
            LAS f32x4* RED = (LAS f32x4*)F.lds;
#pragma unroll
            for (int b = 0; b < 16; ++b) RED[(F.wave * 16 + b) * 64 + F.lane] = acc[b];
            __syncthreads();
            for (int o = F.tid; o < 16 * 64; o += NWAVES * 64) { const int b = o >> 6, l4 = o & 63; f32x4 s = *(const f32x4*)(b_ada + F.vcu * 256 + l4 * 4);
#pragma unroll
                for (int w = 0; w < 8; ++w) s += RED[(w * 16 + b) * 64 + l4];
                *(f32x4*)(MOD + (size_t)b * NMODC + F.vcu * 256 + l4 * 4) = s; }
            __syncthreads();
        }
        for (int idx = F.vcu * 512 + F.tid; idx < M * 8; idx += F.G * 512) {
            const int row = idx >> 3, i = idx & 7;
            const float invf = powf(500000.0f, -(float)i / 8.0f);
            const float ang = (float)pos[row] * invf;
            const double rev = (double)ang * 0.15915494309189535; const double fr = rev - rint(rev);
            COS[idx] = __builtin_amdgcn_cosf((float)fr); SIN[idx] = __builtin_amdgcn_sinf((float)fr);
        }
        {
            const float* w_in = INP(6); const float* w_rnn_o = INP(14); const float* w_attn_o = INP(20); const float* w_out = INP(21); const float* w_up = INP(23); const float* w_down = INP(26);
            bf16_t* WIN_T = WSP(bf16_t, WS_WIN); bf16_t* WA_T = WSP(bf16_t, WS_WA); bf16_t* WB_T = WSP(bf16_t, WS_WB); bf16_t* WOUT_T = WSP(bf16_t, WS_WOUT); bf16_t* WUP_T = WSP(bf16_t, WS_WUP); bf16_t* WDOWN_T = WSP(bf16_t, WS_WDOWN);
            LAS float* scr = (LAS float*)(F.lds + F.wave * 16384);
            constexpr int I_IN = 16 * (INCOLS / 32), I_SQ = 16 * 32, I_UP = 16 * (2 * DFF / 32), I_DN = (DFF / 64) * 32;
            constexpr int NITEMS = I_IN + 3 * I_SQ + I_UP + I_DN;
            for (int it = gw; it < NITEMS; it += NGW) {
                int r = it;
                if (r < I_IN) { p0_transpose_item(w_in, DM, INCOLS, WIN_T, 0, scr, r / (INCOLS / 32), r % (INCOLS / 32), F.lane); continue; } r -= I_IN;
                if (r < I_SQ) { p0_transpose_item(w_rnn_o, DM, DM, WA_T, 0, scr, r / 32, r % 32, F.lane); continue; } r -= I_SQ;
                if (r < I_SQ) { p0_transpose_item(w_attn_o, DM, DM, WB_T, 0, scr, r / 32, r % 32, F.lane); continue; } r -= I_SQ;
                if (r < I_SQ) { p0_transpose_item(w_out, DM, DM, WOUT_T, 0, scr, r / 32, r % 32, F.lane); continue; } r -= I_SQ;
                if (r < I_UP) { const int kb = r / (2 * DFF / 32), nb = r % (2 * DFF / 32), n0 = nb * 32; const int jn = n0 < DFF ? n0 : n0 - DFF; const int mapped = (jn / 128) * 256 + (n0 < DFF ? 0 : 128) + (jn % 128);
                    p0_transpose_item(w_up, DM, 2 * DFF, WUP_T, mapped - n0, scr, kb, nb, F.lane); continue; } r -= I_UP;
                p0_transpose_item(w_down, DFF, DM, WDOWN_T, 0, scr, r / 32, r % 32, F.lane);
            }
        }
        if (gw == 0) {
            const float* lq1 = INP(15); const float* lk1 = INP(16); const float* lq2 = INP(17); const float* lk2 = INP(18);
            const float s1 = wave_sum(lq1[F.lane] * lk1[F.lane]), s2 = wave_sum(lq2[F.lane] * lk2[F.lane]);
            if (F.lane == 0) MOD[BATCH * NMODC] = fexp(s1) - fexp(s2) + 0.2f;
        }
    }
    SEAM(P_PRO);
    if (IN(P_NORM1)) { KArgs* KA = ka_ptr(); FRAME(); const float* x = INP(0); const float* norm1_g = INP(5); const float* MOD = WSP(float, WS_MOD); bf16_t* H = WSP(bf16_t, WS_H); for (int m = gw; m < M; m += NGW) { const float* mb = MOD + (size_t)(m / SEQ) * NMODC; normmod_row(x + (size_t)m * DM, norm1_g, mb + 1024, mb, H + (size_t)m * DM, F.lane); } }
    SEAM(P_NORM1);
    if (IN(P_PROJ)) {
        KArgs* KA = ka_ptr(); FRAME(); bf16_t* H = WSP(bf16_t, WS_H); bf16_t* WIN_T = WSP(bf16_t, WS_WIN); bf16_t* XR = WSP(bf16_t, WS_XR); bf16_t* AO = WSP(bf16_t, WS_AO); bf16_t* KB = WSP(bf16_t, WS_K); bf16_t* VB = WSP(bf16_t, WS_V);
        bf16_t* GT = (bf16_t*)KA->out; const float* COS = WSP(float, WS_COS); const float* SIN = WSP(float, WS_SIN);
        pg8::Gemm g{H, WIN_T, M, INCOLS, DM, DM}; pg8::StaticOrder S; S.init(M, INCOLS, F.G, (int)blockIdx.x);
        EpiProj E{XR, AO, KB, VB, GT, COS, SIN};
        pg8::gemm_phase<EpiProj, pg8::StaticOrder, PG8_ALIGN, PG8_SP2>(F.lds + RING_OFF, g, S, E);
    }
    SEAM(P_PROJ);
    if (IN(P_MIX)) {
        KArgs* KA = ka_ptr(); FRAME(); bf16_t* XR = WSP(bf16_t, WS_XR); bf16_t* AO = WSP(bf16_t, WS_AO); bf16_t* KB = WSP(bf16_t, WS_K); bf16_t* VB = WSP(bf16_t, WS_V); bf16_t* HF = WSP(bf16_t, WS_HF); const float* MOD = WSP(float, WS_MOD);
        const float* conv_rnn_w = INP(7); const float* conv_rnn_b = INP(8); const float* w_rg_a = INP(9); const float* b_rg_a = INP(10); const float* w_rg_i = INP(11); const float* b_rg_i = INP(12); const float* rg_lambda = INP(13); const float* subln_g = INP(19);
        if ((MIX_SEL & 1) && (KA->pad & 1) && F.vcu < 256) { const int b = F.vcu >> 4, n = F.vcu & 15;
            rg::sweep<0>(b, n, XR, AO, HF, conv_rnn_w, conv_rnn_b, w_rg_a, b_rg_a, w_rg_i, b_rg_i, rg_lambda, F.lds);
            rg::sweep<1>(b, n, XR, AO, HF, conv_rnn_w, conv_rnn_b, w_rg_a, b_rg_a, w_rg_i, b_rg_i, rg_lambda, F.lds);
            __syncthreads(); }
        const float lam = MOD[BATCH * NMODC];
        if ((MIX_SEL & 2) && (KA->pad & 2)) for (int uidx = F.vcu * 8; uidx < BATCH * 8 * 16; uidx += F.G * 8) {
#pragma unroll 1
            for (int q = 0; q < 8; ++q) { const int un = uidx + q; const int bh = un >> 4, qb = un & 15;
                att::attn_unit(bh >> 3, bh & 7, qb, AO, KB, VB, lam, subln_g, (char*)lds); }
        }
    }
    SEAM(P_MIX);
    if (IN(P_MERGE)) {
        KArgs* KA = ka_ptr(); FRAME(); bf16_t* AO = WSP(bf16_t, WS_AO); bf16_t* WA_T = WSP(bf16_t, WS_WA); bf16_t* WB_T = WSP(bf16_t, WS_WB); bf16_t* GT = (bf16_t*)KA->out; bf16_t* MG = WSP(bf16_t, WS_XR);
        pg8::StaticOrder S; S.init(M, DM, F.G, (int)blockIdx.x);
        { pg8::Gemm g{AO, WA_T, M, DM, DM, 2048}; EpiMerge<0> E{GT, MG}; pg8::gemm_phase<EpiMerge<0>, pg8::StaticOrder, PG8_ALIGN, PG8_SP2>(F.lds + RING_OFF, g, S, E); }
        VM_WAIT(); __builtin_amdgcn_fence(__ATOMIC_ACQUIRE, "agent"); VM_WAIT(); __syncthreads();
        { pg8::Gemm g{AO + 1024, WB_T, M, DM, DM, 2048}; EpiMerge<1> E{GT, MG}; pg8::gemm_phase<EpiMerge<1>, pg8::StaticOrder, PG8_ALIGN, PG8_SP2>(F.lds + RING_OFF, g, S, E); }
    }
    SEAM(P_MERGE);
    if (IN(P_OUT)) {
        KArgs* KA = ka_ptr(); FRAME(); bf16_t* MG = WSP(bf16_t, WS_XR); bf16_t* WOUT_T = WSP(bf16_t, WS_WOUT); const float* x = INP(0); float* out = KA->out; const float* MOD = WSP(float, WS_MOD);
        pg8::Gemm g{MG, WOUT_T, M, DM, DM, DM}; pg8::StaticOrder S; S.init(M, DM, F.G, (int)blockIdx.x);
        EpiResid E{x, out, MOD + 2048}; pg8::gemm_phase<EpiResid, pg8::StaticOrder, PG8_ALIGN, PG8_SP2>(F.lds + RING_OFF, g, S, E);
    }
    SEAM(P_OUT);
    if (IN(P_NORM2)) { KArgs* KA = ka_ptr(); FRAME(); const float* out = KA->out; const float* norm2_g = INP(22); const float* MOD = WSP(float, WS_MOD); bf16_t* H = WSP(bf16_t, WS_H); for (int m = gw; m < M; m += NGW) { const float* mb = MOD + (size_t)(m / SEQ) * NMODC; normmod_row(out + (size_t)m * DM, norm2_g, mb + 4096, mb + 3072, H + (size_t)m * DM, F.lane); } }
    SEAM(P_NORM2);
    if (IN(P_UP)) {
        KArgs* KA = ka_ptr(); FRAME(); bf16_t* H = WSP(bf16_t, WS_H); bf16_t* WUP_T = WSP(bf16_t, WS_WUP); bf16_t* ACT = WSP(bf16_t, WS_ACT); float* EDGE = WSP(float, WS_EDGE); const float* conv_ffn_w = INP(24); const float* conv_ffn_b = INP(25);
        pg8::Gemm g{H, WUP_T, M, 2 * DFF, DM, DM}; pg8::StaticOrder S; S.init(M, 2 * DFF, F.G, (int)blockIdx.x);
        EpiUpConv E{ACT, EDGE, conv_ffn_w, conv_ffn_b}; pg8::gemm_phase<EpiUpConv, pg8::StaticOrder, PG8_ALIGN, PG8_SP2>(F.lds + RING_OFF, g, S, E);
    }
    SEAM(P_UP);
    if (IN(P_FIX)) {
        KArgs* KA = ka_ptr(); FRAME(); bf16_t* ACT = WSP(bf16_t, WS_ACT); const float* EDGE = WSP(float, WS_EDGE); const float* conv_ffn_w = INP(24); const float* conv_ffn_b = INP(25);
        for (int idx = F.vcu * 512 + F.tid; idx < 512 * 2 * DFF; idx += F.G * 512) {
            const int j = idx % DFF, ge = idx / DFF, e = ge & 1, gband = ge >> 1;
            const int pc = (j / 128) * 256 + (j % 128);
            const float* Eb = EDGE + (size_t)gband * 4 * 5632;
            float pv, pg, cv, cg, nv, ng;
            if (e == 0) { const bool z = (gband % 32) == 0; pv = z ? 0.f : Eb[-5632 + pc]; pg = z ? 0.f : Eb[-5632 + pc + 128]; cv = Eb[pc]; cg = Eb[pc + 128]; nv = Eb[5632 + pc]; ng = Eb[5632 + pc + 128]; }
            else { const bool z = ((gband + 1) % 32) == 0; pv = Eb[2 * 5632 + pc]; pg = Eb[2 * 5632 + pc + 128]; cv = Eb[3 * 5632 + pc]; cg = Eb[3 * 5632 + pc + 128]; nv = z ? 0.f : Eb[4 * 5632 + pc]; ng = z ? 0.f : Eb[4 * 5632 + pc + 128]; }
            const float vcv = conv_ffn_b[j] + conv_ffn_w[j] * pv + conv_ffn_w[2 * DFF + j] * cv + conv_ffn_w[4 * DFF + j] * nv;
            const float gcv = conv_ffn_b[DFF + j] + conv_ffn_w[DFF + j] * pg + conv_ffn_w[3 * DFF + j] * cg + conv_ffn_w[5 * DFF + j] * ng;
            ACT[(size_t)(gband * 64 + (e ? 63 : 0)) * DFF + j] = f2bf(gcv * sigmoidf_(gcv) * vcv);
        }
    }
    SEAM(P_FIX);
    if (IN(P_DOWN)) {
        KArgs* KA = ka_ptr(); FRAME(); bf16_t* ACT = WSP(bf16_t, WS_ACT); bf16_t* WDOWN_T = WSP(bf16_t, WS_WDOWN); float* out = KA->out; const float* MOD = WSP(float, WS_MOD);
        pg8::Gemm g{ACT, WDOWN_T, M, DM, DFF, DFF}; pg8::StaticOrder S; S.init(M, DM, F.G, (int)blockIdx.x);
        EpiResid E{out, out, MOD + 5120}; pg8::gemm_phase<EpiResid, pg8::StaticOrder, PG8_ALIGN, PG8_SP2>(F.lds + RING_OFF, g, S, E);
    }
    SEAM(P_DOWN);
    if (IN(P_FINAL)) {
        KArgs* KA = ka_ptr(); FRAME(); float* out = KA->out; const float* final_g = INP(27);
        for (int m = gw; m < M; m += NGW) { float* xr = out + (size_t)m * DM; f32x4 v[4]; float s = 0.f;
#pragma unroll
            for (int j = 0; j < 4; ++j) { v[j] = *((const f32x4*)xr + F.lane + 64 * j); s += (v[j].x * v[j].x + v[j].y * v[j].y) + (v[j].z * v[j].z + v[j].w * v[j].w); }
            const float rstd = rsqrtf(wave_sum(s) * (1.f / DM) + EPS);
#pragma unroll
            for (int j = 0; j < 4; ++j) { const f32x4 gg = *((const f32x4*)final_g + F.lane + 64 * j); *((f32x4*)xr + F.lane + 64 * j) = v[j] * rstd * gg; } }
    }
#undef IN
#undef SEAM
#undef INP
#undef WSP
#undef FRAME
}
__device__ __forceinline__ float nv_sigmoid(float x) { return 1.f / (1.f + __expf(-x)); }
__device__ __forceinline__ float nv_gelu(float x) { const float u = 1.5957691216057308f * (x + 0.044715f * x * x * x); return x / (1.f + __expf(-u)); }
__global__ void __launch_bounds__(256) k_mod(const float* __restrict__ c, const float* __restrict__ w_ada, const float* __restrict__ b_ada, float* __restrict__ mod,
                                             const float* lq1, const float* lk1, const float* lq2, const float* lk2) {
    const int j = blockIdx.x * 256 + threadIdx.x, b = blockIdx.y;
    float acc = b_ada[j];
    for (int k = 0; k < DM; ++k) { const float cv = c[b * DM + k]; acc += (cv / (1.f + __expf(-cv))) * w_ada[(size_t)k * NMODC + j]; }
    mod[b * NMODC + j] = acc;
    if (blockIdx.x == 0 && blockIdx.y == 0 && threadIdx.x == 0) {
        float s1 = 0.f, s2 = 0.f;
        for (int i = 0; i < 64; ++i) { s1 += lq1[i] * lk1[i]; s2 += lq2[i] * lk2[i]; }
        mod[BATCH * NMODC] = __expf(s1) - __expf(s2) + 0.2f;
    }
}
__global__ void __launch_bounds__(256) k_rope_tab(const int* __restrict__ pos, float* __restrict__ cs, float* __restrict__ sn) {
    const int idx = blockIdx.x * 256 + threadIdx.x; if (idx >= M * 8) return;
    const int row = idx >> 3, i = idx & 7;
    const float invf = powf(500000.0f, -(float)i / 8.0f);
    const float ang = (float)pos[row] * invf;
    const double rev = (double)ang * 0.15915494309189535;
    const double fr = rev - rint(rev);
    cs[idx] = __builtin_amdgcn_cosf((float)fr); sn[idx] = __builtin_amdgcn_sinf((float)fr);
}
__global__ void __launch_bounds__(256) k_normmod(const float* __restrict__ x, const float* __restrict__ g, const float* __restrict__ mod, int sh_off, int sc_off, bf16_t* __restrict__ out) {
    const int row = blockIdx.x * 4 + (threadIdx.x >> 6), lane = threadIdx.x & 63, b = row / SEQ;
    const float* xr = x + (size_t)row * DM; float v[16]; float ss = 0.f;
#pragma unroll
    for (int j = 0; j < 16; ++j) { v[j] = xr[lane + 64 * j]; ss += v[j] * v[j]; }
#pragma unroll
    for (int o = 1; o < 64; o <<= 1) ss += __shfl_xor(ss, o);
    const float rstd = rsqrtf(ss * (1.f / DM) + EPS);
#pragma unroll
    for (int j = 0; j < 16; ++j) { const int k = lane + 64 * j; out[(size_t)row * DM + k] = f2bf(v[j] * rstd * g[k] * (1.f + mod[b * NMODC + sc_off + k]) + mod[b * NMODC + sh_off + k]); }
}
__global__ void __launch_bounds__(256) k_final(float* __restrict__ x, const float* __restrict__ g) {
    const int row = blockIdx.x * 4 + (threadIdx.x >> 6), lane = threadIdx.x & 63;
    float* xr = x + (size_t)row * DM; float v[16]; float ss = 0.f;
#pragma unroll
    for (int j = 0; j < 16; ++j) { v[j] = xr[lane + 64 * j]; ss += v[j] * v[j]; }
#pragma unroll
    for (int o = 1; o < 64; o <<= 1) ss += __shfl_xor(ss, o);
    const float rstd = rsqrtf(ss * (1.f / DM) + EPS);
#pragma unroll
    for (int j = 0; j < 16; ++j) { const int k = lane + 64 * j; xr[k] = v[j] * rstd * g[k]; }
}
template <class Epi> __global__ void __launch_bounds__(256) nv_gemm(const bf16_t* __restrict__ A, int lda, const float* __restrict__ W, int N, int K, Epi E) {
    __shared__ float As[16][68]; __shared__ float Bs[16][64];
    const int tid = threadIdx.x, tx = tid & 15, ty = tid >> 4, m0 = blockIdx.y * 64, n0 = blockIdx.x * 64;
    float acc[4][4] = {};
    for (int k0 = 0; k0 < K; k0 += 16) {
        { const int r = tid >> 2, kk = (tid & 3) * 4; const bf16_t* ap = A + (size_t)(m0 + r) * lda + k0 + kk;
          As[kk + 0][r] = bf2f(ap[0]); As[kk + 1][r] = bf2f(ap[1]); As[kk + 2][r] = bf2f(ap[2]); As[kk + 3][r] = bf2f(ap[3]); }
        { const int kk = tid >> 4, n = (tid & 15) * 4; const float4 w = *(const float4*)(W + (size_t)(k0 + kk) * N + n0 + n); *(float4*)&Bs[kk][n] = w; }
        __syncthreads();
#pragma unroll
        for (int k = 0; k < 16; ++k) { const float4 a = *(const float4*)&As[k][ty * 4]; const float4 b = *(const float4*)&Bs[k][tx * 4];
            const float av[4] = {a.x, a.y, a.z, a.w}, bv[4] = {b.x, b.y, b.z, b.w};
#pragma unroll
            for (int i = 0; i < 4; ++i)
#pragma unroll
                for (int j = 0; j < 4; ++j) acc[i][j] += av[i] * bv[j]; }
        __syncthreads();
    }
#pragma unroll
    for (int i = 0; i < 4; ++i)
#pragma unroll
        for (int j = 0; j < 4; ++j) E(m0 + ty * 4 + i, n0 + tx * 4 + j, acc[i][j]);
}
struct EProj { bf16_t *XR, *AO, *KB, *VB, *GT;
    __device__ void operator()(int m, int n, float v) const { const bf16_t o = f2bf(v);
        if (n < 1024) XR[(size_t)m * 1024 + n] = o; else if (n < 2048) AO[(size_t)m * 2048 + n - 1024] = o; else if (n < 3072) AO[(size_t)m * 2048 + 1024 + n - 2048] = o;
        else if (n < 4096) KB[(size_t)m * 1024 + n - 3072] = o; else if (n < 5120) VB[(size_t)m * 1024 + n - 4096] = o; else GT[(size_t)m * 2048 + n - 5120] = o; } };
struct EMergeA { const bf16_t* GT; bf16_t* MG; __device__ void operator()(int m, int n, float v) const { MG[(size_t)m * 1024 + n] = f2bf(nv_sigmoid(bf2f(GT[(size_t)m * 2048 + n])) * v); } };
struct EMergeB { const bf16_t* GT; bf16_t* MG; __device__ void operator()(int m, int n, float v) const { MG[(size_t)m * 1024 + n] = f2bf(bf2f(MG[(size_t)m * 1024 + n]) + nv_sigmoid(bf2f(GT[(size_t)m * 2048 + 1024 + n])) * v); } };
struct EOut { const float* x; const float* mod; float* X1; __device__ void operator()(int m, int n, float v) const { X1[(size_t)m * 1024 + n] = x[(size_t)m * 1024 + n] + mod[(m / SEQ) * NMODC + 2048 + n] * v; } };
struct EUp { bf16_t* UP; __device__ void operator()(int m, int n, float v) const { UP[(size_t)m * 5632 + n] = f2bf(v); } };
struct EDown { float* X; const float* mod; __device__ void operator()(int m, int n, float v) const { X[(size_t)m * 1024 + n] += mod[(m / SEQ) * NMODC + 5120 + n] * v; } };

__global__ void __launch_bounds__(256) k_rope(bf16_t* __restrict__ AO, bf16_t* __restrict__ KB, const float* __restrict__ cs, const float* __restrict__ sn) {
    const int idx = blockIdx.x * 256 + threadIdx.x; const int row = idx >> 4, hc = idx & 15;
    bf16_t* q = AO + (size_t)row * 2048 + 1024 + hc * 64; bf16_t* k = KB + (size_t)row * 1024 + hc * 64;
    float qv[64];
#pragma unroll
    for (int d = 0; d < 64; ++d) qv[d] = bf2f(q[d]);
#pragma unroll
    for (int i = 0; i < 8; ++i) { const float c = cs[row * 8 + i], s = sn[row * 8 + i]; const float a = qv[i], b = qv[i + 8]; qv[i] = a * c - b * s; qv[i + 8] = b * c + a * s;
        const float ka = bf2f(k[i]), kb = bf2f(k[i + 8]); k[i] = f2bf(ka * c - kb * s); k[i + 8] = f2bf(kb * c + ka * s); }
#pragma unroll
    for (int d = 0; d < 64; ++d) q[d] = f2bf(qv[d] * C2);
}
__global__ void __launch_bounds__(64) nv_rglru(const bf16_t* __restrict__ XR, bf16_t* __restrict__ AO, bf16_t* __restrict__ HF, const float* __restrict__ cw, const float* __restrict__ cb,
                                               const float* __restrict__ w_a, const float* __restrict__ b_a, const float* __restrict__ w_i, const float* __restrict__ b_i, const float* __restrict__ lam) {
    __shared__ float wA[64][64]; __shared__ float wI[64][64]; __shared__ float xcs[64];
    const int j = threadIdx.x, n = blockIdx.x, b = blockIdx.y, ch = n * 64 + j;
    const float c0 = cw[0 * DM + ch], c1 = cw[1 * DM + ch], c2 = cw[2 * DM + ch], c3 = cw[3 * DM + ch], cbv = cb[ch];
    for (int d = 0; d < 2; ++d) {
        __syncthreads();
        for (int k = 0; k < 64; ++k) { wA[k][j] = w_a[(((size_t)d * 16 + n) * 64 + k) * 64 + j]; wI[k][j] = w_i[(((size_t)d * 16 + n) * 64 + k) * 64 + j]; }
        const float ba = b_a[d * DM + ch], bi = b_i[d * DM + ch], sp = log1pf(__expf(-lam[d * DM + ch]));
        float h = 0.f;
        for (int tt = 0; tt < SEQ; ++tt) {
            const int t = d == 0 ? tt : SEQ - 1 - tt; const size_t row = (size_t)b * SEQ + t;
            float xc = cbv;
            if (t >= 2) xc += c0 * bf2f(XR[(row - 2) * DM + ch]);
            if (t >= 1) xc += c1 * bf2f(XR[(row - 1) * DM + ch]);
            xc += c2 * bf2f(XR[row * DM + ch]);
            if (t + 1 < SEQ) xc += c3 * bf2f(XR[(row + 1) * DM + ch]);
            __syncthreads(); xcs[j] = xc; __syncthreads();
            float ga = ba, gi = bi;
#pragma unroll 16
            for (int k = 0; k < 64; ++k) { const float xv = xcs[k]; ga += xv * wA[k][j]; gi += xv * wI[k][j]; }
            const float r = nv_sigmoid(ga), ig = nv_sigmoid(gi), la = -8.f * r * sp, a = __expf(la), u = sqrtf(-expm1f(2.f * la)) * ig * xc;
            h = a * h + u;
            if (d == 0) HF[row * DM + ch] = f2bf(h);
            else { const float yr = bf2f(AO[row * 2048 + ch]); AO[row * 2048 + ch] = f2bf((h + bf2f(HF[row * DM + ch])) * nv_gelu(yr)); }
        }
    }
}
__global__ void __launch_bounds__(256) nv_attn(bf16_t* __restrict__ AO, const bf16_t* __restrict__ KB, const bf16_t* __restrict__ VB, const float* __restrict__ subg, const float* __restrict__ scal) {
    __shared__ float Ks[64][64]; __shared__ float Vs[64][128];
    const int tid = threadIdx.x, qi = tid >> 3, chn = tid & 7, h = blockIdx.y, b = blockIdx.z;
    const size_t row = (size_t)b * SEQ + blockIdx.x * 32 + qi; const float lam = scal[0];
    float res[16];
    for (int c = 0; c < 2; ++c) {
        float q[64];
#pragma unroll
        for (int d = 0; d < 64; ++d) q[d] = bf2f(AO[row * 2048 + 1024 + h * 128 + c * 64 + d]);
        float m = -1e30f, l = 0.f, acc[16];
#pragma unroll
        for (int e = 0; e < 16; ++e) acc[e] = 0.f;
        for (int kt = 0; kt < SEQ / 64; ++kt) {
            __syncthreads();
            for (int i = 0; i < 16; ++i) { const int idx = tid + 256 * i, key = idx >> 6, d = idx & 63; Ks[key][d] = bf2f(KB[((size_t)b * SEQ + kt * 64 + key) * 1024 + h * 128 + c * 64 + d]); }
            for (int i = 0; i < 32; ++i) { const int idx = tid + 256 * i, key = idx >> 7, d = idx & 127; Vs[key][d] = bf2f(VB[((size_t)b * SEQ + kt * 64 + key) * 1024 + h * 128 + d]); }
            __syncthreads();
            for (int key = 0; key < 64; ++key) {
                float s = 0.f;
#pragma unroll
                for (int d = 0; d < 64; ++d) s += q[d] * Ks[key][d];
                const float mn = fmaxf(m, s), al = exp2f(m - mn), p = exp2f(s - mn); l = l * al + p; m = mn;
#pragma unroll
                for (int e = 0; e < 16; ++e) acc[e] = acc[e] * al + p * Vs[key][chn * 16 + e];
            }
        }
        const float inv = 1.f / l;
#pragma unroll
        for (int e = 0; e < 16; ++e) res[e] = c == 0 ? acc[e] * inv : res[e] - lam * acc[e] * inv;
    }
    float ss = 0.f;
#pragma unroll
    for (int e = 0; e < 16; ++e) ss += res[e] * res[e];
    ss += __shfl_xor(ss, 1); ss += __shfl_xor(ss, 2); ss += __shfl_xor(ss, 4);
    const float rstd = rsqrtf(ss * (1.f / 128.f) + EPS);
    __syncthreads();
#pragma unroll
    for (int e = 0; e < 16; ++e) AO[row * 2048 + 1024 + h * 128 + chn * 16 + e] = f2bf(res[e] * rstd * subg[chn * 16 + e] * 0.8f);
}
__global__ void __launch_bounds__(256) k_convact(const bf16_t* __restrict__ UP, int m0, const float* __restrict__ cw, const float* __restrict__ cb, bf16_t* __restrict__ ACT) {
    const int j = blockIdx.x * 256 + threadIdx.x, r = blockIdx.y; const int s = (m0 + r) % SEQ;
    float v = cb[j], g = cb[DFF + j];
#pragma unroll
    for (int k = 0; k < 3; ++k) { const int ss = s + k - 1; if (ss >= 0 && ss < SEQ) { v += cw[k * 2 * DFF + j] * bf2f(UP[(size_t)(r + k - 1) * 5632 + j]); g += cw[k * 2 * DFF + DFF + j] * bf2f(UP[(size_t)(r + k - 1) * 5632 + DFF + j]); } }
    ACT[(size_t)(m0 + r) * DFF + j] = f2bf(g / (1.f + __expf(-g)) * v);
}

#ifndef NAIVE_MASK
#define NAIVE_MASK 0x0
#endif
#ifndef ONE_LAUNCH
#define ONE_LAUNCH 1
#endif
extern "C" void kernel_launch(void* const* d_in, const int* in_sizes, int n_in, void* d_out, int out_size, void* d_ws, size_t ws_size, hipStream_t stream) {
    static int grid = 0;
    if (grid == 0) {
        if (n_in != 28 || in_sizes[0] != M * DM || out_size != M * DM || ws_size < WS_NEED) { fprintf(stderr, "kernel_launch: unexpected shapes (n_in %d, in0 %d, out %d, ws %zu); nothing launched\n", n_in, n_in > 0 ? in_sizes[0] : -1, out_size, ws_size); grid = -1; return; }
        int dev = 0, cus = 0, per_cu = 0;
        if (hipGetDevice(&dev) != hipSuccess || hipDeviceGetAttribute(&cus, hipDeviceAttributeMultiprocessorCount, dev) != hipSuccess) { grid = -1; return; }
        if (hipFuncSetAttribute((const void*)mk_fwd, hipFuncAttributeMaxDynamicSharedMemorySize, LDS_BYTES) != hipSuccess) { fprintf(stderr, "kernel_launch: hipFuncSetAttribute failed\n"); grid = -1; return; }
        if (hipOccupancyMaxActiveBlocksPerMultiprocessor(&per_cu, (const void*)mk_fwd, NWAVES * 64, LDS_BYTES) != hipSuccess || per_cu < 1) fprintf(stderr, "kernel_launch: occupancy query says %d\n", per_cu);
        (void)hipGetLastError();
        grid = cus;
        if (grid != 256) fprintf(stderr, "kernel_launch: %d CUs; built for 256\n", grid);
    }
    if (grid < 0) return;
    (void)hipMemsetAsync((char*)d_ws + WS_CTL, 0, CTL_ZERO_BYTES, stream);
    Args a{};
    for (int i = 0; i < 28; ++i) a.in[i] = d_in[i];
    a.out = (float*)d_out; a.ws = (unsigned char*)d_ws;
    int li = 0;
    auto L = [&](int lo, int hi, int flags) { a.ph_lo = lo; a.ph_hi = hi; a.li = li++; a.pad = flags; hipLaunchKernelGGL(mk_fwd, dim3(grid), dim3(NWAVES * 64), LDS_BYTES, stream, a); };
#if ONE_LAUNCH && (NAIVE_MASK == 0)
    L(0, N_PHASES, 3);
#else
    const float* x = (const float*)d_in[0]; const float* c = (const float*)d_in[1]; const int* pos = (const int*)d_in[2];
    const float* w_ada = (const float*)d_in[3]; const float* b_ada = (const float*)d_in[4]; const float* norm1_g = (const float*)d_in[5]; const float* w_in = (const float*)d_in[6];
    const float* conv_rnn_w = (const float*)d_in[7]; const float* conv_rnn_b = (const float*)d_in[8]; const float* w_rg_a = (const float*)d_in[9]; const float* b_rg_a = (const float*)d_in[10];
    const float* w_rg_i = (const float*)d_in[11]; const float* b_rg_i = (const float*)d_in[12]; const float* rg_lambda = (const float*)d_in[13]; const float* w_rnn_o = (const float*)d_in[14];
    const float* lq1 = (const float*)d_in[15]; const float* lk1 = (const float*)d_in[16]; const float* lq2 = (const float*)d_in[17]; const float* lk2 = (const float*)d_in[18];
    const float* subln_g = (const float*)d_in[19]; const float* w_attn_o = (const float*)d_in[20]; const float* w_out = (const float*)d_in[21]; const float* norm2_g = (const float*)d_in[22];
    const float* w_up = (const float*)d_in[23]; const float* conv_ffn_w = (const float*)d_in[24]; const float* conv_ffn_b = (const float*)d_in[25]; const float* w_down = (const float*)d_in[26];
    const float* final_g = (const float*)d_in[27];
    unsigned char* ws = (unsigned char*)d_ws; float* out = (float*)d_out;
    float* MOD = (float*)(ws + WS_MOD); float* COS = (float*)(ws + WS_COS); float* SIN = (float*)(ws + WS_SIN);
    bf16_t* H = (bf16_t*)(ws + WS_H); bf16_t* XR = (bf16_t*)(ws + WS_XR); bf16_t* AO = (bf16_t*)(ws + WS_AO); bf16_t* KB = (bf16_t*)(ws + WS_K); bf16_t* VB = (bf16_t*)(ws + WS_V);
    bf16_t* HF = (bf16_t*)(ws + WS_HF); bf16_t* GT = (bf16_t*)d_out; bf16_t* MG = XR; bf16_t* UP = (bf16_t*)(ws + WS_UP); bf16_t* ACT = (bf16_t*)(ws + WS_ACT);
    constexpr int NM = NAIVE_MASK;
    L(P_PRO, P_PRO + 1, 3);
    if (NM & 1) { k_mod<<<dim3(NMODC / 256, BATCH), 256, 0, stream>>>(c, w_ada, b_ada, MOD, lq1, lk1, lq2, lk2); k_rope_tab<<<M * 8 / 256, 256, 0, stream>>>(pos, COS, SIN); }
    if (NM & 2) k_normmod<<<M / 4, 256, 0, stream>>>(x, norm1_g, MOD, 0, 1024, H); else L(P_NORM1, P_NORM1 + 1, 3);
    if (NM & 4) { nv_gemm<EProj><<<dim3(INCOLS / 64, M / 64), 256, 0, stream>>>(H, DM, w_in, INCOLS, DM, EProj{XR, AO, KB, VB, GT}); k_rope<<<M * 16 / 256, 256, 0, stream>>>(AO, KB, COS, SIN); }
    else L(P_PROJ, P_PROJ + 1, 3);
    if (NM & 8) nv_rglru<<<dim3(16, BATCH), 64, 0, stream>>>(XR, AO, HF, conv_rnn_w, conv_rnn_b, w_rg_a, b_rg_a, w_rg_i, b_rg_i, rg_lambda); else L(P_MIX, P_MIX + 1, 1);
    if (NM & 16) nv_attn<<<dim3(SEQ / 32, 8, BATCH), 256, 0, stream>>>(AO, KB, VB, subln_g, MOD + BATCH * NMODC); else L(P_MIX, P_MIX + 1, 2);
    if (NM & 32) { nv_gemm<EMergeA><<<dim3(DM / 64, M / 64), 256, 0, stream>>>(AO, 2048, w_rnn_o, DM, DM, EMergeA{GT, MG}); nv_gemm<EMergeB><<<dim3(DM / 64, M / 64), 256, 0, stream>>>(AO + 1024, 2048, w_attn_o, DM, DM, EMergeB{GT, MG}); }
    else L(P_MERGE, P_MERGE + 1, 3);
    if (NM & 64) nv_gemm<EOut><<<dim3(DM / 64, M / 64), 256, 0, stream>>>(MG, DM, w_out, DM, DM, EOut{x, MOD, out}); else L(P_OUT, P_OUT + 1, 3);
    if (NM & 128) k_normmod<<<M / 4, 256, 0, stream>>>(out, norm2_g, MOD, 3072, 4096, H); else L(P_NORM2, P_NORM2 + 1, 3);
    if (NM & 256) { for (int half = 0; half < 2; ++half) { const int m0 = half * (M / 2);
            nv_gemm<EUp><<<dim3(2 * DFF / 64, M / 2 / 64), 256, 0, stream>>>(H + (size_t)m0 * DM, DM, w_up, 2 * DFF, DM, EUp{UP});
            k_convact<<<dim3(DFF / 256, M / 2), 256, 0, stream>>>(UP, m0, conv_ffn_w, conv_ffn_b, ACT); } }
    else { L(P_UP, P_UP + 1, 3); L(P_FIX, P_FIX + 1, 3); }
    if (NM & 512) nv_gemm<EDown><<<dim3(DM / 64, M / 64), 256, 0, stream>>>(ACT, DFF, w_down, DM, DFF, EDown{out, MOD}); else L(P_DOWN, P_DOWN + 1, 3);
    if (NM & 1024) k_final<<<M / 4, 256, 0, stream>>>(out, final_g); else L(P_FINAL, P_FINAL + 1, 3);
#endif
}
```

```cpp
#include <hip/hip_runtime.h>
#include <hip/hip_bf16.h>
#include <cstdint>
#include <cstdio>
#include <cmath>

namespace pg8 {
#define PG8_LAS __attribute__((address_space(3)))
typedef unsigned short bf16_t;
typedef short bf16x8 __attribute__((ext_vector_type(8)));
typedef float f32x4 __attribute__((ext_vector_type(4)));
typedef unsigned u32x4 __attribute__((ext_vector_type(4)));
constexpr int BM = 256, BK = 64, HALF = 128, HTB = HALF * BK * 2  , STAGE_BYTES = 8 * HTB, NXCD = 8, WGM = 8;

__host__ __device__ __forceinline__ int lds_byte(int r, int c) { const int st = (r >> 4) * 2 + (c >> 5), rr = r & 15, cc = c & 31, ob = rr * 64 + cc * 2; return st * 1024 + (ob ^ (((ob >> 9) & 1) << 5)); }
__host__ __device__ __forceinline__ void stage_rc(int b, int& R, int& C) { const int st = b / 1024, sb = b % 1024, swz = sb ^ (((sb >> 9) & 1) << 5); R = (st >> 1) * 16 + swz / 64; C = (st & 1) * 32 + (swz % 64) / 2; }
__host__ __device__ __forceinline__ int perm32(int rho) { const int n = rho >> 4, i = rho & 15; return 8 * (i >> 2) + 4 * n + (i & 3); }

struct Unit { int pm, pn; };
struct Gemm { const bf16_t* A; const bf16_t* Bt; int M, N, K, lda; };

struct StaticOrder {
    int nM, nN, nwg, G, c;
    __host__ __device__ void init(int M, int N, int G_, int c_) { nM = M / BM; nN = N / BM; nwg = nM * nN; G = G_; c = c_; }
    __host__ __device__ bool next(int i, Unit& u) const {
        const long L = (long)i * G + c; if (L >= nwg) return false;
        int wgid = (int)L; { const int q = nwg / NXCD, r = nwg % NXCD, xcd = wgid % NXCD, off = wgid / NXCD; wgid = (xcd < r ? xcd * (q + 1) : r * (q + 1) + (xcd - r) * q) + off; }
        const int nig = WGM * nN, gid = wgid / nig, fm = gid * WGM, gsz = (nM - fm) < WGM ? (nM - fm) : WGM;
        u.pm = fm + ((wgid % nig) % gsz); u.pn = (wgid % nig) / gsz; return true;
    }
    __device__ __forceinline__ void a_ready(const Unit&) const {}
    __device__ __forceinline__ void done(const Unit&) const {}
};

__device__ __forceinline__ unsigned cvt_pk_bf16(float lo, float hi) { unsigned r; asm volatile("v_cvt_pk_bf16_f32 %0, %1, %2" : "=v"(r) : "v"(lo), "v"(hi)); return r; }
template <class Epi, class Sched, bool ALIGN_EPI = false, bool SP2 = false>
__device__ __forceinline__ void gemm_phase(PG8_LAS unsigned char* lds, const Gemm g, const Sched& S, const Epi& E) {
    const int tid = threadIdx.x, wid = __builtin_amdgcn_readfirstlane(tid >> 6), lane = tid & 63, wr = wid >> 2, wc = wid & 3, fr = lane & 15, fq = lane >> 4;
    const int K = g.K, nt = K / BK;
    unsigned voffA[2], voffB[2];
#pragma unroll
    for (int i = 0; i < 2; ++i) { int R, C; stage_rc(tid * 16 + i * 8192, R, C); const int Rb = Epi::PERM ? ((R & ~31) + perm32(R & 31)) : R;
        voffA[i] = (unsigned)(R * g.lda + C) * 2u; voffB[i] = (unsigned)(Rb * K + C) * 2u; }
    const size_t kstep = (size_t)(BK * 2);
    const size_t hstepB = (size_t)HALF * K * 2, hstepA = (size_t)HALF * g.lda * 2;
    const size_t tstepA = 2 * hstepA, tstepB = 2 * hstepB;
    const unsigned ldsw = (unsigned)wid * 1024u;
    const int aoff = lds_byte(wr * 64 + fr, fq * 8), boff = lds_byte(wc * 32 + fr, fq * 8);
#define PG8_SA(b, h) (((b) * 2 + (h)) * HTB)
#define PG8_SB(b, h) ((4 + (b) * 2 + (h)) * HTB)
#define PG8_STAGE(bufoff, gbase, voff) do { _Pragma("unroll") for (int _i = 0; _i < 2; ++_i) \
        __builtin_amdgcn_global_load_lds((const unsigned*)((const char*)(gbase) + (voff)[_i]), (PG8_LAS unsigned*)(lds + (bufoff) + ldsw + _i * 8192), 16, 0, 0); } while (0)
#define PG8_LDA(dst, b, h) do { _Pragma("unroll") for (int m = 0; m < 4; ++m) _Pragma("unroll") for (int k = 0; k < 2; ++k) dst[m][k] = *(const PG8_LAS bf16x8*)(lds + PG8_SA(b, h) + aoff + m * 2048 + k * 1024); } while (0)
#define PG8_LDB(dst, b, h) do { _Pragma("unroll") for (int n = 0; n < 2; ++n) _Pragma("unroll") for (int k = 0; k < 2; ++k) dst[n][k] = *(const PG8_LAS bf16x8*)(lds + PG8_SB(b, h) + boff + n * 2048 + k * 1024); } while (0)
#define PG8_MMA(ai, bj, At, Bt) do { __builtin_amdgcn_s_setprio(1); _Pragma("unroll") for (int m = 0; m < 4; ++m) _Pragma("unroll") for (int n = 0; n < 2; ++n) _Pragma("unroll") for (int k = 0; k < 2; ++k) \
        acc[ai][bj][m][n] = __builtin_amdgcn_mfma_f32_16x16x32_bf16(Bt[n][k], At[m][k], acc[ai][bj][m][n], 0, 0, 0); __builtin_amdgcn_s_setprio(0); } while (0)
#define PG8_WAIT_V(n) asm volatile("s_waitcnt vmcnt(" #n ")" ::: "memory")
#define PG8_WAIT_L(n) asm volatile("s_waitcnt lgkmcnt(" #n ")" ::: "memory")
#define PG8_BAR __builtin_amdgcn_s_barrier()
#define PG8_SCHED __builtin_amdgcn_sched_barrier(0)
    Unit cur, nxt; int ui = 0;
    if (!S.next(0, cur)) return;
    f32x4 acc[2][2][4][2];
#pragma unroll
    for (int a = 0; a < 2; ++a)
#pragma unroll
        for (int b = 0; b < 2; ++b)
#pragma unroll
            for (int m = 0; m < 4; ++m)
#pragma unroll
                for (int n = 0; n < 2; ++n) acc[a][b][m][n] = (f32x4){0.f, 0.f, 0.f, 0.f};
    bf16x8 At[4][2], B0[2][2], B1[2][2];
    const char* cA = (const char*)g.A + (size_t)cur.pm * tstepA; const char* cB = (const char*)g.Bt + (size_t)cur.pn * tstepB;
    S.a_ready(cur);
    if constexpr (SP2) {
        PG8_STAGE(PG8_SB(0, 0), cB, voffB); PG8_STAGE(PG8_SB(0, 1), cB + hstepB, voffB); PG8_STAGE(PG8_SA(0, 0), cA, voffA); PG8_STAGE(PG8_SA(0, 1), cA + hstepA, voffA);
        if (wr == 1) PG8_BAR;
        PG8_WAIT_V(2); PG8_BAR;
        PG8_STAGE(PG8_SB(1, 0), cB + kstep, voffB); PG8_STAGE(PG8_SA(1, 0), cA + kstep, voffA); PG8_STAGE(PG8_SB(1, 1), cB + hstepB + kstep, voffB);
        PG8_WAIT_V(6); PG8_BAR;
    } else {
        PG8_STAGE(PG8_SB(0, 0), cB, voffB); PG8_STAGE(PG8_SA(0, 0), cA, voffA); PG8_STAGE(PG8_SB(0, 1), cB + hstepB, voffB); PG8_STAGE(PG8_SA(0, 1), cA + hstepA, voffA);
        if (wr == 1) PG8_BAR;
        PG8_WAIT_V(4); PG8_BAR;
        PG8_STAGE(PG8_SB(1, 0), cB + kstep, voffB); PG8_STAGE(PG8_SA(1, 0), cA + kstep, voffA); PG8_STAGE(PG8_SB(1, 1), cB + hstepB + kstep, voffB);
        PG8_WAIT_V(6); PG8_BAR;
    }
    for (;;) {
        const bool has_next = S.next(ui + 1, nxt);
        const char* nA = has_next ? (const char*)g.A + (size_t)nxt.pm * tstepA : cA; const char* nB = has_next ? (const char*)g.Bt + (size_t)nxt.pn * tstepB : cB;
        for (int t = 0; t < nt; t += 2) {
            if constexpr (Epi::HAS_MID) { if (t == nt / 2) E.mid(acc, cur, wr, wc, fr, fq); }
            const bool last = (t == nt - 2);
            const char* a1 = cA + (size_t)(t + 1) * kstep;
            const char* a2 = last ? nA : cA + (size_t)(t + 2) * kstep; const char* b2 = last ? nB : cB + (size_t)(t + 2) * kstep;
            const char* a3 = a2 + kstep; const char* b3 = b2 + kstep;
            if (last && has_next) S.a_ready(nxt);
            if constexpr (SP2) {
            PG8_LDB(B0, 0, 0); PG8_LDB(B1, 0, 1); PG8_SCHED; PG8_LDA(At, 0, 0); PG8_STAGE(PG8_SA(1, 1), a1 + hstepA, voffA);
            PG8_WAIT_V(8); PG8_WAIT_L(0); PG8_BAR; PG8_MMA(0, 0, At, B0); PG8_MMA(0, 1, At, B1); PG8_BAR; PG8_SCHED;
            PG8_LDA(At, 0, 1); PG8_STAGE(PG8_SB(0, 0), b2, voffB); PG8_STAGE(PG8_SB(0, 1), b2 + hstepB, voffB); PG8_STAGE(PG8_SA(0, 0), a2, voffA);
            PG8_WAIT_V(8); PG8_WAIT_L(0); PG8_BAR; PG8_MMA(1, 0, At, B0); PG8_MMA(1, 1, At, B1); PG8_BAR; PG8_SCHED;
            PG8_LDB(B0, 1, 0); PG8_LDB(B1, 1, 1); PG8_SCHED; PG8_LDA(At, 1, 0); PG8_STAGE(PG8_SA(0, 1), a2 + hstepA, voffA);
            PG8_WAIT_V(8); PG8_WAIT_L(0); PG8_BAR; PG8_MMA(0, 0, At, B0); PG8_MMA(0, 1, At, B1); PG8_BAR; PG8_SCHED;
            PG8_LDA(At, 1, 1); PG8_STAGE(PG8_SB(1, 0), b3, voffB); PG8_STAGE(PG8_SB(1, 1), b3 + hstepB, voffB); PG8_STAGE(PG8_SA(1, 0), a3, voffA);
            PG8_WAIT_V(8); PG8_WAIT_L(0); PG8_BAR; PG8_MMA(1, 0, At, B0); PG8_MMA(1, 1, At, B1); PG8_BAR; PG8_SCHED;
            } else {
            PG8_LDB(B0, 0, 0); PG8_SCHED; PG8_LDA(At, 0, 0); PG8_STAGE(PG8_SA(1, 1), a1 + hstepA, voffA);
            PG8_WAIT_L(8); PG8_BAR; PG8_WAIT_L(0); PG8_MMA(0, 0, At, B0); PG8_BAR; PG8_SCHED;
            PG8_LDB(B1, 0, 1); PG8_STAGE(PG8_SB(0, 0), b2, voffB);
            PG8_BAR; PG8_WAIT_L(0); PG8_MMA(0, 1, At, B1); PG8_BAR;
            PG8_LDA(At, 0, 1); PG8_STAGE(PG8_SA(0, 0), a2, voffA);
            PG8_BAR; PG8_WAIT_L(0); PG8_MMA(1, 0, At, B0); PG8_BAR; PG8_SCHED;
            PG8_STAGE(PG8_SB(0, 1), b2 + hstepB, voffB);
            PG8_WAIT_V(6); PG8_BAR; PG8_MMA(1, 1, At, B1); PG8_BAR;
            PG8_LDB(B0, 1, 0); PG8_SCHED; PG8_LDA(At, 1, 0); PG8_STAGE(PG8_SA(0, 1), a2 + hstepA, voffA);
            PG8_WAIT_L(8); PG8_BAR; PG8_WAIT_L(0); PG8_MMA(0, 0, At, B0); PG8_BAR; PG8_SCHED;
            PG8_LDB(B1, 1, 1); PG8_STAGE(PG8_SB(1, 0), b3, voffB);
            PG8_BAR; PG8_WAIT_L(0); PG8_MMA(0, 1, At, B1); PG8_BAR;
            PG8_LDA(At, 1, 1); PG8_STAGE(PG8_SA(1, 0), a3, voffA);
            PG8_BAR; PG8_WAIT_L(0); PG8_MMA(1, 0, At, B0); PG8_BAR; PG8_SCHED;
            PG8_STAGE(PG8_SB(1, 1), b3 + hstepB, voffB);
            PG8_WAIT_V(6); PG8_BAR; PG8_MMA(1, 1, At, B1); PG8_BAR;
            }
        }
        if constexpr (ALIGN_EPI) { if (wr == 0) PG8_BAR; }
        if constexpr (!Epi::AFTER_DRAIN) { E(acc, cur, wr, wc, fr, fq); S.done(cur); }
        if (!has_next) break;
#pragma unroll
        for (int a = 0; a < 2; ++a)
#pragma unroll
            for (int b = 0; b < 2; ++b)
#pragma unroll
                for (int m = 0; m < 4; ++m)
#pragma unroll
                    for (int n = 0; n < 2; ++n) acc[a][b][m][n] = (f32x4){0.f, 0.f, 0.f, 0.f};
        cur = nxt; cA = nA; cB = nB; ++ui;
        if constexpr (ALIGN_EPI) { if (wr == 1) PG8_BAR; }
    }
    PG8_WAIT_V(0);
    if constexpr (!ALIGN_EPI) { if (wr == 0) PG8_BAR; }
    PG8_BAR;
    if constexpr (Epi::AFTER_DRAIN) { E.fused(acc, cur, wr, wc, fr, fq, lds, wid, lane); S.done(cur); }
#undef PG8_SA
#undef PG8_SB
#undef PG8_STAGE
#undef PG8_LDA
#undef PG8_LDB
#undef PG8_MMA
#undef PG8_WAIT_V
#undef PG8_WAIT_L
#undef PG8_BAR
#undef PG8_SCHED
}
}
#ifndef PG8_SP2
#define PG8_SP2 true
#endif
#ifndef PG8_ALIGN
#define PG8_ALIGN true
#endif

typedef unsigned short bf16_t;
constexpr int DM = 1024, BATCH = 16, SEQ = 2048, M = BATCH * SEQ, INCOLS = 7168, DFF = 2816, NMODC = 6 * DM;
constexpr float EPS = 1e-6f;
constexpr float C2 = 0.125f * 1.4426950408889634f;
constexpr size_t MiB = 1u << 20;
constexpr size_t WS_CTL = 0, CTL_ZERO_BYTES = 1 * MiB;
constexpr size_t WS_MOD = 1 * MiB, WS_COS = 2 * MiB, WS_SIN = 3 * MiB;
constexpr size_t WS_WIN = 4 * MiB, WS_WA = 18 * MiB, WS_WB = 20 * MiB, WS_WOUT = 22 * MiB, WS_WUP = 24 * MiB, WS_WDOWN = 35 * MiB;
constexpr size_t WS_H = 48 * MiB, WS_XR = 112 * MiB, WS_AO = 176 * MiB, WS_K = 304 * MiB, WS_V = 368 * MiB, WS_HF = 432 * MiB;
constexpr size_t WS_UP = 112 * MiB, WS_ACT = 288 * MiB, WS_EDGE = 112 * MiB;
constexpr size_t WS_NEED = 512 * MiB;
constexpr int CW_TMO = 0, CW_CODE = 1, CW_BAR = 4096;

constexpr int NWAVES = 8;
constexpr int RING_OFF = 0, RING_BYTES = 131072, LDSCTL_OFF = RING_BYTES, MISC_OFF = LDSCTL_OFF + 320, LDS_BYTES = 147456;

#define GAS __attribute__((address_space(1)))
#define LAS __attribute__((address_space(3)))
typedef unsigned v4u __attribute__((ext_vector_type(4)));
typedef unsigned v2u __attribute__((ext_vector_type(2)));
typedef float f32x4 __attribute__((ext_vector_type(4)));
typedef float f32x2 __attribute__((ext_vector_type(2)));
typedef short bf16x8 __attribute__((ext_vector_type(8)));
typedef GAS unsigned gu32;
#define RLX_AGENT __ATOMIC_RELAXED, __HIP_MEMORY_SCOPE_AGENT
#define LDS_WAIT() asm volatile("s_waitcnt lgkmcnt(0)" ::: "memory")
#define VM_WAIT() asm volatile("s_waitcnt vmcnt(0)" ::: "memory")

__device__ __forceinline__ float bf2f(bf16_t v) { return __uint_as_float((unsigned)v << 16); }
__device__ __forceinline__ unsigned f2bfu(float f) { unsigned u = __float_as_uint(f); return (u + 0x7fffu + ((u >> 16) & 1u)) >> 16; }
__device__ __forceinline__ bf16_t f2bf(float f) { return (bf16_t)f2bfu(f); }
__device__ __forceinline__ unsigned pk2(float lo, float hi) { return pg8::cvt_pk_bf16(lo, hi); }
__device__ __forceinline__ float lo_bf(unsigned w) { return __uint_as_float(w << 16); }
__device__ __forceinline__ float hi_bf(unsigned w) { return __uint_as_float(w & 0xffff0000u); }
__device__ __forceinline__ float fexp(float x) { return __builtin_amdgcn_exp2f(x * 1.4426950408889634f); }
__device__ __forceinline__ float frcp(float x) { return __builtin_amdgcn_rcpf(x); }
__device__ __forceinline__ float sigmoidf_(float x) { return frcp(1.f + fexp(-x)); }
__device__ __forceinline__ float gelu_tanh(float x) { const float u = 1.5957691216057308f * (x + 0.044715f * x * x * x); return x * frcp(1.f + fexp(-u)); }
__device__ __forceinline__ float wave_sum(float v) {
#pragma unroll
    for (int o = 1; o < 64; o <<= 1) v += __shfl_xor(v, o);
    return v;
}
typedef pg8::f32x4 (&AccRef)[2][2][4][2];
typedef const pg8::f32x4 (&AccCRef)[2][2][4][2];

#ifndef EPI_NT
#define EPI_NT 0
#endif
#if EPI_NT
#define ST16(p, v) __builtin_nontemporal_store((v), (v4u*)(p))
#else
#define ST16(p, v) (*(v4u*)(p) = (v))
#endif
struct EpiProj {
    static constexpr bool PERM = true, AFTER_DRAIN = false, HAS_MID = false;
    bf16_t *XR, *AO, *KB, *VB, *GT; const float *COS, *SIN; bf16_t* local;
    __device__ __forceinline__ void operator()(AccCRef acc, const pg8::Unit& u, int wr, int wc, int fr, int fq) const {
        const int pn = u.pn; bf16_t* base; int ldc, colt; float sc = 1.f; bool rope = false;
        if (pn < 4) { base = XR; ldc = 1024; colt = pn * 256; }
        else if (pn < 8) { base = AO; ldc = 2048; colt = (pn - 4) * 256; }
        else if (pn < 12) { base = AO + 1024; ldc = 2048; colt = (pn - 8) * 256; sc = C2; rope = true; }
        else if (pn < 16) { base = KB; ldc = 1024; colt = (pn - 12) * 256; rope = true; }
        else if (pn < 20) { base = VB; ldc = 1024; colt = (pn - 16) * 256; }
        else { base = GT; ldc = 2048; colt = (pn - 20) * 128; }
        const bool gates = pn >= 20;
        const bool dorope = rope && ((wc & 1) == 0);
        const int row0 = u.pm * 256 + wr * 64 + fr, col0 = colt + wc * 32 + 8 * fq;
        if (local) { base = local + (size_t)blockIdx.x * 65536 - (size_t)u.pm * 256 * 256 - colt; ldc = 256; }
#pragma unroll
        for (int ai = 0; ai < 2; ++ai)
#pragma unroll
            for (int m = 0; m < 4; ++m) {
                const int row = row0 + ai * 128 + m * 16;
                f32x4 c0 = {1.f, 1.f, 1.f, 1.f}, c1 = c0, s0 = {0.f, 0.f, 0.f, 0.f}, s1 = s0;
                if (dorope) { c0 = *(const f32x4*)(COS + (size_t)row * 8); c1 = *(const f32x4*)(COS + (size_t)row * 8 + 4); s0 = *(const f32x4*)(SIN + (size_t)row * 8); s1 = *(const f32x4*)(SIN + (size_t)row * 8 + 4);
                    if (fq == 0) { s0 = -s0; s1 = -s1; } if (fq >= 2) { c0 = (f32x4){1.f, 1.f, 1.f, 1.f}; c1 = c0; s0 = (f32x4){0.f, 0.f, 0.f, 0.f}; s1 = s0; } }
#pragma unroll
                for (int bj = 0; bj < 2; ++bj) {
                    f32x4 v0 = acc[ai][bj][m][0], v1 = acc[ai][bj][m][1];
                    if (dorope) { f32x4 p0, p1;
#pragma unroll
                        for (int e = 0; e < 4; ++e) { p0[e] = __shfl_xor(v0[e], 16); p1[e] = __shfl_xor(v1[e], 16); }
                        v0 = v0 * c0 + p0 * s0; v1 = v1 * c1 + p1 * s1; }
                    v0 = v0 * sc; v1 = v1 * sc;
                    if (gates) {
                        const f32x4 a0 = acc[ai][0][m][0], a1 = acc[ai][0][m][1], b0 = acc[ai][1][m][0], b1 = acc[ai][1][m][1];
#pragma unroll
                        for (int e = 0; e < 4; ++e) { const float eb0 = 1.f + fexp(-b0[e]), eb1 = 1.f + fexp(-b1[e]);
                            if (bj == 0) { v0[e] = eb0 * frcp(1.f + fexp(-a0[e])); v1[e] = eb1 * frcp(1.f + fexp(-a1[e])); } else { v0[e] = frcp(eb0); v1[e] = frcp(eb1); } }
                    }
                    v4u w; w.x = pk2(v0[0], v0[1]); w.y = pk2(v0[2], v0[3]); w.z = pk2(v1[0], v1[1]); w.w = pk2(v1[2], v1[3]);
#if defined(PROBE_FULLLINE)
                    if (local) { ST16(base + (size_t)(row - (fr >> 1) - (fr & 1)) * ldc + colt + wc * 64 + (fr & 1) * 32 + 8 * fq + bj * 128, w); } else
#endif
                    ST16(base + (size_t)row * ldc + col0 + bj * (gates ? 1024 : 128), w);
                }
            }
    }
};
typedef pg8::f32x4 (&AccMRef)[2][2][4][2];
struct EpiMerge {
    static constexpr bool PERM = true, AFTER_DRAIN = false, HAS_MID = true;
    const bf16_t* GT; bf16_t* MG;
    __device__ __forceinline__ void mid(AccMRef acc, const pg8::Unit& u, int wr, int wc, int fr, int fq) const {
        int zero = 0; asm volatile("" : "+v"(zero));
        const bf16_t* gp = GT + (size_t)(u.pm * 256 + wr * 64 + fr) * 2048 + u.pn * 256 + wc * 32 + 8 * fq + zero;
#pragma unroll
        for (int ai = 0; ai < 2; ++ai)
#pragma unroll
            for (int m = 0; m < 4; ++m) {
#pragma unroll
                for (int bj = 0; bj < 2; ++bj) {
                    const v4u g = *(const v4u*)(gp + (size_t)(ai * 128 + m * 16) * 2048 + bj * 128);
                    acc[ai][bj][m][0][0] *= lo_bf(g.x); acc[ai][bj][m][0][1] *= hi_bf(g.x); acc[ai][bj][m][0][2] *= lo_bf(g.y); acc[ai][bj][m][0][3] *= hi_bf(g.y);
                    acc[ai][bj][m][1][0] *= lo_bf(g.z); acc[ai][bj][m][1][1] *= hi_bf(g.z); acc[ai][bj][m][1][2] *= lo_bf(g.w); acc[ai][bj][m][1][3] *= hi_bf(g.w);
                }
                if (m & 1) asm volatile("" ::: "memory");
            }
    }
    __device__ __forceinline__ void operator()(AccCRef acc, const pg8::Unit& u, int wr, int wc, int fr, int fq) const {
        const int row0 = u.pm * 256 + wr * 64 + fr, col0 = u.pn * 256 + wc * 32 + 8 * fq;
#pragma unroll
        for (int ai = 0; ai < 2; ++ai)
#pragma unroll
            for (int m = 0; m < 4; ++m) {
                const int row = row0 + ai * 128 + m * 16;
#pragma unroll
                for (int bj = 0; bj < 2; ++bj) {
                    const v4u g = *(const v4u*)(GT + (size_t)row * 2048 + 1024 + col0 + bj * 128);
                    const f32x4 v0 = acc[ai][bj][m][0], v1 = acc[ai][bj][m][1];
                    v4u w; w.x = pk2(lo_bf(g.x) * v0[0], hi_bf(g.x) * v0[1]); w.y = pk2(lo_bf(g.y) * v0[2], hi_bf(g.y) * v0[3]);
                    w.z = pk2(lo_bf(g.z) * v1[0], hi_bf(g.z) * v1[1]); w.w = pk2(lo_bf(g.w) * v1[2], hi_bf(g.w) * v1[3]);
                    *(v4u*)(MG + (size_t)row * 1024 + col0 + bj * 128) = w;
                }
            }
    }
};
struct EpiResid {
    static constexpr bool PERM = false, AFTER_DRAIN = false, HAS_MID = false;
    const float* RES; float* OUT; const float* gate;
    __device__ __forceinline__ void operator()(AccCRef acc, const pg8::Unit& u, int wr, int wc, int fr, int fq) const {
        const int row0 = u.pm * 256 + wr * 64 + fr, col0 = u.pn * 256 + wc * 32 + 4 * fq; const float* gb = gate + (size_t)(u.pm >> 3) * NMODC;
        f32x4 gv[2][2];
#pragma unroll
        for (int bj = 0; bj < 2; ++bj)
#pragma unroll
            for (int n = 0; n < 2; ++n) gv[bj][n] = *(const f32x4*)(gb + col0 + bj * 128 + n * 16);
#pragma unroll
        for (int ai = 0; ai < 2; ++ai)
#pragma unroll
            for (int m = 0; m < 4; ++m) { const size_t off = (size_t)(row0 + ai * 128 + m * 16) * 1024 + col0;
#pragma unroll
                for (int bj = 0; bj < 2; ++bj)
#pragma unroll
                    for (int n = 0; n < 2; ++n) { const f32x4 r = *(const f32x4*)(RES + off + bj * 128 + n * 16); *(f32x4*)(OUT + off + bj * 128 + n * 16) = r + gv[bj][n] * acc[ai][bj][m][n]; }
                if (m & 1) asm volatile("" ::: "memory"); }
    }
};
template <int CTRL> __device__ __forceinline__ float dpp_rot(float v) { return __uint_as_float((unsigned)__builtin_amdgcn_update_dpp(0, (int)__float_as_uint(v), CTRL, 0xf, 0xf, false)); }
template <int CTRL> __device__ __forceinline__ float dpp_upd(float old, float v) { return __uint_as_float((unsigned)__builtin_amdgcn_update_dpp((int)__float_as_uint(old), (int)__float_as_uint(v), CTRL, 0xf, 0xf, false)); }
struct EpiUpConv {
    static constexpr bool PERM = true, AFTER_DRAIN = false, HAS_MID = false;
    bf16_t* ACT; float* EDGE; const float* cw; const float* cb;
    __device__ __forceinline__ void operator()(AccCRef acc, const pg8::Unit& u, int wr, int wc, int fr, int fq) const {
        const int jj = wc * 32 + 8 * fq, j = u.pn * 128 + jj;
        const int pc = u.pn * 256 + jj;
#pragma unroll
        for (int ai = 0; ai < 2; ++ai) {
            const int band = u.pm * 4 + ai * 2 + wr; const int rowb = band * 64;
            if (fr < 2) {
#pragma unroll
                for (int bj = 0; bj < 2; ++bj)
#pragma unroll
                    for (int n = 0; n < 2; ++n) *(f32x4*)(EDGE + ((size_t)band * 4 + fr) * 5632 + pc + bj * 128 + 4 * n) = acc[ai][bj][0][n];
            }
            if (fr >= 14) {
#pragma unroll
                for (int bj = 0; bj < 2; ++bj)
#pragma unroll
                    for (int n = 0; n < 2; ++n) *(f32x4*)(EDGE + ((size_t)band * 4 + fr - 12) * 5632 + pc + bj * 128 + 4 * n) = acc[ai][bj][3][n];
            }
            v2u pk0[4];
#pragma unroll
            for (int n = 0; n < 2; ++n) {
                float oe[4][4];
#pragma unroll
                for (int e = 0; e < 4; ++e) {
                    float vv[4];
#pragma unroll
                    for (int bj = 0; bj < 2; ++bj) {
                        const int oc = bj * DFF + j + 4 * n + e;
                        const float w0 = cw[oc], w1 = cw[2 * DFF + oc], w2 = cw[4 * DFF + oc], bs = cb[oc];
#pragma unroll
                        for (int m = 0; m < 4; ++m) {
                            const float cur = acc[ai][bj][m][n][e], pvs = acc[ai][bj][m > 0 ? m - 1 : 0][n][e], nxs = acc[ai][bj][m < 3 ? m + 1 : 3][n][e];
                            const float pv = dpp_upd<0x111>(dpp_rot<0x121>(pvs), cur), nx = dpp_upd<0x101>(dpp_rot<0x12F>(nxs), cur);
                            const float r = bs + w0 * pv + w1 * cur + w2 * nx;
                            if (bj == 0) vv[m] = r; else oe[m][e] = r * frcp(1.f + fexp(-r)) * vv[m];
                        }
                    }
                }
#pragma unroll
                for (int m = 0; m < 4; ++m) {
                    v2u w; w.x = pk2(oe[m][0], oe[m][1]); w.y = pk2(oe[m][2], oe[m][3]);
                    if (n == 0) pk0[m] = w;
                    else { const bool skip = (m == 0 && fr == 0) || (m == 3 && fr == 15); v4u w4; w4.x = pk0[m].x; w4.y = pk0[m].y; w4.z = w.x; w4.w = w.y;
                        if (!skip) *(v4u*)(ACT + (size_t)(rowb + m * 16 + fr) * DFF + j) = w4; }
                }
                asm volatile("" ::: "memory");
            }
        }
    }
};
struct EpiNull {
    static constexpr bool PERM = true, AFTER_DRAIN = false, HAS_MID = false; float* sink;
    __device__ __forceinline__ void operator()(AccCRef acc, const pg8::Unit& u, int wr, int wc, int fr, int fq) const {
        f32x4 s = {0.f, 0.f, 0.f, 0.f};
#pragma unroll
        for (int ai = 0; ai < 2; ++ai)
#pragma unroll
            for (int bj = 0; bj < 2; ++bj)
#pragma unroll
                for (int m = 0; m < 4; ++m)
#pragma unroll
                    for (int n = 0; n < 2; ++n) s += acc[ai][bj][m][n];
        if (s[0] + s[1] + s[2] + s[3] == 123.456f) *(f32x4*)(sink + (size_t)(u.pm * 4096 + u.pn * 16 + fr)) = s;
    }
};
namespace att {
using bf16x8 = __attribute__((ext_vector_type(8))) short;
using s16x4  = __attribute__((ext_vector_type(4))) short;
using f32x16 = __attribute__((ext_vector_type(16))) float;
using u32x4  = __attribute__((ext_vector_type(4))) unsigned;
constexpr int KVBLK = 64, LDK = 1024, LDQ = 2048;
constexpr int SHM_V = 64 * 128 * 2, SHM_K = 64 * 128 * 2, WS_OFF = 2 * SHM_V + 2 * SHM_K, LDS_BYTES = WS_OFF + 8 * 64 * 4;
constexpr float THR2 = 6.0f;
#define KSWZ(row, colB) ((row) * 256 + ((colB) ^ (((row) & 7) << 4)))
#define SBAR() __builtin_amdgcn_sched_barrier(0)
__device__ __forceinline__ int crow(int r, int hi) { return (r & 3) + 8 * (r >> 2) + 4 * hi; }
__device__ __forceinline__ unsigned cvtpk(float lo, float hi) { unsigned r; asm volatile("v_cvt_pk_bf16_f32 %0, %1, %2" : "=v"(r) : "v"(lo), "v"(hi)); return r; }
__device__ __forceinline__ void partialSM(f32x16& p0, f32x16& p1, float& m_reg, float& alpha) {
    float pmax = p0[0];
#pragma unroll
    for (int r = 1; r < 16; ++r) pmax = fmaxf(pmax, p0[r]);
#pragma unroll
    for (int r = 0; r < 16; ++r) pmax = fmaxf(pmax, p1[r]);
    { auto rr = __builtin_amdgcn_permlane32_swap(__float_as_uint(pmax), __float_as_uint(pmax), false, false); pmax = fmaxf(__uint_as_float(rr[0]), __uint_as_float(rr[1])); }
    float mn;
    if (__builtin_expect(__all(pmax - m_reg <= THR2), 1)) { mn = m_reg; alpha = 1.f; }
    else { mn = fmaxf(m_reg, pmax); alpha = __builtin_amdgcn_exp2f(m_reg - mn); m_reg = mn; }
#pragma unroll
    for (int r = 0; r < 16; ++r) { p0[r] -= mn; p1[r] -= mn; }
#pragma unroll
    for (int r = 0; r < 16; ++r) p0[r] = __builtin_amdgcn_exp2f(p0[r]);
}
__device__ __forceinline__ void finishSM(f32x16& p0, f32x16& p1, float alpha, float& l_reg, bf16x8& pa0, bf16x8& pa1, bf16x8& pa2, bf16x8& pa3) {
#pragma unroll
    for (int r = 0; r < 16; ++r) p1[r] = __builtin_amdgcn_exp2f(p1[r]);
    float ps = 0;
#pragma unroll
    for (int r = 0; r < 16; ++r) ps += p0[r];
#pragma unroll
    for (int r = 0; r < 16; ++r) ps += p1[r];
    { auto rr = __builtin_amdgcn_permlane32_swap(__float_as_uint(ps), __float_as_uint(ps), false, false); ps = __uint_as_float(rr[0]) + __uint_as_float(rr[1]); }
    l_reg = l_reg * alpha + ps;
#define PK4(P, BASE, OUT) do { unsigned a0 = cvtpk(P[BASE + 0], P[BASE + 1]), a1 = cvtpk(P[BASE + 2], P[BASE + 3]);   \
    unsigned b0 = cvtpk(P[BASE + 4], P[BASE + 5]), b1 = cvtpk(P[BASE + 6], P[BASE + 7]);                              \
    auto r0 = __builtin_amdgcn_permlane32_swap(a0, b0, false, false); auto r1 = __builtin_amdgcn_permlane32_swap(a1, b1, false, false); \
    u32x4 w = {r0[0], r1[0], r0[1], r1[1]}; OUT = *reinterpret_cast<bf16x8*>(&w); } while (0)
    PK4(p0, 0, pa0); PK4(p0, 8, pa1); PK4(p1, 0, pa2); PK4(p1, 8, pa3);
#undef PK4
}
__device__ __forceinline__ void qkt(f32x16& p0, f32x16& p1, const char* Ks, const bf16x8* qr, int c, int r32, int hi) {
    p0 = f32x16{}; p1 = f32x16{};
#pragma unroll
    for (int d0 = 0; d0 < 4; ++d0) { const int cb = ((c * 4 + d0) * 16 + hi * 8) * 2;
        const bf16x8 b0 = *reinterpret_cast<const bf16x8*>(Ks + KSWZ(r32, cb));
        const bf16x8 b1 = *reinterpret_cast<const bf16x8*>(Ks + KSWZ(32 + r32, cb));
        p0 = __builtin_amdgcn_mfma_f32_32x32x16_bf16(b0, qr[d0], p0, 0, 0, 0);
        p1 = __builtin_amdgcn_mfma_f32_32x32x16_bf16(b1, qr[d0], p1, 0, 0, 0); }
}
__device__ __forceinline__ int v_st(int k, int c) { const int kk = (k & ~0xC) | ((k & 4) << 1) | ((k & 8) >> 1); return ((kk >> 3) * 4 + (c >> 5)) * 512 + ((kk & 7) * 32 + (c & 31)) * 2; }
__device__ __forceinline__ int v_rd_base(int lane) { return ((lane & 3) << 3) | (((lane >> 2) & 3) << 6) | (((lane >> 4) & 1) << 5) | (((lane >> 5) & 1) << 8); }
constexpr int v_rd_off(int d0, int ks, int half) { return d0 * 512 + ks * 4096 + half * 2048; }
template <int OFF> __device__ __forceinline__ s16x4 tr_read(int vb) { s16x4 r; asm volatile("ds_read_b64_tr_b16 %0, %1 offset:%2" : "=&v"(r) : "v"(vb), "i"(OFF) : "memory"); return r; }
template <int D0> __device__ __forceinline__ void pv_one(f32x16& od, int vb, bf16x8 pa0, bf16x8 pa1, bf16x8 pa2, bf16x8 pa3) {
    const s16x4 l0 = tr_read<v_rd_off(D0, 0, 0)>(vb), h0 = tr_read<v_rd_off(D0, 0, 1)>(vb), l1 = tr_read<v_rd_off(D0, 1, 0)>(vb), h1 = tr_read<v_rd_off(D0, 1, 1)>(vb);
    const s16x4 l2 = tr_read<v_rd_off(D0, 2, 0)>(vb), h2 = tr_read<v_rd_off(D0, 2, 1)>(vb), l3 = tr_read<v_rd_off(D0, 3, 0)>(vb), h3 = tr_read<v_rd_off(D0, 3, 1)>(vb);
    asm volatile("s_waitcnt lgkmcnt(0)" ::: "memory"); SBAR();
#define PK(L, H) (bf16x8){L[0], L[1], L[2], L[3], H[0], H[1], H[2], H[3]}
    od = __builtin_amdgcn_mfma_f32_32x32x16_bf16(pa0, PK(l0, h0), od, 0, 0, 0);
    od = __builtin_amdgcn_mfma_f32_32x32x16_bf16(pa1, PK(l1, h1), od, 0, 0, 0);
    od = __builtin_amdgcn_mfma_f32_32x32x16_bf16(pa2, PK(l2, h2), od, 0, 0, 0);
    od = __builtin_amdgcn_mfma_f32_32x32x16_bf16(pa3, PK(l3, h3), od, 0, 0, 0);
#undef PK
}
__device__ __forceinline__ void pv_d0(f32x16* o, int vb, bf16x8 pa0, bf16x8 pa1, bf16x8 pa2, bf16x8 pa3) {
    pv_one<0>(o[0], vb, pa0, pa1, pa2, pa3); pv_one<1>(o[1], vb, pa0, pa1, pa2, pa3); pv_one<2>(o[2], vb, pa0, pa1, pa2, pa3); pv_one<3>(o[3], vb, pa0, pa1, pa2, pa3);
}
template <bool DUMMY> __device__ __forceinline__ void attn_unit(int b, int h, int qb, bf16_t* AO, const bf16_t* __restrict__ KB, const bf16_t* __restrict__ VB, float lam, const float* __restrict__ subg, char* lds, bf16_t* Odummy) {
    const int tid = threadIdx.x, wid = tid >> 6, lane = tid & 63, r32 = lane & 31, hi = lane >> 5, c = wid >> 2, wq = wid & 3;
    char* V_lds = lds; char* K_lds = lds + 2 * SHM_V;
    float* ws = (float*)(lds + WS_OFF) + wid * 64; float* li_l = ws; float* al_l = ws + 32;
    const size_t rowbase = (size_t)b * SEQ; const int q0 = qb * 128;
    float m_reg = -1e30f, l_reg = 0; f32x16 o[4] = {}; bf16x8 qr[4];
    bf16_t* Qrow = AO + (rowbase + q0 + wq * 32) * LDQ + 1024 + h * 128;
    { const bf16_t* Qw = Qrow + (size_t)r32 * LDQ + c * 64 + hi * 8;
#pragma unroll
      for (int d0 = 0; d0 < 4; ++d0) qr[d0] = *reinterpret_cast<const bf16x8*>(Qw + d0 * 16); }
    const bf16_t* Kh = KB + rowbase * LDK + h * 128; const bf16_t* Vh = VB + rowbase * LDK + h * 128;
    const int sr = tid >> 4, sc = (tid & 15) * 8, vst0 = v_st(sr, sc), vst1 = v_st(32 + sr, sc);
    const int vb0 = (int)(uintptr_t)V_lds + v_rd_base(lane);
    struct { bf16x8 vs0, vs1, ks0, ks1; } sr_[1];
#define SLOAD(i, k0) do { sr_[i].vs0 = *reinterpret_cast<const bf16x8*>(&Vh[(size_t)((k0) + sr) * LDK + sc]); sr_[i].vs1 = *reinterpret_cast<const bf16x8*>(&Vh[(size_t)((k0) + 32 + sr) * LDK + sc]); \
    sr_[i].ks0 = *reinterpret_cast<const bf16x8*>(&Kh[(size_t)((k0) + sr) * LDK + sc]); sr_[i].ks1 = *reinterpret_cast<const bf16x8*>(&Kh[(size_t)((k0) + 32 + sr) * LDK + sc]); } while (0)
#define SWRITE(bf, i) do { *(bf16x8*)(V_lds + (bf) * SHM_V + vst0) = sr_[i].vs0; *(bf16x8*)(V_lds + (bf) * SHM_V + vst1) = sr_[i].vs1; const int kc = sc * 2; \
    *(bf16x8*)(K_lds + (bf) * SHM_K + KSWZ(sr, kc)) = sr_[i].ks0; *(bf16x8*)(K_lds + (bf) * SHM_K + KSWZ(32 + sr, kc)) = sr_[i].ks1; } while (0)
#define SWAIT() asm volatile("s_waitcnt vmcnt(0)" ::: "memory")
#define RESC(a) do { if (__any((a) < 1.f)) { if (hi == 0) al_l[r32] = (a); asm volatile("s_waitcnt lgkmcnt(0)" ::: "memory"); \
    _Pragma("unroll") for (int d = 0; d < 4; ++d) _Pragma("unroll") for (int r = 0; r < 16; ++r) o[d][r] *= al_l[crow(r, hi)]; } } while (0)
    f32x16 pA0, pA1, pB0, pB1; float alA, alB; bf16x8 pa0, pa1, pa2, pa3; constexpr int NT = SEQ / KVBLK;
    constexpr int SE = 0, SO = 0;
    SLOAD(SE, 0); asm volatile("s_waitcnt vmcnt(0)" ::: "memory"); SWRITE(0, SE); __syncthreads();
    qkt(pA0, pA1, K_lds, qr, c, r32, hi); partialSM(pA0, pA1, m_reg, alA);
    SLOAD(SO, KVBLK);
    SWAIT(); SWRITE(1, SO); __syncthreads();
    for (int j = 1; j + 1 < NT; j += 2) {
        SBAR(); qkt(pB0, pB1, K_lds + SHM_K, qr, c, r32, hi);
        finishSM(pA0, pA1, alA, l_reg, pa0, pa1, pa2, pa3); SBAR();
        SLOAD(SO, (j + 1) * KVBLK); SBAR();
        pv_d0(o, vb0, pa0, pa1, pa2, pa3); partialSM(pB0, pB1, m_reg, alB);
        __syncthreads(); SWAIT(); SWRITE(0, SE);
        RESC(alB); __syncthreads();
        SBAR(); qkt(pA0, pA1, K_lds, qr, c, r32, hi);
        finishSM(pB0, pB1, alB, l_reg, pa0, pa1, pa2, pa3); SBAR();
        SLOAD(SE, (j + 2) * KVBLK); SBAR();
        pv_d0(o, vb0 + SHM_V, pa0, pa1, pa2, pa3); partialSM(pA0, pA1, m_reg, alA);
        __syncthreads(); SWAIT(); SWRITE(1, SO);
        RESC(alA); __syncthreads();
    }
    SBAR(); qkt(pB0, pB1, K_lds + SHM_K, qr, c, r32, hi);
    finishSM(pA0, pA1, alA, l_reg, pa0, pa1, pa2, pa3); SBAR();
    pv_d0(o, vb0, pa0, pa1, pa2, pa3); partialSM(pB0, pB1, m_reg, alB);
    __syncthreads(); RESC(alB);
    finishSM(pB0, pB1, alB, l_reg, pa0, pa1, pa2, pa3); SBAR();
    pv_d0(o, vb0 + SHM_V, pa0, pa1, pa2, pa3);
    if (hi == 0) li_l[r32] = l_reg; asm volatile("s_waitcnt lgkmcnt(0)" ::: "memory");
    float rli[16];
#pragma unroll
    for (int r = 0; r < 16; ++r) rli[r] = __builtin_amdgcn_rcpf(li_l[crow(r, hi)]);
    __syncthreads();
    float* X = (float*)lds + wq * 4096;
    if (c == 1) {
#pragma unroll
        for (int r = 0; r < 16; ++r)
#pragma unroll
            for (int d0 = 0; d0 < 4; ++d0) X[crow(r, hi) * 128 + d0 * 32 + r32] = o[d0][r] * rli[r];
    }
    __syncthreads();
    if (c == 0) {
        float g4[4];
#pragma unroll
        for (int d0 = 0; d0 < 4; ++d0) g4[d0] = subg[d0 * 32 + r32] * 0.8f;
#pragma unroll
        for (int r = 0; r < 16; ++r) {
            float v[4], ss = 0.f;
#pragma unroll
            for (int d0 = 0; d0 < 4; ++d0) { v[d0] = o[d0][r] * rli[r] - lam * X[crow(r, hi) * 128 + d0 * 32 + r32]; ss += v[d0] * v[d0]; }
            ss += __shfl_xor(ss, 1); ss += __shfl_xor(ss, 2); ss += __shfl_xor(ss, 4); ss += __shfl_xor(ss, 8); ss += __shfl_xor(ss, 16);
            const float rstd = rsqrtf(ss * (1.f / 128.f) + EPS);
            bf16_t* Or = DUMMY ? Odummy + (rowbase + q0 + wq * 32 + crow(r, hi)) * (size_t)1024 + h * 128 + r32 : Qrow + (size_t)crow(r, hi) * LDQ + r32;
#pragma unroll
            for (int d0 = 0; d0 < 4; ++d0) Or[d0 * 32] = f2bf(v[d0] * rstd * g4[d0]);
        }
    }
    __syncthreads();
#undef SLOAD
#undef SWRITE
#undef SWAIT
#undef RESC
}
#undef KSWZ
#undef SBAR
}
namespace rg {
typedef float f32x4v __attribute__((ext_vector_type(4)));
typedef short bf16x8v __attribute__((ext_vector_type(8)));
constexpr int T = 128, XS = 72, FS = 68;
constexpr int L_XRAW = 0, L_XCF = 16896, L_XCB = L_XCF + T * FS * 4, L_WA = L_XCB + T * XS * 2, L_WI = L_WA + 64 * XS * 2, L_SUM = L_WI + 64 * XS * 2, L_CAR = L_SUM + 8 * 64 * 2 * 4, L_END = L_CAR + 2 * 64 * 4;
static_assert(L_END <= 131072, "rg lds");
template <int DIR> __device__ __forceinline__ void sweep(int b, int n, const bf16_t* __restrict__ XR, bf16_t* AO, bf16_t* HF, const float* __restrict__ cw, const float* __restrict__ cb,
        const float* __restrict__ w_a, const float* __restrict__ b_a, const float* __restrict__ w_i, const float* __restrict__ b_i, const float* __restrict__ lam, LAS unsigned char* lds, bf16_t* Odummy) {
    const int tid = threadIdx.x, wid = __builtin_amdgcn_readfirstlane(tid >> 6), lane = tid & 63, fr = lane & 15, fq = lane >> 4;
    LAS bf16_t* XRAW = (LAS bf16_t*)(lds + L_XRAW); LAS float* XCF = (LAS float*)(lds + L_XCF); LAS bf16_t* XCB = (LAS bf16_t*)(lds + L_XCB);
    LAS bf16_t* WA = (LAS bf16_t*)(lds + L_WA); LAS bf16_t* WI = (LAS bf16_t*)(lds + L_WI); LAS float* SUM = (LAS float*)(lds + L_SUM); LAS float* CAR = (LAS float*)(lds + L_CAR);
    const size_t rowbase = (size_t)b * SEQ;
    __syncthreads();
    { const float* wa = w_a + ((size_t)DIR * 16 + n) * 4096; const float* wi = w_i + ((size_t)DIR * 16 + n) * 4096;
#pragma unroll
      for (int i = 0; i < 8; ++i) { const int idx = tid + 512 * i, k = idx >> 6, j = idx & 63; WA[j * XS + k] = f2bf(wa[idx]); WI[j * XS + k] = f2bf(wi[idx]); }
      if (tid < 128) CAR[tid] = 0.f; }
    float ba[4], bi[4], sp[4];
#pragma unroll
    for (int nf = 0; nf < 4; ++nf) { const int ch = n * 64 + nf * 16 + fr; ba[nf] = b_a[DIR * DM + ch]; bi[nf] = b_i[DIR * DM + ch]; sp[nf] = -8.f * log1pf(__expf(-lam[DIR * DM + ch])); }
    const int p2 = (tid & 31) * 2; const int chp = n * 64 + p2;
    const float k00 = cw[0 * DM + chp], k01 = cw[0 * DM + chp + 1], k10 = cw[1 * DM + chp], k11 = cw[1 * DM + chp + 1], k20 = cw[2 * DM + chp], k21 = cw[2 * DM + chp + 1], k30 = cw[3 * DM + chp], k31 = cw[3 * DM + chp + 1];
    const float cb0 = cb[chp], cb1 = cb[chp + 1];
    v4u pre[3];
#define RG_LOAD(t0_) do { _Pragma("unroll") for (int i = 0; i < 3; ++i) { const int pidx = tid + 512 * i; const int rr = pidx >> 3, cc = pidx & 7; const int t = (t0_) - 2 + rr; \
        pre[i] = (v4u){0u, 0u, 0u, 0u}; if (pidx < (T + 3) * 8 && t >= 0 && t < SEQ) pre[i] = *(const v4u*)(XR + (rowbase + t) * DM + n * 64 + cc * 8); } } while (0)
    RG_LOAD(DIR == 0 ? 0 : SEQ - T);
    for (int ci = 0; ci < SEQ / T; ++ci) {
        const int chunk = DIR == 0 ? ci : SEQ / T - 1 - ci; const int t0 = chunk * T; const int cur = ci & 1;
        __syncthreads();
#pragma unroll
        for (int i = 0; i < 3; ++i) { const int pidx = tid + 512 * i; if (pidx < (T + 3) * 8) *(LAS v4u*)(XRAW + pidx * 8) = pre[i]; }
        __syncthreads();
        if (ci + 1 < SEQ / T) RG_LOAD(DIR == 0 ? t0 + T : t0 - T);
#pragma unroll
        for (int i = 0; i < 8; ++i) { const int r = (tid >> 5) + 16 * i;
            const unsigned x0 = *(LAS unsigned*)(XRAW + (r + 0) * 64 + p2), x1 = *(LAS unsigned*)(XRAW + (r + 1) * 64 + p2), x2 = *(LAS unsigned*)(XRAW + (r + 2) * 64 + p2), x3 = *(LAS unsigned*)(XRAW + (r + 3) * 64 + p2);
            const float v0 = cb0 + k00 * lo_bf(x0) + k10 * lo_bf(x1) + k20 * lo_bf(x2) + k30 * lo_bf(x3);
            const float v1 = cb1 + k01 * hi_bf(x0) + k11 * hi_bf(x1) + k21 * hi_bf(x2) + k31 * hi_bf(x3);
            *(LAS f32x2*)(XCF + r * FS + p2) = (f32x2){v0, v1}; *(LAS unsigned*)(XCB + r * XS + p2) = pk2(v0, v1); }
        __syncthreads();
        bf16x8v a0 = *(LAS bf16x8v*)(XCB + (wid * 16 + fr) * XS + fq * 8), a1 = *(LAS bf16x8v*)(XCB + (wid * 16 + fr) * XS + 32 + fq * 8);
        f32x4v ga[4], gi[4];
#pragma unroll
        for (int nf = 0; nf < 4; ++nf) {
            const bf16x8v wa0 = *(LAS bf16x8v*)(WA + (nf * 16 + fr) * XS + fq * 8), wa1 = *(LAS bf16x8v*)(WA + (nf * 16 + fr) * XS + 32 + fq * 8);
            const bf16x8v wi0 = *(LAS bf16x8v*)(WI + (nf * 16 + fr) * XS + fq * 8), wi1 = *(LAS bf16x8v*)(WI + (nf * 16 + fr) * XS + 32 + fq * 8);
            ga[nf] = __builtin_amdgcn_mfma_f32_16x16x32_bf16(a0, wa0, (f32x4v){0.f, 0.f, 0.f, 0.f}, 0, 0, 0); ga[nf] = __builtin_amdgcn_mfma_f32_16x16x32_bf16(a1, wa1, ga[nf], 0, 0, 0);
            gi[nf] = __builtin_amdgcn_mfma_f32_16x16x32_bf16(a0, wi0, (f32x4v){0.f, 0.f, 0.f, 0.f}, 0, 0, 0); gi[nf] = __builtin_amdgcn_mfma_f32_16x16x32_bf16(a1, wi1, gi[nf], 0, 0, 0);
        }
        float hl[4][4], P[4][4], Ain[4], Hin[4], Aex[4], Hex[4];
#pragma unroll
        for (int nf = 0; nf < 4; ++nf) {
            float av[4], uv[4];
#pragma unroll
            for (int g = 0; g < 4; ++g) {
                const float r = sigmoidf_(ga[nf][g] + ba[nf]), ig = sigmoidf_(gi[nf][g] + bi[nf]);
                const float la = sp[nf] * r, a = fexp(la), x2 = 2.f * la;
                const float poly = -x2 * (1.f + x2 * (0.5f + x2 * (0.16666667f + x2 * (0.041666668f + x2 * (0.0083333333f + x2 * 0.0013888889f)))));
                const float om = x2 > -0.25f ? poly : 1.f - a * a;
                const float xc = XCF[(wid * 16 + fq * 4 + g) * FS + nf * 16 + fr];
                av[g] = a; uv[g] = __builtin_amdgcn_sqrtf(om) * ig * xc;
            }
            if (DIR == 0) { hl[nf][0] = uv[0]; P[nf][0] = av[0];
#pragma unroll
                for (int g = 1; g < 4; ++g) { hl[nf][g] = av[g] * hl[nf][g - 1] + uv[g]; P[nf][g] = av[g] * P[nf][g - 1]; } }
            else { hl[nf][3] = uv[3]; P[nf][3] = av[3];
#pragma unroll
                for (int g = 2; g >= 0; --g) { hl[nf][g] = av[g] * hl[nf][g + 1] + uv[g]; P[nf][g] = av[g] * P[nf][g + 1]; } }
            float A = DIR == 0 ? P[nf][3] : P[nf][0], H = DIR == 0 ? hl[nf][3] : hl[nf][0];
            { const float Ap = DIR == 0 ? __shfl_up(A, 16) : __shfl_down(A, 16), Hp = DIR == 0 ? __shfl_up(H, 16) : __shfl_down(H, 16);
              if (DIR == 0 ? fq >= 1 : fq <= 2) { H = A * Hp + H; A = A * Ap; } }
            { const float Ap = DIR == 0 ? __shfl_up(A, 32) : __shfl_down(A, 32), Hp = DIR == 0 ? __shfl_up(H, 32) : __shfl_down(H, 32);
              if (DIR == 0 ? fq >= 2 : fq <= 1) { H = A * Hp + H; A = A * Ap; } }
            Ain[nf] = A; Hin[nf] = H;
            { const float Ae = DIR == 0 ? __shfl_up(A, 16) : __shfl_down(A, 16), He = DIR == 0 ? __shfl_up(H, 16) : __shfl_down(H, 16);
              const bool first = DIR == 0 ? fq == 0 : fq == 3; Aex[nf] = first ? 1.f : Ae; Hex[nf] = first ? 0.f : He; }
            if (DIR == 0 ? fq == 3 : fq == 0) { SUM[(wid * 64 + nf * 16 + fr) * 2] = A; SUM[(wid * 64 + nf * 16 + fr) * 2 + 1] = H; }
        }
        __syncthreads();
#pragma unroll
        for (int nf = 0; nf < 4; ++nf) {
            const int chl = nf * 16 + fr;
            float cwv = CAR[cur * 64 + chl];
            if (DIR == 0) { for (int w2 = 0; w2 < wid; ++w2) cwv = SUM[(w2 * 64 + chl) * 2] * cwv + SUM[(w2 * 64 + chl) * 2 + 1]; }
            else { for (int w2 = 7; w2 > wid; --w2) cwv = SUM[(w2 * 64 + chl) * 2] * cwv + SUM[(w2 * 64 + chl) * 2 + 1]; }
            if ((DIR == 0 ? wid == 7 && fq == 3 : wid == 0 && fq == 0)) CAR[(cur ^ 1) * 64 + chl] = Ain[nf] * cwv + Hin[nf];
            const float cl = Aex[nf] * cwv + Hex[nf];
#pragma unroll
            for (int g = 0; g < 4; ++g) {
                const float hv = hl[nf][g] + P[nf][g] * cl;
                const size_t row = rowbase + t0 + wid * 16 + fq * 4 + g; const int ch = n * 64 + chl;
                if (DIR == 0) HF[row * DM + ch] = f2bf(hv);
                else { const float yr = bf2f(AO[row * 2048 + ch]); const bf16_t ov = f2bf((hv + bf2f(HF[row * DM + ch])) * gelu_tanh(yr)); if (Odummy) Odummy[row * DM + ch] = ov; else AO[row * 2048 + ch] = ov; }
            }
        }
    }
#undef RG_LOAD
}
}
#define XB_TMO      128
#define XB_XCNT(j)  (256  + 64 * (j))
#define XB_XSUB(j)  (1280 + 64 * (j))
#define XB_XGEN(j)  (2304 + 64 * (j))
#define XB_TOP      3328
#define XB_TOPGEN   3392
#define XCD_BAR_WORDS 3456
#define XB_SPIN_CAP (1u << 18)

__device__ __forceinline__ unsigned xb_ld(unsigned* p)              { return __hip_atomic_load(p, __ATOMIC_RELAXED, __HIP_MEMORY_SCOPE_AGENT); }
__device__ __forceinline__ unsigned xb_add(unsigned* p, unsigned v) { return __hip_atomic_fetch_add(p, v, __ATOMIC_RELAXED, __HIP_MEMORY_SCOPE_AGENT); }
__device__ __forceinline__ unsigned xb_xcc_id() { return (unsigned)__builtin_amdgcn_s_getreg((3 << 11) | 20) & 0xFu; }
#define XB_SPIN(cond, bar) do { unsigned _sp = 0; while (cond) { __builtin_amdgcn_s_sleep(1); \
    if ((++_sp & 255u) == 0u) { if (xb_ld(&(bar)[XB_TMO])) break; if (_sp > XB_SPIN_CAP) { atomicAdd(&(bar)[XB_TMO], 1u); break; } } } } while (0)

struct XcdBarrier {
    unsigned* bar; unsigned x;
    volatile LAS unsigned* st;
};

__device__ __forceinline__ XcdBarrier xcd_barrier_post(unsigned* bar, volatile LAS unsigned* st) {
    XcdBarrier b; b.bar = bar; b.x = xb_xcc_id(); b.st = st;
    if (threadIdx.x == 0) (void)xb_add(&bar[XB_XCNT(b.x)], 1u);
    return b;
}
__device__ __forceinline__ void xcd_barrier_complete(unsigned* bar, unsigned x, unsigned& nloc, unsigned& nx) {
    const unsigned G = gridDim.x * gridDim.y * gridDim.z;
    unsigned sum, cnt, mine, sp = 0u;
    for (;;) {
        sum = 0u; cnt = 0u; mine = 0u;
#pragma unroll
        for (unsigned j = 0; j < 16; ++j) { const unsigned c = xb_ld(&bar[XB_XCNT(j)]); sum += c; cnt += (c > 0u) ? 1u : 0u; mine = (j == x) ? c : mine; }
        if (sum == G) break;
        __builtin_amdgcn_s_sleep(1);
        if ((++sp & 255u) == 0u) { if (xb_ld(&bar[XB_TMO])) break; if (sp > XB_SPIN_CAP) { atomicAdd(&bar[XB_TMO], 1u); break; } }
    }
    nloc = mine > 0u ? mine : 1u; nx = cnt > 0u ? cnt : 1u;
}

__device__ __forceinline__ void xcd_barrier(const XcdBarrier& b) {
    asm volatile("s_waitcnt vmcnt(0)" ::: "memory");
    __syncthreads();
    if (threadIdx.x == 0) {
        unsigned* bar = b.bar;
        __builtin_amdgcn_s_waitcnt(0);
        unsigned nloc = b.st[0], nx = b.st[1];
        if (nloc == 0u) { xcd_barrier_complete(bar, b.x, nloc, nx); b.st[0] = nloc; b.st[1] = nx; }
        const unsigned old = xb_add(&bar[XB_XSUB(b.x)], 1u);
        const unsigned gen = old / nloc;
        if (old + 1u == (gen + 1u) * nloc) {
            __builtin_amdgcn_fence(__ATOMIC_RELEASE, "agent");
            asm volatile("s_waitcnt vmcnt(0)" ::: "memory");
            const unsigned og = xb_add(&bar[XB_TOP], 1u);
            const unsigned tg = og / nx;
            if (og + 1u == (tg + 1u) * nx) xb_add(&bar[XB_TOPGEN], 1u);
            else XB_SPIN(xb_ld(&bar[XB_TOPGEN]) == tg, bar);
            __builtin_amdgcn_fence(__ATOMIC_ACQUIRE, "agent");
            xb_add(&bar[XB_XGEN(b.x)], 1u);
            asm volatile("s_waitcnt vmcnt(0)" ::: "memory");
        } else {
            XB_SPIN(xb_ld(&bar[XB_XGEN(b.x)]) == gen, bar);
            __builtin_amdgcn_fence(__ATOMIC_ACQUIRE, "agent");
            asm volatile("s_waitcnt vmcnt(0)" ::: "memory");
        }
    }
    __syncthreads();
}
struct Frame {
    LAS unsigned char* lds;
    int tid, lane, wave, vcu, G;
};
__device__ __forceinline__ void p0_transpose_item(const float* W, int K, int N, bf16_t* WT, int row_off, LAS float* scr, int kb, int nb, int lane, int ldt, int koff) {
    const int k0 = 64 * kb, n0 = 32 * nb;
#pragma unroll 8
    for (int i = 0; i < 32; ++i) { const int kk = 2 * i + (lane >> 5); scr[kk * 33 + (lane & 31)] = W[(size_t)(k0 + kk) * N + n0 + (lane & 31)]; }
    LDS_WAIT(); asm volatile("" ::: "memory");
    const int c = lane & 7;
#pragma unroll
    for (int j = 0; j < 4; ++j) { const int n = (lane >> 3) + 8 * j; const LAS float* s = scr + (8 * c) * 33 + n;
        v4u o; o.x = pk2(s[0 * 33], s[1 * 33]); o.y = pk2(s[2 * 33], s[3 * 33]); o.z = pk2(s[4 * 33], s[5 * 33]); o.w = pk2(s[6 * 33], s[7 * 33]);
        *(GAS v4u*)(WT + (size_t)(row_off + n0 + n) * ldt + koff + k0 + 8 * c) = o; }
    LDS_WAIT(); asm volatile("" ::: "memory");
}
__device__ __forceinline__ void normmod_row(const float* xrow, const float* g, const float* sc, const float* sh, bf16_t* orow, int lane) {
    f32x4 v[4]; float s = 0.f;
#pragma unroll
    for (int j = 0; j < 4; ++j) { v[j] = *((const f32x4*)xrow + lane + 64 * j); s += (v[j].x * v[j].x + v[j].y * v[j].y) + (v[j].z * v[j].z + v[j].w * v[j].w); }
    const float rstd = rsqrtf(wave_sum(s) * (1.f / DM) + EPS);
#pragma unroll
    for (int j = 0; j < 4; ++j) { const f32x4 gg = *((const f32x4*)g + lane + 64 * j), cc = *((const f32x4*)sc + lane + 64 * j), hh = *((const f32x4*)sh + lane + 64 * j);
        const f32x4 y = v[j] * rstd * gg * (cc + 1.f) + hh; v2u w; w.x = pk2(y.x, y.y); w.y = pk2(y.z, y.w); *((v2u*)orow + lane + 64 * j) = w; }
}

#ifndef PROBE_REP
#define PROBE_REP 0
#endif
#ifndef MIX_SEL
#define MIX_SEL 3
#endif
#ifndef PH_MASK
#define PH_MASK 0x7ff
#endif
struct Args { const void* in[28]; float* out; unsigned char* ws; int ph_lo, ph_hi, li, pad; };
typedef const __attribute__((address_space(4))) Args KArgs;
__device__ __forceinline__ KArgs* ka_ptr() { auto p = __builtin_amdgcn_kernarg_segment_ptr(); asm volatile("" : "+s"(p)); return (KArgs*)p; }
enum { P_PRO = 0, P_NORM1, P_PROJ, P_MIX, P_MERGE, P_OUT, P_NORM2, P_UP, P_FIX, P_DOWN, P_FINAL, N_PHASES };

__global__ void __launch_bounds__(NWAVES * 64, 2) mk_fwd(Args args) {
    extern __shared__ __attribute__((aligned(16))) unsigned char lds[];
    for (int u = threadIdx.x; u < (LDS_BYTES - LDSCTL_OFF) / 4; u += NWAVES * 64) ((LAS unsigned*)((LAS unsigned char*)lds + LDSCTL_OFF))[u] = 0u;
    __syncthreads();
    { KArgs* KA = ka_ptr(); if (KA->ph_hi - KA->ph_lo > 1) (void)xcd_barrier_post((unsigned*)(KA->ws + WS_CTL) + CW_BAR + KA->li * XCD_BAR_WORDS, (volatile LAS unsigned*)((LAS unsigned char*)lds + MISC_OFF) + 8); }
#define INP(k) ((const float*)KA->in[k])
#define WSP(T, off) ((T*)(KA->ws + (off)))
#define IN(k) (((PH_MASK >> (k)) & 1) && ka_ptr()->ph_lo <= (k) && (k) < ka_ptr()->ph_hi)
#define SEAM(k) do { KArgs* KB_ = ka_ptr(); if (KB_->ph_lo <= (k) && (k) + 1 < KB_->ph_hi) { XcdBarrier bar; bar.bar = (unsigned*)(KB_->ws + WS_CTL) + CW_BAR + KB_->li * XCD_BAR_WORDS; bar.x = xb_xcc_id(); \
        bar.st = (volatile LAS unsigned*)((LAS unsigned char*)lds + MISC_OFF) + 8; xcd_barrier(bar); } } while (0)
#define FRAME() Frame F; F.lds = (LAS unsigned char*)lds; F.tid = threadIdx.x; F.lane = F.tid & 63; F.wave = __builtin_amdgcn_readfirstlane(F.tid >> 6); F.G = gridDim.x; \
        { const int bx = blockIdx.x; F.vcu = (F.G % 8 == 0) ? (bx % 8) * (F.G / 8) + bx / 8 : bx; } const int gw = F.vcu * NWAVES + F.wave, NGW = F.G * NWAVES; (void)gw; (void)NGW;

    if (IN(P_PRO)) for (int rep_ = (PROBE_REP >> P_PRO) & 1; rep_ >= 0; --rep_) {
        KArgs* KA = ka_ptr(); FRAME(); const float* cvec = INP(1); const int* pos = (const int*)KA->in[2]; const float* w_ada = INP(3); const float* b_ada = INP(4);
        float* MOD = WSP(float, WS_MOD); float* COS = WSP(float, WS_COS); float* SIN = WSP(float, WS_SIN);
        {
            LAS float* SC = (LAS float*)F.lds;
            for (int i = F.tid; i < BATCH * DM; i += NWAVES * 64) { const float cv = cvec[i]; SC[i] = cv * sigmoidf_(cv); }
            __syncthreads();
            const int ncol = NMODC / 256;
            const int col0 = F.vcu * ncol;
            LAS float* RED = (LAS float*)F.lds + BATCH * DM;
            if (F.tid < 192) {
                const int ks = F.tid / 6, cg = F.tid % 6; f32x4 accm[16];
#pragma unroll
                for (int b = 0; b < 16; ++b) accm[b] = (f32x4){0.f, 0.f, 0.f, 0.f};
#pragma unroll 8
                for (int kk = 0; kk < 32; ++kk) { const int k = ks * 32 + kk; const f32x4 w4 = *(const f32x4*)(w_ada + (size_t)k * NMODC + col0 + 4 * cg);
#pragma unroll
                    for (int b = 0; b < 16; ++b) accm[b] += w4 * SC[b * DM + k]; }
#pragma unroll
                for (int b = 0; b < 16; ++b) *(LAS f32x4*)(RED + (ks * 16 + b) * 24 + 4 * cg) = accm[b];
            }
            __syncthreads();
            if (F.tid < 16 * 24) { const int bb = F.tid / 24, q = F.tid % 24; float s = b_ada[col0 + q];
                for (int k2 = 0; k2 < 32; ++k2) s += RED[(k2 * 16 + bb) * 24 + q];
                MOD[(size_t)bb * NMODC + col0 + q] = s; }
            __syncthreads();
        }
        for (int idx = F.vcu * 512 + F.tid; idx < M * 8; idx += F.G * 512) {
            const int row = idx >> 3, i = idx & 7;
            const float invf = powf(500000.0f, -(float)i / 8.0f);
            const float ang = (float)pos[row] * invf;
            const double rev = (double)ang * 0.15915494309189535; const double fr = rev - rint(rev);
            COS[idx] = __builtin_amdgcn_cosf((float)fr); SIN[idx] = __builtin_amdgcn_sinf((float)fr);
        }
        if (gw == 0) {
            const float* lq1 = INP(15); const float* lk1 = INP(16); const float* lq2 = INP(17); const float* lk2 = INP(18);
            const float s1 = wave_sum(lq1[F.lane] * lk1[F.lane]), s2 = wave_sum(lq2[F.lane] * lk2[F.lane]);
            if (F.lane == 0) MOD[BATCH * NMODC] = fexp(s1) - fexp(s2) + 0.2f;
        }
    }
    SEAM(P_PRO);
    if (IN(P_NORM1)) for (int rep_ = (PROBE_REP >> P_NORM1) & 1; rep_ >= 0; --rep_) { KArgs* KA = ka_ptr(); FRAME(); const float* x = INP(0); const float* norm1_g = INP(5); const float* MOD = WSP(float, WS_MOD); bf16_t* H = WSP(bf16_t, WS_H);
        {
            const float* w_in = INP(6); const float* w_rnn_o = INP(14); const float* w_attn_o = INP(20); const float* w_out = INP(21); const float* w_up = INP(23); const float* w_down = INP(26);
            bf16_t* WIN_T = WSP(bf16_t, WS_WIN); bf16_t* WA_T = WSP(bf16_t, WS_WA); bf16_t* WB_T = WSP(bf16_t, WS_WB); bf16_t* WOUT_T = WSP(bf16_t, WS_WOUT); bf16_t* WUP_T = WSP(bf16_t, WS_WUP); bf16_t* WDOWN_T = WSP(bf16_t, WS_WDOWN);
            LAS float* scr = (LAS float*)(F.lds + F.wave * 16384);
            constexpr int I_IN = 16 * (INCOLS / 32), I_SQ = 16 * 32, I_UP = 16 * (2 * DFF / 32), I_DN = (DFF / 64) * 32;
            constexpr int NITEMS = I_IN + 3 * I_SQ + I_UP + I_DN;
            for (int it = gw; it < NITEMS; it += NGW) {
                int r = it;
                if (r < I_IN) { const int kb = r / (INCOLS / 32), nb = r % (INCOLS / 32), n0 = nb * 32; int mapped = n0;
                    if (n0 >= 5120) { const int g = n0 - 5120, jn = g < 1024 ? g : g - 1024; mapped = 5120 + (jn / 128) * 256 + (g < 1024 ? 0 : 128) + (jn % 128); }
                    p0_transpose_item(w_in, DM, INCOLS, WIN_T, mapped - n0, scr, kb, nb, F.lane, DM, 0); continue; } r -= I_IN;
                if (r < I_SQ) { p0_transpose_item(w_rnn_o, DM, DM, WA_T, 0, scr, r / 32, r % 32, F.lane, 2048, 0); continue; } r -= I_SQ;
                if (r < I_SQ) { p0_transpose_item(w_attn_o, DM, DM, WA_T, 0, scr, r / 32, r % 32, F.lane, 2048, 1024); continue; } r -= I_SQ;
                if (r < I_SQ) { p0_transpose_item(w_out, DM, DM, WOUT_T, 0, scr, r / 32, r % 32, F.lane, DM, 0); continue; } r -= I_SQ;
                if (r < I_UP) { const int kb = r / (2 * DFF / 32), nb = r % (2 * DFF / 32), n0 = nb * 32; const int jn = n0 < DFF ? n0 : n0 - DFF; const int mapped = (jn / 128) * 256 + (n0 < DFF ? 0 : 128) + (jn % 128);
                    p0_transpose_item(w_up, DM, 2 * DFF, WUP_T, mapped - n0, scr, kb, nb, F.lane, DM, 0); continue; } r -= I_UP;
                p0_transpose_item(w_down, DFF, DM, WDOWN_T, 0, scr, r / 32, r % 32, F.lane, DFF, 0);
            }
        }
        for (int m = gw; m < M; m += NGW) { const float* mb = MOD + (size_t)(m / SEQ) * NMODC; normmod_row(x + (size_t)m * DM, norm1_g, mb + 1024, mb, H + (size_t)m * DM, F.lane); } }
    SEAM(P_NORM1);
    if (IN(P_PROJ)) for (int rep_ = (PROBE_REP >> P_PROJ) & 1; rep_ >= 0; --rep_) {
        KArgs* KA = ka_ptr(); FRAME(); bf16_t* H = WSP(bf16_t, WS_H); bf16_t* WIN_T = WSP(bf16_t, WS_WIN); bf16_t* XR = WSP(bf16_t, WS_XR); bf16_t* AO = WSP(bf16_t, WS_AO); bf16_t* KB = WSP(bf16_t, WS_K); bf16_t* VB = WSP(bf16_t, WS_V);
        bf16_t* GT = (bf16_t*)KA->out; const float* COS = WSP(float, WS_COS); const float* SIN = WSP(float, WS_SIN);
        pg8::Gemm g{H, WIN_T, M, INCOLS, DM, DM}; pg8::StaticOrder S; S.init(M, INCOLS, F.G, (int)blockIdx.x);
        EpiProj E{XR, AO, KB, VB, GT, COS, SIN, nullptr};
#if defined(STAGGER_US)
        { const unsigned sg = (unsigned)F.vcu & 3u; if (sg) { const unsigned long long t0 = __builtin_amdgcn_s_memrealtime(); while (__builtin_amdgcn_s_memrealtime() - t0 < (unsigned long long)(sg * STAGGER_US * 100)) __builtin_amdgcn_s_sleep(32); } }
#endif
#if defined(PROBE_LOCALEPI)
        if (rep_) { EpiProj EL{XR, AO, KB, VB, GT, COS, SIN, WSP(bf16_t, WS_HF)}; pg8::gemm_phase<EpiProj, pg8::StaticOrder, PG8_ALIGN, PG8_SP2>(F.lds + RING_OFF, g, S, EL); } else
#endif
#if defined(PROBE_NULLEPI)
        if (rep_) { EpiNull EN{(float*)WSP(float, WS_HF)}; pg8::gemm_phase<EpiNull, pg8::StaticOrder, PG8_ALIGN, PG8_SP2>(F.lds + RING_OFF, g, S, EN); } else
#endif
        pg8::gemm_phase<EpiProj, pg8::StaticOrder, PG8_ALIGN, PG8_SP2>(F.lds + RING_OFF, g, S, E);
    }
    SEAM(P_PROJ);
    if (IN(P_MIX)) {
        KArgs* KA = ka_ptr(); FRAME(); bf16_t* XR = WSP(bf16_t, WS_XR); bf16_t* AO = WSP(bf16_t, WS_AO); bf16_t* KB = WSP(bf16_t, WS_K); bf16_t* VB = WSP(bf16_t, WS_V); bf16_t* HF = WSP(bf16_t, WS_HF); const float* MOD = WSP(float, WS_MOD);
        const float* conv_rnn_w = INP(7); const float* conv_rnn_b = INP(8); const float* w_rg_a = INP(9); const float* b_rg_a = INP(10); const float* w_rg_i = INP(11); const float* b_rg_i = INP(12); const float* rg_lambda = INP(13); const float* subln_g = INP(19);
        if ((MIX_SEL & 1) && (KA->pad & 1) && F.vcu < 256) { const int b = F.vcu >> 4, n = F.vcu & 15;
            for (int rep_ = (PROBE_REP >> P_MIX) & 1; rep_ >= 0; --rep_) {
                rg::sweep<0>(b, n, XR, AO, HF, conv_rnn_w, conv_rnn_b, w_rg_a, b_rg_a, w_rg_i, b_rg_i, rg_lambda, F.lds, nullptr);
                rg::sweep<1>(b, n, XR, AO, HF, conv_rnn_w, conv_rnn_b, w_rg_a, b_rg_a, w_rg_i, b_rg_i, rg_lambda, F.lds, rep_ ? WSP(bf16_t, WS_H) : (bf16_t*)nullptr);
                __syncthreads(); } }
        const float lam = MOD[BATCH * NMODC];
        if (((PROBE_REP >> 11) & 1) && (KA->pad & 2)) for (int uidx = F.vcu * 8; uidx < BATCH * 8 * 16; uidx += F.G * 8) {
#pragma unroll 1
            for (int q = 0; q < 8; ++q) { const int un = uidx + q; const int bh = un >> 4, qb = un & 15;
                att::attn_unit<true>(bh >> 3, bh & 7, qb, AO, KB, VB, lam, subln_g, (char*)lds, WSP(bf16_t, WS_H)); }
        }
        if ((MIX_SEL & 2) && (KA->pad & 2)) for (int uidx = F.vcu * 8; uidx < BATCH * 8 * 16; uidx += F.G * 8) {
#pragma unroll 1
            for (int q = 0; q < 8; ++q) { const int un = uidx + q; const int bh = un >> 4, qb = un & 15;
                att::attn_unit<false>(bh >> 3, bh & 7, qb, AO, KB, VB, lam, subln_g, (char*)lds, nullptr); }
        }
    }
    SEAM(P_MIX);
    if (IN(P_MERGE)) for (int rep_ = (PROBE_REP >> P_MERGE) & 1; rep_ >= 0; --rep_) {
        KArgs* KA = ka_ptr(); FRAME(); bf16_t* AO = WSP(bf16_t, WS_AO); bf16_t* WA_T = WSP(bf16_t, WS_WA); bf16_t* WB_T = WSP(bf16_t, WS_WB); bf16_t* GT = (bf16_t*)KA->out; bf16_t* MG = WSP(bf16_t, WS_XR);
        pg8::StaticOrder S; S.init(M, DM, F.G, (int)blockIdx.x);
        pg8::Gemm g{AO, WA_T, M, DM, 2048, 2048}; EpiMerge E{GT, MG}; pg8::gemm_phase<EpiMerge, pg8::StaticOrder, PG8_ALIGN, PG8_SP2>(F.lds + RING_OFF, g, S, E);
    }
    SEAM(P_MERGE);
    if (IN(P_OUT)) for (int rep_ = (PROBE_REP >> P_OUT) & 1; rep_ >= 0; --rep_) {
        KArgs* KA = ka_ptr(); FRAME(); bf16_t* MG = WSP(bf16_t, WS_XR); bf16_t* WOUT_T = WSP(bf16_t, WS_WOUT); const float* x = INP(0); float* out = KA->out; const float* MOD = WSP(float, WS_MOD);
        pg8::Gemm g{MG, WOUT_T, M, DM, DM, DM}; pg8::StaticOrder S; S.init(M, DM, F.G, (int)blockIdx.x);
        EpiResid E{x, out, MOD + 2048}; pg8::gemm_phase<EpiResid, pg8::StaticOrder, PG8_ALIGN, PG8_SP2>(F.lds + RING_OFF, g, S, E);
    }
    SEAM(P_OUT);
    if (IN(P_NORM2)) for (int rep_ = (PROBE_REP >> P_NORM2) & 1; rep_ >= 0; --rep_) { KArgs* KA = ka_ptr(); FRAME(); const float* out = KA->out; const float* norm2_g = INP(22); const float* MOD = WSP(float, WS_MOD); bf16_t* H = WSP(bf16_t, WS_H); for (int m = gw; m < M; m += NGW) { const float* mb = MOD + (size_t)(m / SEQ) * NMODC; normmod_row(out + (size_t)m * DM, norm2_g, mb + 4096, mb + 3072, H + (size_t)m * DM, F.lane); } }
    SEAM(P_NORM2);
    if (IN(P_UP)) for (int rep_ = (PROBE_REP >> P_UP) & 1; rep_ >= 0; --rep_) {
        KArgs* KA = ka_ptr(); FRAME(); bf16_t* H = WSP(bf16_t, WS_H); bf16_t* WUP_T = WSP(bf16_t, WS_WUP); bf16_t* ACT = WSP(bf16_t, WS_ACT); float* EDGE = WSP(float, WS_EDGE); const float* conv_ffn_w = INP(24); const float* conv_ffn_b = INP(25);
        pg8::Gemm g{H, WUP_T, M, 2 * DFF, DM, DM}; pg8::StaticOrder S; S.init(M, 2 * DFF, F.G, (int)blockIdx.x);
        EpiUpConv E{ACT, EDGE, conv_ffn_w, conv_ffn_b}; pg8::gemm_phase<EpiUpConv, pg8::StaticOrder, PG8_ALIGN, PG8_SP2>(F.lds + RING_OFF, g, S, E);
    }
    SEAM(P_UP);
    if (IN(P_FIX)) for (int rep_ = (PROBE_REP >> P_FIX) & 1; rep_ >= 0; --rep_) {
        KArgs* KA = ka_ptr(); FRAME(); bf16_t* ACT = WSP(bf16_t, WS_ACT); const float* EDGE = WSP(float, WS_EDGE); const float* conv_ffn_w = INP(24); const float* conv_ffn_b = INP(25);
        for (int idx = F.vcu * 512 + F.tid; idx < 512 * 2 * (DFF / 4); idx += F.G * 512) {
            const int j = (idx % (DFF / 4)) * 4, ge = idx / (DFF / 4), e = ge & 1, gband = ge >> 1;
            const int pc = (j / 128) * 256 + (j % 128);
            const float* Eb = EDGE + (size_t)gband * 4 * 5632;
            const f32x4 z4 = {0.f, 0.f, 0.f, 0.f}; f32x4 pv, pg, cv, cg, nv, ng;
            if (e == 0) { const bool z = (gband % 32) == 0; pv = z ? z4 : *(const f32x4*)(Eb - 5632 + pc); pg = z ? z4 : *(const f32x4*)(Eb - 5632 + pc + 128); cv = *(const f32x4*)(Eb + pc); cg = *(const f32x4*)(Eb + pc + 128); nv = *(const f32x4*)(Eb + 5632 + pc); ng = *(const f32x4*)(Eb + 5632 + pc + 128); }
            else { const bool z = ((gband + 1) % 32) == 0; pv = *(const f32x4*)(Eb + 2 * 5632 + pc); pg = *(const f32x4*)(Eb + 2 * 5632 + pc + 128); cv = *(const f32x4*)(Eb + 3 * 5632 + pc); cg = *(const f32x4*)(Eb + 3 * 5632 + pc + 128); nv = z ? z4 : *(const f32x4*)(Eb + 4 * 5632 + pc); ng = z ? z4 : *(const f32x4*)(Eb + 4 * 5632 + pc + 128); }
            const f32x4 vcv = *(const f32x4*)(conv_ffn_b + j) + *(const f32x4*)(conv_ffn_w + j) * pv + *(const f32x4*)(conv_ffn_w + 2 * DFF + j) * cv + *(const f32x4*)(conv_ffn_w + 4 * DFF + j) * nv;
            const f32x4 gcv = *(const f32x4*)(conv_ffn_b + DFF + j) + *(const f32x4*)(conv_ffn_w + DFF + j) * pg + *(const f32x4*)(conv_ffn_w + 3 * DFF + j) * cg + *(const f32x4*)(conv_ffn_w + 5 * DFF + j) * ng;
            v2u w; w.x = pk2(gcv.x * sigmoidf_(gcv.x) * vcv.x, gcv.y * sigmoidf_(gcv.y) * vcv.y); w.y = pk2(gcv.z * sigmoidf_(gcv.z) * vcv.z, gcv.w * sigmoidf_(gcv.w) * vcv.w);
            *(v2u*)(ACT + (size_t)(gband * 64 + (e ? 63 : 0)) * DFF + j) = w;
        }
    }
    SEAM(P_FIX);
    if (IN(P_DOWN)) {
        KArgs* KA = ka_ptr(); FRAME(); bf16_t* ACT = WSP(bf16_t, WS_ACT); bf16_t* WDOWN_T = WSP(bf16_t, WS_WDOWN); float* out = KA->out; const float* MOD = WSP(float, WS_MOD);
        pg8::Gemm g{ACT, WDOWN_T, M, DM, DFF, DFF}; pg8::StaticOrder S; S.init(M, DM, F.G, (int)blockIdx.x);
        for (int rep_ = (PROBE_REP >> P_DOWN) & 1; rep_ >= 0; --rep_) { EpiResid E{out, rep_ ? WSP(float, 112 * MiB) : out, MOD + 5120}; pg8::gemm_phase<EpiResid, pg8::StaticOrder, PG8_ALIGN, PG8_SP2>(F.lds + RING_OFF, g, S, E); }
    }
    SEAM(P_DOWN);
    if (IN(P_FINAL)) {
        KArgs* KA = ka_ptr(); FRAME(); float* out = KA->out; const float* final_g = INP(27);
        for (int rep_ = (PROBE_REP >> P_FINAL) & 1; rep_ >= 0; --rep_) for (int m = gw; m < M; m += NGW) { float* xr = out + (size_t)m * DM; float* xo = rep_ ? WSP(float, 112 * MiB) + (size_t)m * DM : xr; f32x4 v[4]; float s = 0.f;
#pragma unroll
            for (int j = 0; j < 4; ++j) { v[j] = *((const f32x4*)xr + F.lane + 64 * j); s += (v[j].x * v[j].x + v[j].y * v[j].y) + (v[j].z * v[j].z + v[j].w * v[j].w); }
            const float rstd = rsqrtf(wave_sum(s) * (1.f / DM) + EPS);
#pragma unroll
            for (int j = 0; j < 4; ++j) { const f32x4 gg = *((const f32x4*)final_g + F.lane + 64 * j); *((f32x4*)xo + F.lane + 64 * j) = v[j] * rstd * gg; } }
    }
#undef IN
#undef SEAM
#undef INP
#undef WSP
#undef FRAME
}
__device__ __forceinline__ float nv_sigmoid(float x) { return 1.f / (1.f + __expf(-x)); }
__device__ __forceinline__ float nv_gelu(float x) { const float u = 1.5957691216057308f * (x + 0.044715f * x * x * x); return x / (1.f + __expf(-u)); }
__global__ void __launch_bounds__(256) k_mod(const float* __restrict__ c, const float* __restrict__ w_ada, const float* __restrict__ b_ada, float* __restrict__ mod,
                                             const float* lq1, const float* lk1, const float* lq2, const float* lk2) {
    const int j = blockIdx.x * 256 + threadIdx.x, b = blockIdx.y;
    float acc = b_ada[j];
    for (int k = 0; k < DM; ++k) { const float cv = c[b * DM + k]; acc += (cv / (1.f + __expf(-cv))) * w_ada[(size_t)k * NMODC + j]; }
    mod[b * NMODC + j] = acc;
    if (blockIdx.x == 0 && blockIdx.y == 0 && threadIdx.x == 0) {
        float s1 = 0.f, s2 = 0.f;
        for (int i = 0; i < 64; ++i) { s1 += lq1[i] * lk1[i]; s2 += lq2[i] * lk2[i]; }
        mod[BATCH * NMODC] = __expf(s1) - __expf(s2) + 0.2f;
    }
}
__global__ void __launch_bounds__(256) k_rope_tab(const int* __restrict__ pos, float* __restrict__ cs, float* __restrict__ sn) {
    const int idx = blockIdx.x * 256 + threadIdx.x; if (idx >= M * 8) return;
    const int row = idx >> 3, i = idx & 7;
    const float invf = powf(500000.0f, -(float)i / 8.0f);
    const float ang = (float)pos[row] * invf;
    const double rev = (double)ang * 0.15915494309189535;
    const double fr = rev - rint(rev);
    cs[idx] = __builtin_amdgcn_cosf((float)fr); sn[idx] = __builtin_amdgcn_sinf((float)fr);
}
__global__ void __launch_bounds__(256) k_normmod(const float* __restrict__ x, const float* __restrict__ g, const float* __restrict__ mod, int sh_off, int sc_off, bf16_t* __restrict__ out) {
    const int row = blockIdx.x * 4 + (threadIdx.x >> 6), lane = threadIdx.x & 63, b = row / SEQ;
    const float* xr = x + (size_t)row * DM; float v[16]; float ss = 0.f;
#pragma unroll
    for (int j = 0; j < 16; ++j) { v[j] = xr[lane + 64 * j]; ss += v[j] * v[j]; }
#pragma unroll
    for (int o = 1; o < 64; o <<= 1) ss += __shfl_xor(ss, o);
    const float rstd = rsqrtf(ss * (1.f / DM) + EPS);
#pragma unroll
    for (int j = 0; j < 16; ++j) { const int k = lane + 64 * j; out[(size_t)row * DM + k] = f2bf(v[j] * rstd * g[k] * (1.f + mod[b * NMODC + sc_off + k]) + mod[b * NMODC + sh_off + k]); }
}
__global__ void __launch_bounds__(256) k_final(float* __restrict__ x, const float* __restrict__ g) {
    const int row = blockIdx.x * 4 + (threadIdx.x >> 6), lane = threadIdx.x & 63;
    float* xr = x + (size_t)row * DM; float v[16]; float ss = 0.f;
#pragma unroll
    for (int j = 0; j < 16; ++j) { v[j] = xr[lane + 64 * j]; ss += v[j] * v[j]; }
#pragma unroll
    for (int o = 1; o < 64; o <<= 1) ss += __shfl_xor(ss, o);
    const float rstd = rsqrtf(ss * (1.f / DM) + EPS);
#pragma unroll
    for (int j = 0; j < 16; ++j) { const int k = lane + 64 * j; xr[k] = v[j] * rstd * g[k]; }
}
template <class Epi> __global__ void __launch_bounds__(256) nv_gemm(const bf16_t* __restrict__ A, int lda, const float* __restrict__ W, int N, int K, Epi E) {
    __shared__ float As[16][68]; __shared__ float Bs[16][64];
    const int tid = threadIdx.x, tx = tid & 15, ty = tid >> 4, m0 = blockIdx.y * 64, n0 = blockIdx.x * 64;
    float acc[4][4] = {};
    for (int k0 = 0; k0 < K; k0 += 16) {
        { const int r = tid >> 2, kk = (tid & 3) * 4; const bf16_t* ap = A + (size_t)(m0 + r) * lda + k0 + kk;
          As[kk + 0][r] = bf2f(ap[0]); As[kk + 1][r] = bf2f(ap[1]); As[kk + 2][r] = bf2f(ap[2]); As[kk + 3][r] = bf2f(ap[3]); }
        { const int kk = tid >> 4, n = (tid & 15) * 4; const float4 w = *(const float4*)(W + (size_t)(k0 + kk) * N + n0 + n); *(float4*)&Bs[kk][n] = w; }
        __syncthreads();
#pragma unroll
        for (int k = 0; k < 16; ++k) { const float4 a = *(const float4*)&As[k][ty * 4]; const float4 b = *(const float4*)&Bs[k][tx * 4];
            const float av[4] = {a.x, a.y, a.z, a.w}, bv[4] = {b.x, b.y, b.z, b.w};
#pragma unroll
            for (int i = 0; i < 4; ++i)
#pragma unroll
                for (int j = 0; j < 4; ++j) acc[i][j] += av[i] * bv[j]; }
        __syncthreads();
    }
#pragma unroll
    for (int i = 0; i < 4; ++i)
#pragma unroll
        for (int j = 0; j < 4; ++j) E(m0 + ty * 4 + i, n0 + tx * 4 + j, acc[i][j]);
}
struct EProj { bf16_t *XR, *AO, *KB, *VB, *GT;
    __device__ void operator()(int m, int n, float v) const { const bf16_t o = f2bf(v);
        if (n < 1024) XR[(size_t)m * 1024 + n] = o; else if (n < 2048) AO[(size_t)m * 2048 + n - 1024] = o; else if (n < 3072) AO[(size_t)m * 2048 + 1024 + n - 2048] = o;
        else if (n < 4096) KB[(size_t)m * 1024 + n - 3072] = o; else if (n < 5120) VB[(size_t)m * 1024 + n - 4096] = o; else GT[(size_t)m * 2048 + n - 5120] = o; } };
struct EMergeA { const bf16_t* GT; bf16_t* MG; __device__ void operator()(int m, int n, float v) const { MG[(size_t)m * 1024 + n] = f2bf(nv_sigmoid(bf2f(GT[(size_t)m * 2048 + n])) * v); } };
struct EMergeB { const bf16_t* GT; bf16_t* MG; __device__ void operator()(int m, int n, float v) const { MG[(size_t)m * 1024 + n] = f2bf(bf2f(MG[(size_t)m * 1024 + n]) + nv_sigmoid(bf2f(GT[(size_t)m * 2048 + 1024 + n])) * v); } };
struct EOut { const float* x; const float* mod; float* X1; __device__ void operator()(int m, int n, float v) const { X1[(size_t)m * 1024 + n] = x[(size_t)m * 1024 + n] + mod[(m / SEQ) * NMODC + 2048 + n] * v; } };
struct EUp { bf16_t* UP; __device__ void operator()(int m, int n, float v) const { UP[(size_t)m * 5632 + n] = f2bf(v); } };
struct EDown { float* X; const float* mod; __device__ void operator()(int m, int n, float v) const { X[(size_t)m * 1024 + n] += mod[(m / SEQ) * NMODC + 5120 + n] * v; } };

__global__ void __launch_bounds__(256) k_rope(bf16_t* __restrict__ AO, bf16_t* __restrict__ KB, const float* __restrict__ cs, const float* __restrict__ sn) {
    const int idx = blockIdx.x * 256 + threadIdx.x; const int row = idx >> 4, hc = idx & 15;
    bf16_t* q = AO + (size_t)row * 2048 + 1024 + hc * 64; bf16_t* k = KB + (size_t)row * 1024 + hc * 64;
    float qv[64];
#pragma unroll
    for (int d = 0; d < 64; ++d) qv[d] = bf2f(q[d]);
#pragma unroll
    for (int i = 0; i < 8; ++i) { const float c = cs[row * 8 + i], s = sn[row * 8 + i]; const float a = qv[i], b = qv[i + 8]; qv[i] = a * c - b * s; qv[i + 8] = b * c + a * s;
        const float ka = bf2f(k[i]), kb = bf2f(k[i + 8]); k[i] = f2bf(ka * c - kb * s); k[i + 8] = f2bf(kb * c + ka * s); }
#pragma unroll
    for (int d = 0; d < 64; ++d) q[d] = f2bf(qv[d] * C2);
}
__global__ void __launch_bounds__(64) nv_rglru(const bf16_t* __restrict__ XR, bf16_t* __restrict__ AO, bf16_t* __restrict__ HF, const float* __restrict__ cw, const float* __restrict__ cb,
                                               const float* __restrict__ w_a, const float* __restrict__ b_a, const float* __restrict__ w_i, const float* __restrict__ b_i, const float* __restrict__ lam) {
    __shared__ float wA[64][64]; __shared__ float wI[64][64]; __shared__ float xcs[64];
    const int j = threadIdx.x, n = blockIdx.x, b = blockIdx.y, ch = n * 64 + j;
    const float c0 = cw[0 * DM + ch], c1 = cw[1 * DM + ch], c2 = cw[2 * DM + ch], c3 = cw[3 * DM + ch], cbv = cb[ch];
    for (int d = 0; d < 2; ++d) {
        __syncthreads();
        for (int k = 0; k < 64; ++k) { wA[k][j] = w_a[(((size_t)d * 16 + n) * 64 + k) * 64 + j]; wI[k][j] = w_i[(((size_t)d * 16 + n) * 64 + k) * 64 + j]; }
        const float ba = b_a[d * DM + ch], bi = b_i[d * DM + ch], sp = log1pf(__expf(-lam[d * DM + ch]));
        float h = 0.f;
        for (int tt = 0; tt < SEQ; ++tt) {
            const int t = d == 0 ? tt : SEQ - 1 - tt; const size_t row = (size_t)b * SEQ + t;
            float xc = cbv;
            if (t >= 2) xc += c0 * bf2f(XR[(row - 2) * DM + ch]);
            if (t >= 1) xc += c1 * bf2f(XR[(row - 1) * DM + ch]);
            xc += c2 * bf2f(XR[row * DM + ch]);
            if (t + 1 < SEQ) xc += c3 * bf2f(XR[(row + 1) * DM + ch]);
            __syncthreads(); xcs[j] = xc; __syncthreads();
            float ga = ba, gi = bi;
#pragma unroll 16
            for (int k = 0; k < 64; ++k) { const float xv = xcs[k]; ga += xv * wA[k][j]; gi += xv * wI[k][j]; }
            const float r = nv_sigmoid(ga), ig = nv_sigmoid(gi), la = -8.f * r * sp, a = __expf(la), u = sqrtf(-expm1f(2.f * la)) * ig * xc;
            h = a * h + u;
            if (d == 0) HF[row * DM + ch] = f2bf(h);
            else { const float yr = bf2f(AO[row * 2048 + ch]); AO[row * 2048 + ch] = f2bf((h + bf2f(HF[row * DM + ch])) * nv_gelu(yr)); }
        }
    }
}
__global__ void __launch_bounds__(256) nv_attn(bf16_t* __restrict__ AO, const bf16_t* __restrict__ KB, const bf16_t* __restrict__ VB, const float* __restrict__ subg, const float* __restrict__ scal) {
    __shared__ float Ks[64][64]; __shared__ float Vs[64][128];
    const int tid = threadIdx.x, qi = tid >> 3, chn = tid & 7, h = blockIdx.y, b = blockIdx.z;
    const size_t row = (size_t)b * SEQ + blockIdx.x * 32 + qi; const float lam = scal[0];
    float res[16];
    for (int c = 0; c < 2; ++c) {
        float q[64];
#pragma unroll
        for (int d = 0; d < 64; ++d) q[d] = bf2f(AO[row * 2048 + 1024 + h * 128 + c * 64 + d]);
        float m = -1e30f, l = 0.f, acc[16];
#pragma unroll
        for (int e = 0; e < 16; ++e) acc[e] = 0.f;
        for (int kt = 0; kt < SEQ / 64; ++kt) {
            __syncthreads();
            for (int i = 0; i < 16; ++i) { const int idx = tid + 256 * i, key = idx >> 6, d = idx & 63; Ks[key][d] = bf2f(KB[((size_t)b * SEQ + kt * 64 + key) * 1024 + h * 128 + c * 64 + d]); }
            for (int i = 0; i < 32; ++i) { const int idx = tid + 256 * i, key = idx >> 7, d = idx & 127; Vs[key][d] = bf2f(VB[((size_t)b * SEQ + kt * 64 + key) * 1024 + h * 128 + d]); }
            __syncthreads();
            for (int key = 0; key < 64; ++key) {
                float s = 0.f;
#pragma unroll
                for (int d = 0; d < 64; ++d) s += q[d] * Ks[key][d];
                const float mn = fmaxf(m, s), al = exp2f(m - mn), p = exp2f(s - mn); l = l * al + p; m = mn;
#pragma unroll
                for (int e = 0; e < 16; ++e) acc[e] = acc[e] * al + p * Vs[key][chn * 16 + e];
            }
        }
        const float inv = 1.f / l;
#pragma unroll
        for (int e = 0; e < 16; ++e) res[e] = c == 0 ? acc[e] * inv : res[e] - lam * acc[e] * inv;
    }
    float ss = 0.f;
#pragma unroll
    for (int e = 0; e < 16; ++e) ss += res[e] * res[e];
    ss += __shfl_xor(ss, 1); ss += __shfl_xor(ss, 2); ss += __shfl_xor(ss, 4);
    const float rstd = rsqrtf(ss * (1.f / 128.f) + EPS);
    __syncthreads();
#pragma unroll
    for (int e = 0; e < 16; ++e) AO[row * 2048 + 1024 + h * 128 + chn * 16 + e] = f2bf(res[e] * rstd * subg[chn * 16 + e] * 0.8f);
}
__global__ void __launch_bounds__(256) k_convact(const bf16_t* __restrict__ UP, int m0, const float* __restrict__ cw, const float* __restrict__ cb, bf16_t* __restrict__ ACT) {
    const int j = blockIdx.x * 256 + threadIdx.x, r = blockIdx.y; const int s = (m0 + r) % SEQ;
    float v = cb[j], g = cb[DFF + j];
#pragma unroll
    for (int k = 0; k < 3; ++k) { const int ss = s + k - 1; if (ss >= 0 && ss < SEQ) { v += cw[k * 2 * DFF + j] * bf2f(UP[(size_t)(r + k - 1) * 5632 + j]); g += cw[k * 2 * DFF + DFF + j] * bf2f(UP[(size_t)(r + k - 1) * 5632 + DFF + j]); } }
    ACT[(size_t)(m0 + r) * DFF + j] = f2bf(g / (1.f + __expf(-g)) * v);
}

#ifndef NAIVE_MASK
#define NAIVE_MASK 0x0
#endif
#ifndef ONE_LAUNCH
#define ONE_LAUNCH 1
#endif
extern "C" void kernel_launch(void* const* d_in, const int* in_sizes, int n_in, void* d_out, int out_size, void* d_ws, size_t ws_size, hipStream_t stream) {
    static int grid = 0;
    if (grid == 0) {
        if (n_in != 28 || in_sizes[0] != M * DM || out_size != M * DM || ws_size < WS_NEED) { fprintf(stderr, "kernel_launch: unexpected shapes (n_in %d, in0 %d, out %d, ws %zu); nothing launched\n", n_in, n_in > 0 ? in_sizes[0] : -1, out_size, ws_size); grid = -1; return; }
        int dev = 0, cus = 0, per_cu = 0;
        if (hipGetDevice(&dev) != hipSuccess || hipDeviceGetAttribute(&cus, hipDeviceAttributeMultiprocessorCount, dev) != hipSuccess) { grid = -1; return; }
        if (hipFuncSetAttribute((const void*)mk_fwd, hipFuncAttributeMaxDynamicSharedMemorySize, LDS_BYTES) != hipSuccess) { fprintf(stderr, "kernel_launch: hipFuncSetAttribute failed\n"); grid = -1; return; }
        if (hipOccupancyMaxActiveBlocksPerMultiprocessor(&per_cu, (const void*)mk_fwd, NWAVES * 64, LDS_BYTES) != hipSuccess || per_cu < 1) fprintf(stderr, "kernel_launch: occupancy query says %d\n", per_cu);
        (void)hipGetLastError();
        grid = cus;
        if (grid != 256) fprintf(stderr, "kernel_launch: %d CUs; built for 256\n", grid);
    }
    if (grid < 0) return;
    (void)hipMemsetAsync((char*)d_ws + WS_CTL, 0, CTL_ZERO_BYTES, stream);
    Args a{};
    for (int i = 0; i < 28; ++i) a.in[i] = d_in[i];
    a.out = (float*)d_out; a.ws = (unsigned char*)d_ws;
    int li = 0;
    auto L = [&](int lo, int hi, int flags) { a.ph_lo = lo; a.ph_hi = hi; a.li = li++; a.pad = flags; hipLaunchKernelGGL(mk_fwd, dim3(grid), dim3(NWAVES * 64), LDS_BYTES, stream, a); };
#if ONE_LAUNCH && (NAIVE_MASK == 0)
    L(0, N_PHASES, 3);
#else
    const float* x = (const float*)d_in[0]; const float* c = (const float*)d_in[1]; const int* pos = (const int*)d_in[2];
    const float* w_ada = (const float*)d_in[3]; const float* b_ada = (const float*)d_in[4]; const float* norm1_g = (const float*)d_in[5]; const float* w_in = (const float*)d_in[6];
    const float* conv_rnn_w = (const float*)d_in[7]; const float* conv_rnn_b = (const float*)d_in[8]; const float* w_rg_a = (const float*)d_in[9]; const float* b_rg_a = (const float*)d_in[10];
    const float* w_rg_i = (const float*)d_in[11]; const float* b_rg_i = (const float*)d_in[12]; const float* rg_lambda = (const float*)d_in[13]; const float* w_rnn_o = (const float*)d_in[14];
    const float* lq1 = (const float*)d_in[15]; const float* lk1 = (const float*)d_in[16]; const float* lq2 = (const float*)d_in[17]; const float* lk2 = (const float*)d_in[18];
    const float* subln_g = (const float*)d_in[19]; const float* w_attn_o = (const float*)d_in[20]; const float* w_out = (const float*)d_in[21]; const float* norm2_g = (const float*)d_in[22];
    const float* w_up = (const float*)d_in[23]; const float* conv_ffn_w = (const float*)d_in[24]; const float* conv_ffn_b = (const float*)d_in[25]; const float* w_down = (const float*)d_in[26];
    const float* final_g = (const float*)d_in[27];
    unsigned char* ws = (unsigned char*)d_ws; float* out = (float*)d_out;
    float* MOD = (float*)(ws + WS_MOD); float* COS = (float*)(ws + WS_COS); float* SIN = (float*)(ws + WS_SIN);
    bf16_t* H = (bf16_t*)(ws + WS_H); bf16_t* XR = (bf16_t*)(ws + WS_XR); bf16_t* AO = (bf16_t*)(ws + WS_AO); bf16_t* KB = (bf16_t*)(ws + WS_K); bf16_t* VB = (bf16_t*)(ws + WS_V);
    bf16_t* HF = (bf16_t*)(ws + WS_HF); bf16_t* GT = (bf16_t*)d_out; bf16_t* MG = XR; bf16_t* UP = (bf16_t*)(ws + WS_UP); bf16_t* ACT = (bf16_t*)(ws + WS_ACT);
    constexpr int NM = NAIVE_MASK;
    L(P_PRO, P_PRO + 1, 3);
    if (NM & 1) { k_mod<<<dim3(NMODC / 256, BATCH), 256, 0, stream>>>(c, w_ada, b_ada, MOD, lq1, lk1, lq2, lk2); k_rope_tab<<<M * 8 / 256, 256, 0, stream>>>(pos, COS, SIN); }
    if (NM & 2) k_normmod<<<M / 4, 256, 0, stream>>>(x, norm1_g, MOD, 0, 1024, H); else L(P_NORM1, P_NORM1 + 1, 3);
    if (NM & 4) { nv_gemm<EProj><<<dim3(INCOLS / 64, M / 64), 256, 0, stream>>>(H, DM, w_in, INCOLS, DM, EProj{XR, AO, KB, VB, GT}); k_rope<<<M * 16 / 256, 256, 0, stream>>>(AO, KB, COS, SIN); }
    else L(P_PROJ, P_PROJ + 1, 3);
    if (NM & 8) nv_rglru<<<dim3(16, BATCH), 64, 0, stream>>>(XR, AO, HF, conv_rnn_w, conv_rnn_b, w_rg_a, b_rg_a, w_rg_i, b_rg_i, rg_lambda); else L(P_MIX, P_MIX + 1, 1);
    if (NM & 16) nv_attn<<<dim3(SEQ / 32, 8, BATCH), 256, 0, stream>>>(AO, KB, VB, subln_g, MOD + BATCH * NMODC); else L(P_MIX, P_MIX + 1, 2);
    if (NM & 32) { nv_gemm<EMergeA><<<dim3(DM / 64, M / 64), 256, 0, stream>>>(AO, 2048, w_rnn_o, DM, DM, EMergeA{GT, MG}); nv_gemm<EMergeB><<<dim3(DM / 64, M / 64), 256, 0, stream>>>(AO + 1024, 2048, w_attn_o, DM, DM, EMergeB{GT, MG}); }
    else L(P_MERGE, P_MERGE + 1, 3);
    if (NM & 64) nv_gemm<EOut><<<dim3(DM / 64, M / 64), 256, 0, stream>>>(MG, DM, w_out, DM, DM, EOut{x, MOD, out}); else L(P_OUT, P_OUT + 1, 3);
    if (NM & 128) k_normmod<<<M / 4, 256, 0, stream>>>(out, norm2_g, MOD, 3072, 4096, H); else L(P_NORM2, P_NORM2 + 1, 3);
    if (NM & 256) { for (int half = 0; half < 2; ++half) { const int m0 = half * (M / 2);
            nv_gemm<EUp><<<dim3(2 * DFF / 64, M / 2 / 64), 256, 0, stream>>>(H + (size_t)m0 * DM, DM, w_up, 2 * DFF, DM, EUp{UP});
            k_convact<<<dim3(DFF / 256, M / 2), 256, 0, stream>>>(UP, m0, conv_ffn_w, conv_ffn_b, ACT); } }
    else { L(P_UP, P_UP + 1, 3); L(P_FIX, P_FIX + 1, 3); }
    if (NM & 512) nv_gemm<EDown><<<dim3(DM / 64, M / 64), 256, 0, stream>>>(ACT, DFF, w_down, DM, DFF, EDown{out, MOD}); else L(P_DOWN, P_DOWN + 1, 3);
    if (NM & 1024) k_final<<<M / 4, 256, 0, stream>>>(out, final_g); else L(P_FINAL, P_FINAL + 1, 3);
#endif
}
```

```cpp
#include <hip/hip_runtime.h>
#include <hip/hip_bf16.h>
#include <cstdint>
#include <cstdio>
#include <cmath>

namespace pg8 {
#define PG8_LAS __attribute__((address_space(3)))
typedef unsigned short bf16_t;
typedef short bf16x8 __attribute__((ext_vector_type(8)));
typedef float f32x4 __attribute__((ext_vector_type(4)));
typedef unsigned u32x4 __attribute__((ext_vector_type(4)));
constexpr int BM = 256, BK = 64, HALF = 128, HTB = HALF * BK * 2  , STAGE_BYTES = 8 * HTB, NXCD = 8, WGM = 8;

__host__ __device__ __forceinline__ int lds_byte(int r, int c) { const int st = (r >> 4) * 2 + (c >> 5), rr = r & 15, cc = c & 31, ob = rr * 64 + cc * 2; return st * 1024 + (ob ^ (((ob >> 9) & 1) << 5)); }
__host__ __device__ __forceinline__ void stage_rc(int b, int& R, int& C) { const int st = b / 1024, sb = b % 1024, swz = sb ^ (((sb >> 9) & 1) << 5); R = (st >> 1) * 16 + swz / 64; C = (st & 1) * 32 + (swz % 64) / 2; }
__host__ __device__ __forceinline__ int perm32(int rho) { const int n = rho >> 4, i = rho & 15; return 8 * (i >> 2) + 4 * n + (i & 3); }

struct Unit { int pm, pn; };
struct Gemm { const bf16_t* A; const bf16_t* Bt; int M, N, K, lda; };

struct StaticOrder {
    int nM, nN, nwg, G, c;
    __host__ __device__ void init(int M, int N, int G_, int c_) { nM = M / BM; nN = N / BM; nwg = nM * nN; G = G_; c = c_; }
    __host__ __device__ bool next(int i, Unit& u) const {
        const long L = (long)i * G + c; if (L >= nwg) return false;
        int wgid = (int)L; { const int q = nwg / NXCD, r = nwg % NXCD, xcd = wgid % NXCD, off = wgid / NXCD; wgid = (xcd < r ? xcd * (q + 1) : r * (q + 1) + (xcd - r) * q) + off; }
        const int nig = WGM * nN, gid = wgid / nig, fm = gid * WGM, gsz = (nM - fm) < WGM ? (nM - fm) : WGM;
        u.pm = fm + ((wgid % nig) % gsz); u.pn = (wgid % nig) / gsz; return true;
    }
    __device__ __forceinline__ void a_ready(const Unit&) const {}
    __device__ __forceinline__ void done(const Unit&) const {}
};

__device__ __forceinline__ unsigned cvt_pk_bf16(float lo, float hi) { unsigned r; asm volatile("v_cvt_pk_bf16_f32 %0, %1, %2" : "=v"(r) : "v"(lo), "v"(hi)); return r; }
template <class Epi, class Sched, bool ALIGN_EPI = false, bool SP2 = false>
__device__ __forceinline__ void gemm_phase(PG8_LAS unsigned char* lds, const Gemm g, const Sched& S, const Epi& E) {
    const int tid = threadIdx.x, wid = __builtin_amdgcn_readfirstlane(tid >> 6), lane = tid & 63, wr = wid >> 2, wc = wid & 3, fr = lane & 15, fq = lane >> 4;
    const int K = g.K, nt = K / BK;
    unsigned voffA[2], voffB[2];
#pragma unroll
    for (int i = 0; i < 2; ++i) { int R, C; stage_rc(tid * 16 + i * 8192, R, C); const int Rb = Epi::PERM ? ((R & ~31) + perm32(R & 31)) : R;
        voffA[i] = (unsigned)(R * g.lda + C) * 2u; voffB[i] = (unsigned)(Rb * K + C) * 2u; }
    const size_t kstep = (size_t)(BK * 2);
    const size_t hstepB = (size_t)HALF * K * 2, hstepA = (size_t)HALF * g.lda * 2;
    const size_t tstepA = 2 * hstepA, tstepB = 2 * hstepB;
    const unsigned ldsw = (unsigned)wid * 1024u;
    const int aoff = lds_byte(wr * 64 + fr, fq * 8), boff = lds_byte(wc * 32 + fr, fq * 8);
#define PG8_SA(b, h) (((b) * 2 + (h)) * HTB)
#define PG8_SB(b, h) ((4 + (b) * 2 + (h)) * HTB)
#define PG8_STAGE(bufoff, gbase, voff) do { _Pragma("unroll") for (int _i = 0; _i < 2; ++_i) \
        __builtin_amdgcn_global_load_lds((const unsigned*)((const char*)(gbase) + (voff)[_i]), (PG8_LAS unsigned*)(lds + (bufoff) + ldsw + _i * 8192), 16, 0, 0); } while (0)
#define PG8_LDA(dst, b, h) do { _Pragma("unroll") for (int m = 0; m < 4; ++m) _Pragma("unroll") for (int k = 0; k < 2; ++k) dst[m][k] = *(const PG8_LAS bf16x8*)(lds + PG8_SA(b, h) + aoff + m * 2048 + k * 1024); } while (0)
#define PG8_LDB(dst, b, h) do { _Pragma("unroll") for (int n = 0; n < 2; ++n) _Pragma("unroll") for (int k = 0; k < 2; ++k) dst[n][k] = *(const PG8_LAS bf16x8*)(lds + PG8_SB(b, h) + boff + n * 2048 + k * 1024); } while (0)
#define PG8_MMA(ai, bj, At, Bt) do { __builtin_amdgcn_s_setprio(1); _Pragma("unroll") for (int m = 0; m < 4; ++m) _Pragma("unroll") for (int n = 0; n < 2; ++n) _Pragma("unroll") for (int k = 0; k < 2; ++k) \
        acc[ai][bj][m][n] = __builtin_amdgcn_mfma_f32_16x16x32_bf16(Bt[n][k], At[m][k], acc[ai][bj][m][n], 0, 0, 0); __builtin_amdgcn_s_setprio(0); } while (0)
#define PG8_WAIT_V(n) asm volatile("s_waitcnt vmcnt(" #n ")" ::: "memory")
#define PG8_WAIT_L(n) asm volatile("s_waitcnt lgkmcnt(" #n ")" ::: "memory")
#define PG8_BAR __builtin_amdgcn_s_barrier()
#define PG8_SCHED __builtin_amdgcn_sched_barrier(0)
    Unit cur, nxt; int ui = 0;
    if (!S.next(0, cur)) return;
    f32x4 acc[2][2][4][2];
#pragma unroll
    for (int a = 0; a < 2; ++a)
#pragma unroll
        for (int b = 0; b < 2; ++b)
#pragma unroll
            for (int m = 0; m < 4; ++m)
#pragma unroll
                for (int n = 0; n < 2; ++n) acc[a][b][m][n] = (f32x4){0.f, 0.f, 0.f, 0.f};
    bf16x8 At[4][2], B0[2][2], B1[2][2];
    const char* cA = (const char*)g.A + (size_t)cur.pm * tstepA; const char* cB = (const char*)g.Bt + (size_t)cur.pn * tstepB;
    S.a_ready(cur);
    if constexpr (SP2) {
        PG8_STAGE(PG8_SB(0, 0), cB, voffB); PG8_STAGE(PG8_SB(0, 1), cB + hstepB, voffB); PG8_STAGE(PG8_SA(0, 0), cA, voffA); PG8_STAGE(PG8_SA(0, 1), cA + hstepA, voffA);
        if (wr == 1) PG8_BAR;
        PG8_WAIT_V(2); PG8_BAR;
        PG8_STAGE(PG8_SB(1, 0), cB + kstep, voffB); PG8_STAGE(PG8_SA(1, 0), cA + kstep, voffA); PG8_STAGE(PG8_SB(1, 1), cB + hstepB + kstep, voffB);
        PG8_WAIT_V(6); PG8_BAR;
    } else {
        PG8_STAGE(PG8_SB(0, 0), cB, voffB); PG8_STAGE(PG8_SA(0, 0), cA, voffA); PG8_STAGE(PG8_SB(0, 1), cB + hstepB, voffB); PG8_STAGE(PG8_SA(0, 1), cA + hstepA, voffA);
        if (wr == 1) PG8_BAR;
        PG8_WAIT_V(4); PG8_BAR;
        PG8_STAGE(PG8_SB(1, 0), cB + kstep, voffB); PG8_STAGE(PG8_SA(1, 0), cA + kstep, voffA); PG8_STAGE(PG8_SB(1, 1), cB + hstepB + kstep, voffB);
        PG8_WAIT_V(6); PG8_BAR;
    }
    for (;;) {
        const bool has_next = S.next(ui + 1, nxt);
        const char* nA = has_next ? (const char*)g.A + (size_t)nxt.pm * tstepA : cA; const char* nB = has_next ? (const char*)g.Bt + (size_t)nxt.pn * tstepB : cB;
        for (int t = 0; t < nt; t += 2) {
            if constexpr (Epi::HAS_MID) { if (t == nt / 2) E.mid(acc, cur, wr, wc, fr, fq); }
            const bool last = (t == nt - 2);
            const char* a1 = cA + (size_t)(t + 1) * kstep;
            const char* a2 = last ? nA : cA + (size_t)(t + 2) * kstep; const char* b2 = last ? nB : cB + (size_t)(t + 2) * kstep;
            const char* a3 = a2 + kstep; const char* b3 = b2 + kstep;
            if (last && has_next) S.a_ready(nxt);
            if constexpr (SP2) {
            PG8_LDB(B0, 0, 0); PG8_LDB(B1, 0, 1); PG8_SCHED; PG8_LDA(At, 0, 0); PG8_STAGE(PG8_SA(1, 1), a1 + hstepA, voffA);
            PG8_WAIT_V(8); PG8_WAIT_L(0); PG8_BAR; PG8_MMA(0, 0, At, B0); PG8_MMA(0, 1, At, B1); PG8_BAR; PG8_SCHED;
            PG8_LDA(At, 0, 1); PG8_STAGE(PG8_SB(0, 0), b2, voffB); PG8_STAGE(PG8_SB(0, 1), b2 + hstepB, voffB); PG8_STAGE(PG8_SA(0, 0), a2, voffA);
            PG8_WAIT_V(8); PG8_WAIT_L(0); PG8_BAR; PG8_MMA(1, 0, At, B0); PG8_MMA(1, 1, At, B1); PG8_BAR; PG8_SCHED;
            PG8_LDB(B0, 1, 0); PG8_LDB(B1, 1, 1); PG8_SCHED; PG8_LDA(At, 1, 0); PG8_STAGE(PG8_SA(0, 1), a2 + hstepA, voffA);
            PG8_WAIT_V(8); PG8_WAIT_L(0); PG8_BAR; PG8_MMA(0, 0, At, B0); PG8_MMA(0, 1, At, B1); PG8_BAR; PG8_SCHED;
            PG8_LDA(At, 1, 1); PG8_STAGE(PG8_SB(1, 0), b3, voffB); PG8_STAGE(PG8_SB(1, 1), b3 + hstepB, voffB); PG8_STAGE(PG8_SA(1, 0), a3, voffA);
            PG8_WAIT_V(8); PG8_WAIT_L(0); PG8_BAR; PG8_MMA(1, 0, At, B0); PG8_MMA(1, 1, At, B1); PG8_BAR; PG8_SCHED;
            } else {
            PG8_LDB(B0, 0, 0); PG8_SCHED; PG8_LDA(At, 0, 0); PG8_STAGE(PG8_SA(1, 1), a1 + hstepA, voffA);
            PG8_WAIT_L(8); PG8_BAR; PG8_WAIT_L(0); PG8_MMA(0, 0, At, B0); PG8_BAR; PG8_SCHED;
            PG8_LDB(B1, 0, 1); PG8_STAGE(PG8_SB(0, 0), b2, voffB);
            PG8_BAR; PG8_WAIT_L(0); PG8_MMA(0, 1, At, B1); PG8_BAR;
            PG8_LDA(At, 0, 1); PG8_STAGE(PG8_SA(0, 0), a2, voffA);
            PG8_BAR; PG8_WAIT_L(0); PG8_MMA(1, 0, At, B0); PG8_BAR; PG8_SCHED;
            PG8_STAGE(PG8_SB(0, 1), b2 + hstepB, voffB);
            PG8_WAIT_V(6); PG8_BAR; PG8_MMA(1, 1, At, B1); PG8_BAR;
            PG8_LDB(B0, 1, 0); PG8_SCHED; PG8_LDA(At, 1, 0); PG8_STAGE(PG8_SA(0, 1), a2 + hstepA, voffA);
            PG8_WAIT_L(8); PG8_BAR; PG8_WAIT_L(0); PG8_MMA(0, 0, At, B0); PG8_BAR; PG8_SCHED;
            PG8_LDB(B1, 1, 1); PG8_STAGE(PG8_SB(1, 0), b3, voffB);
            PG8_BAR; PG8_WAIT_L(0); PG8_MMA(0, 1, At, B1); PG8_BAR;
            PG8_LDA(At, 1, 1); PG8_STAGE(PG8_SA(1, 0), a3, voffA);
            PG8_BAR; PG8_WAIT_L(0); PG8_MMA(1, 0, At, B0); PG8_BAR; PG8_SCHED;
            PG8_STAGE(PG8_SB(1, 1), b3 + hstepB, voffB);
            PG8_WAIT_V(6); PG8_BAR; PG8_MMA(1, 1, At, B1); PG8_BAR;
            }
        }
        if constexpr (ALIGN_EPI) { if (wr == 0) PG8_BAR; }
        if constexpr (!Epi::AFTER_DRAIN) { E(acc, cur, wr, wc, fr, fq); S.done(cur); }
        if (!has_next) break;
#pragma unroll
        for (int a = 0; a < 2; ++a)
#pragma unroll
            for (int b = 0; b < 2; ++b)
#pragma unroll
                for (int m = 0; m < 4; ++m)
#pragma unroll
                    for (int n = 0; n < 2; ++n) acc[a][b][m][n] = (f32x4){0.f, 0.f, 0.f, 0.f};
        cur = nxt; cA = nA; cB = nB; ++ui;
        if constexpr (ALIGN_EPI) { if (wr == 1) PG8_BAR; }
    }
    PG8_WAIT_V(0);
    if constexpr (!ALIGN_EPI) { if (wr == 0) PG8_BAR; }
    PG8_BAR;
    if constexpr (Epi::AFTER_DRAIN) { E.fused(acc, cur, wr, wc, fr, fq, lds, wid, lane); S.done(cur); }
#undef PG8_SA
#undef PG8_SB
#undef PG8_STAGE
#undef PG8_LDA
#undef PG8_LDB
#undef PG8_MMA
#undef PG8_WAIT_V
#undef PG8_WAIT_L
#undef PG8_BAR
#undef PG8_SCHED
}
}
#ifndef PG8_SP2
#define PG8_SP2 true
#endif
#ifndef PG8_ALIGN
#define PG8_ALIGN true
#endif

typedef unsigned short bf16_t;
constexpr int DM = 1024, BATCH = 16, SEQ = 2048, M = BATCH * SEQ, INCOLS = 7168, DFF = 2816, NMODC = 6 * DM;
constexpr float EPS = 1e-6f;
constexpr float C2 = 0.125f * 1.4426950408889634f;
constexpr size_t MiB = 1u << 20;
constexpr size_t WS_CTL = 0, CTL_ZERO_BYTES = 1 * MiB;
constexpr size_t WS_MOD = 1 * MiB, WS_COS = 2 * MiB, WS_SIN = 3 * MiB;
constexpr size_t WS_WIN = 4 * MiB, WS_WA = 18 * MiB, WS_WB = 20 * MiB, WS_WOUT = 22 * MiB, WS_WUP = 24 * MiB, WS_WDOWN = 35 * MiB;
constexpr size_t WS_H = 48 * MiB, WS_XR = 112 * MiB, WS_AO = 176 * MiB, WS_K = 304 * MiB, WS_V = 368 * MiB, WS_HF = 432 * MiB;
constexpr size_t WS_UP = 112 * MiB, WS_ACT = 288 * MiB, WS_EDGE = 112 * MiB;
constexpr size_t WS_NEED = 512 * MiB;
constexpr int CW_TMO = 0, CW_CODE = 1, CW_BAR = 4096;

constexpr int NWAVES = 8;
constexpr int RING_OFF = 0, RING_BYTES = 131072, LDSCTL_OFF = 159744, MISC_OFF = LDSCTL_OFF + 320, LDS_BYTES = 163840;

#define GAS __attribute__((address_space(1)))
#define LAS __attribute__((address_space(3)))
typedef unsigned v4u __attribute__((ext_vector_type(4)));
typedef unsigned v2u __attribute__((ext_vector_type(2)));
typedef float f32x4 __attribute__((ext_vector_type(4)));
typedef float f32x2 __attribute__((ext_vector_type(2)));
typedef short bf16x8 __attribute__((ext_vector_type(8)));
typedef GAS unsigned gu32;
#define RLX_AGENT __ATOMIC_RELAXED, __HIP_MEMORY_SCOPE_AGENT
#define LDS_WAIT() asm volatile("s_waitcnt lgkmcnt(0)" ::: "memory")
#define VM_WAIT() asm volatile("s_waitcnt vmcnt(0)" ::: "memory")

__device__ __forceinline__ float bf2f(bf16_t v) { return __uint_as_float((unsigned)v << 16); }
__device__ __forceinline__ unsigned f2bfu(float f) { unsigned u = __float_as_uint(f); return (u + 0x7fffu + ((u >> 16) & 1u)) >> 16; }
__device__ __forceinline__ bf16_t f2bf(float f) { return (bf16_t)f2bfu(f); }
__device__ __forceinline__ unsigned pk2(float lo, float hi) { return pg8::cvt_pk_bf16(lo, hi); }
__device__ __forceinline__ float lo_bf(unsigned w) { return __uint_as_float(w << 16); }
__device__ __forceinline__ float hi_bf(unsigned w) { return __uint_as_float(w & 0xffff0000u); }
__device__ __forceinline__ float fexp(float x) { return __builtin_amdgcn_exp2f(x * 1.4426950408889634f); }
__device__ __forceinline__ float frcp(float x) { return __builtin_amdgcn_rcpf(x); }
__device__ __forceinline__ float sigmoidf_(float x) { return frcp(1.f + fexp(-x)); }
__device__ __forceinline__ float gelu_tanh(float x) { const float u = 1.5957691216057308f * (x + 0.044715f * x * x * x); return x * frcp(1.f + fexp(-u)); }
__device__ __forceinline__ float wave_sum(float v) {
#pragma unroll
    for (int o = 1; o < 64; o <<= 1) v += __shfl_xor(v, o);
    return v;
}
typedef pg8::f32x4 (&AccRef)[2][2][4][2];
typedef const pg8::f32x4 (&AccCRef)[2][2][4][2];

#ifndef EPI_NT
#define EPI_NT 0
#endif
#if EPI_NT
#define ST16(p, v) __builtin_nontemporal_store((v), (v4u*)(p))
#else
#define ST16(p, v) (*(v4u*)(p) = (v))
#endif
struct EpiProj {
    static constexpr bool PERM = true, AFTER_DRAIN = false, HAS_MID = false;
    bf16_t *XR, *AO, *KB, *VB, *GT; const float *COS, *SIN; bf16_t* local;
    __device__ __forceinline__ void operator()(AccCRef acc, const pg8::Unit& u, int wr, int wc, int fr, int fq) const {
        const int pn = u.pn; bf16_t* base; int ldc, colt; float sc = 1.f; bool rope = false;
        if (pn < 4) { base = XR; ldc = 1024; colt = pn * 256; }
        else if (pn < 8) { base = AO; ldc = 2048; colt = (pn - 4) * 256; }
        else if (pn < 12) { base = AO + 1024; ldc = 2048; colt = (pn - 8) * 256; sc = C2; rope = true; }
        else if (pn < 16) { base = KB; ldc = 1024; colt = (pn - 12) * 256; rope = true; }
        else if (pn < 20) { base = VB; ldc = 1024; colt = (pn - 16) * 256; }
        else { base = GT; ldc = 2048; colt = (pn - 20) * 128; }
        const bool gates = pn >= 20;
        const bool dorope = rope && ((wc & 1) == 0);
        const int row0 = u.pm * 256 + wr * 64 + fr, col0 = colt + wc * 32 + 8 * fq;
        if (local) { base = local + (size_t)blockIdx.x * 65536 - (size_t)u.pm * 256 * 256 - colt; ldc = 256; }
#pragma unroll
        for (int ai = 0; ai < 2; ++ai)
#pragma unroll
            for (int m = 0; m < 4; ++m) {
                const int row = row0 + ai * 128 + m * 16;
                f32x4 c0 = {1.f, 1.f, 1.f, 1.f}, c1 = c0, s0 = {0.f, 0.f, 0.f, 0.f}, s1 = s0;
                if (dorope) { c0 = *(const f32x4*)(COS + (size_t)row * 8); c1 = *(const f32x4*)(COS + (size_t)row * 8 + 4); s0 = *(const f32x4*)(SIN + (size_t)row * 8); s1 = *(const f32x4*)(SIN + (size_t)row * 8 + 4);
                    if (fq == 0) { s0 = -s0; s1 = -s1; } if (fq >= 2) { c0 = (f32x4){1.f, 1.f, 1.f, 1.f}; c1 = c0; s0 = (f32x4){0.f, 0.f, 0.f, 0.f}; s1 = s0; } }
#pragma unroll
                for (int bj = 0; bj < 2; ++bj) {
                    f32x4 v0 = acc[ai][bj][m][0], v1 = acc[ai][bj][m][1];
                    if (dorope) { f32x4 p0, p1;
#pragma unroll
                        for (int e = 0; e < 4; ++e) { p0[e] = __shfl_xor(v0[e], 16); p1[e] = __shfl_xor(v1[e], 16); }
                        v0 = v0 * c0 + p0 * s0; v1 = v1 * c1 + p1 * s1; }
                    v0 = v0 * sc; v1 = v1 * sc;
                    if (gates) {
                        const f32x4 a0 = acc[ai][0][m][0], a1 = acc[ai][0][m][1], b0 = acc[ai][1][m][0], b1 = acc[ai][1][m][1];
#pragma unroll
                        for (int e = 0; e < 4; ++e) { const float eb0 = 1.f + fexp(-b0[e]), eb1 = 1.f + fexp(-b1[e]);
                            if (bj == 0) { v0[e] = eb0 * frcp(1.f + fexp(-a0[e])); v1[e] = eb1 * frcp(1.f + fexp(-a1[e])); } else { v0[e] = frcp(eb0); v1[e] = frcp(eb1); } }
                    }
                    v4u w; w.x = pk2(v0[0], v0[1]); w.y = pk2(v0[2], v0[3]); w.z = pk2(v1[0], v1[1]); w.w = pk2(v1[2], v1[3]);
#if defined(PROBE_FULLLINE)
                    if (local) { ST16(base + (size_t)(row - (fr >> 1) - (fr & 1)) * ldc + colt + wc * 64 + (fr & 1) * 32 + 8 * fq + bj * 128, w); } else
#endif
                    ST16(base + (size_t)row * ldc + col0 + bj * (gates ? 1024 : 128), w);
                }
            }
    }
};
typedef pg8::f32x4 (&AccMRef)[2][2][4][2];
struct EpiMerge {
    static constexpr bool PERM = true, AFTER_DRAIN = false, HAS_MID = true;
    const bf16_t* GT; bf16_t* MG;
    __device__ __forceinline__ void mid(AccMRef acc, const pg8::Unit& u, int wr, int wc, int fr, int fq) const {
        int zero = 0; asm volatile("" : "+v"(zero));
        const bf16_t* gp = GT + (size_t)(u.pm * 256 + wr * 64 + fr) * 2048 + u.pn * 256 + wc * 32 + 8 * fq + zero;
#pragma unroll
        for (int ai = 0; ai < 2; ++ai)
#pragma unroll
            for (int m = 0; m < 4; ++m) {
#pragma unroll
                for (int bj = 0; bj < 2; ++bj) {
                    const v4u g = *(const v4u*)(gp + (size_t)(ai * 128 + m * 16) * 2048 + bj * 128);
                    acc[ai][bj][m][0][0] *= lo_bf(g.x); acc[ai][bj][m][0][1] *= hi_bf(g.x); acc[ai][bj][m][0][2] *= lo_bf(g.y); acc[ai][bj][m][0][3] *= hi_bf(g.y);
                    acc[ai][bj][m][1][0] *= lo_bf(g.z); acc[ai][bj][m][1][1] *= hi_bf(g.z); acc[ai][bj][m][1][2] *= lo_bf(g.w); acc[ai][bj][m][1][3] *= hi_bf(g.w);
                }
                if (m & 1) asm volatile("" ::: "memory");
            }
    }
    __device__ __forceinline__ void operator()(AccCRef acc, const pg8::Unit& u, int wr, int wc, int fr, int fq) const {
        const int row0 = u.pm * 256 + wr * 64 + fr, col0 = u.pn * 256 + wc * 32 + 8 * fq;
#pragma unroll
        for (int ai = 0; ai < 2; ++ai)
#pragma unroll
            for (int m = 0; m < 4; ++m) {
                const int row = row0 + ai * 128 + m * 16;
#pragma unroll
                for (int bj = 0; bj < 2; ++bj) {
                    const v4u g = *(const v4u*)(GT + (size_t)row * 2048 + 1024 + col0 + bj * 128);
                    const f32x4 v0 = acc[ai][bj][m][0], v1 = acc[ai][bj][m][1];
                    v4u w; w.x = pk2(lo_bf(g.x) * v0[0], hi_bf(g.x) * v0[1]); w.y = pk2(lo_bf(g.y) * v0[2], hi_bf(g.y) * v0[3]);
                    w.z = pk2(lo_bf(g.z) * v1[0], hi_bf(g.z) * v1[1]); w.w = pk2(lo_bf(g.w) * v1[2], hi_bf(g.w) * v1[3]);
                    *(v4u*)(MG + (size_t)row * 1024 + col0 + bj * 128) = w;
                }
            }
    }
};
struct EpiResid1 {
    static constexpr bool PERM = true, AFTER_DRAIN = false, HAS_MID = false;
    const float* X; bf16_t* X1; const float* gate;
    __device__ __forceinline__ void operator()(AccCRef acc, const pg8::Unit& u, int wr, int wc, int fr, int fq) const {
        const int row0 = u.pm * 256 + wr * 64 + fr, col0 = u.pn * 256 + wc * 32 + 8 * fq; const float* gb = gate + (size_t)(u.pm >> 3) * NMODC;
        f32x4 gv[2][2];
#pragma unroll
        for (int bj = 0; bj < 2; ++bj)
#pragma unroll
            for (int n = 0; n < 2; ++n) gv[bj][n] = *(const f32x4*)(gb + col0 + bj * 128 + n * 4);
#pragma unroll
        for (int ai = 0; ai < 2; ++ai)
#pragma unroll
            for (int m = 0; m < 4; ++m) { const size_t off = (size_t)(row0 + ai * 128 + m * 16) * 1024 + col0;
#pragma unroll
                for (int bj = 0; bj < 2; ++bj) { const f32x4 r0 = *(const f32x4*)(X + off + bj * 128), r1 = *(const f32x4*)(X + off + bj * 128 + 4);
                    const f32x4 v0 = r0 + gv[bj][0] * acc[ai][bj][m][0], v1 = r1 + gv[bj][1] * acc[ai][bj][m][1];
                    v4u w; w.x = pk2(v0[0], v0[1]); w.y = pk2(v0[2], v0[3]); w.z = pk2(v1[0], v1[1]); w.w = pk2(v1[2], v1[3]);
                    *(v4u*)(X1 + off + bj * 128) = w; }
                if (m & 1) asm volatile("" ::: "memory"); }
    }
};
struct EpiResid2 {
    static constexpr bool PERM = true, AFTER_DRAIN = false, HAS_MID = false;
    const bf16_t* X1; float* OUT; const float* gate;
    __device__ __forceinline__ void operator()(AccCRef acc, const pg8::Unit& u, int wr, int wc, int fr, int fq) const {
        const int row0 = u.pm * 256 + wr * 64 + fr, col0 = u.pn * 256 + wc * 32 + 8 * fq; const float* gb = gate + (size_t)(u.pm >> 3) * NMODC;
        f32x4 gv[2][2];
#pragma unroll
        for (int bj = 0; bj < 2; ++bj)
#pragma unroll
            for (int n = 0; n < 2; ++n) gv[bj][n] = *(const f32x4*)(gb + col0 + bj * 128 + n * 4);
#pragma unroll
        for (int ai = 0; ai < 2; ++ai)
#pragma unroll
            for (int m = 0; m < 4; ++m) { const size_t off = (size_t)(row0 + ai * 128 + m * 16) * 1024 + col0;
#pragma unroll
                for (int bj = 0; bj < 2; ++bj) { const v4u x = *(const v4u*)(X1 + off + bj * 128);
                    const f32x4 r0 = {lo_bf(x.x), hi_bf(x.x), lo_bf(x.y), hi_bf(x.y)}, r1 = {lo_bf(x.z), hi_bf(x.z), lo_bf(x.w), hi_bf(x.w)};
                    *(f32x4*)(OUT + off + bj * 128) = r0 + gv[bj][0] * acc[ai][bj][m][0]; *(f32x4*)(OUT + off + bj * 128 + 4) = r1 + gv[bj][1] * acc[ai][bj][m][1]; }
                if (m & 1) asm volatile("" ::: "memory"); }
    }
};
template <int CTRL> __device__ __forceinline__ float dpp_rot(float v) { return __uint_as_float((unsigned)__builtin_amdgcn_update_dpp(0, (int)__float_as_uint(v), CTRL, 0xf, 0xf, false)); }
template <int CTRL> __device__ __forceinline__ float dpp_upd(float old, float v) { return __uint_as_float((unsigned)__builtin_amdgcn_update_dpp((int)__float_as_uint(old), (int)__float_as_uint(v), CTRL, 0xf, 0xf, false)); }
struct EpiUpConv {
    static constexpr bool PERM = true, AFTER_DRAIN = false, HAS_MID = false;
    bf16_t* ACT; float* EDGE; const float* cw; const float* cb;
    __device__ __forceinline__ void operator()(AccCRef acc, const pg8::Unit& u, int wr, int wc, int fr, int fq) const {
        const int jj = wc * 32 + 8 * fq, j = u.pn * 128 + jj;
        const int pc = u.pn * 256 + jj;
#pragma unroll
        for (int ai = 0; ai < 2; ++ai) {
            const int band = u.pm * 4 + ai * 2 + wr; const int rowb = band * 64;
            if (fr < 2) {
#pragma unroll
                for (int bj = 0; bj < 2; ++bj)
#pragma unroll
                    for (int n = 0; n < 2; ++n) *(f32x4*)(EDGE + ((size_t)band * 4 + fr) * 5632 + pc + bj * 128 + 4 * n) = acc[ai][bj][0][n];
            }
            if (fr >= 14) {
#pragma unroll
                for (int bj = 0; bj < 2; ++bj)
#pragma unroll
                    for (int n = 0; n < 2; ++n) *(f32x4*)(EDGE + ((size_t)band * 4 + fr - 12) * 5632 + pc + bj * 128 + 4 * n) = acc[ai][bj][3][n];
            }
            v2u pk0[4];
#pragma unroll
            for (int n = 0; n < 2; ++n) {
                float oe[4][4];
#pragma unroll
                for (int e = 0; e < 4; ++e) {
                    float vv[4];
#pragma unroll
                    for (int bj = 0; bj < 2; ++bj) {
                        const int oc = bj * DFF + j + 4 * n + e;
                        const float w0 = cw[oc], w1 = cw[2 * DFF + oc], w2 = cw[4 * DFF + oc], bs = cb[oc];
#pragma unroll
                        for (int m = 0; m < 4; ++m) {
                            const float cur = acc[ai][bj][m][n][e], pvs = acc[ai][bj][m > 0 ? m - 1 : 0][n][e], nxs = acc[ai][bj][m < 3 ? m + 1 : 3][n][e];
                            const float pv = dpp_upd<0x111>(dpp_rot<0x121>(pvs), cur), nx = dpp_upd<0x101>(dpp_rot<0x12F>(nxs), cur);
                            const float r = bs + w0 * pv + w1 * cur + w2 * nx;
                            if (bj == 0) vv[m] = r; else oe[m][e] = r * frcp(1.f + fexp(-r)) * vv[m];
                        }
                    }
                }
#pragma unroll
                for (int m = 0; m < 4; ++m) {
                    v2u w; w.x = pk2(oe[m][0], oe[m][1]); w.y = pk2(oe[m][2], oe[m][3]);
                    if (n == 0) pk0[m] = w;
                    else { const bool skip = (m == 0 && fr == 0) || (m == 3 && fr == 15); v4u w4; w4.x = pk0[m].x; w4.y = pk0[m].y; w4.z = w.x; w4.w = w.y;
                        if (!skip) *(v4u*)(ACT + (size_t)(rowb + m * 16 + fr) * DFF + j) = w4; }
                }
                asm volatile("" ::: "memory");
            }
        }
    }
};
struct EpiNull {
    static constexpr bool PERM = true, AFTER_DRAIN = false, HAS_MID = false; float* sink;
    __device__ __forceinline__ void operator()(AccCRef acc, const pg8::Unit& u, int wr, int wc, int fr, int fq) const {
        f32x4 s = {0.f, 0.f, 0.f, 0.f};
#pragma unroll
        for (int ai = 0; ai < 2; ++ai)
#pragma unroll
            for (int bj = 0; bj < 2; ++bj)
#pragma unroll
                for (int m = 0; m < 4; ++m)
#pragma unroll
                    for (int n = 0; n < 2; ++n) s += acc[ai][bj][m][n];
        if (s[0] + s[1] + s[2] + s[3] == 123.456f) *(f32x4*)(sink + (size_t)(u.pm * 4096 + u.pn * 16 + fr)) = s;
    }
};
namespace att {
using bf16x8 = __attribute__((ext_vector_type(8))) short;
using s16x4  = __attribute__((ext_vector_type(4))) short;
using f32x16 = __attribute__((ext_vector_type(16))) float;
using u32x4  = __attribute__((ext_vector_type(4))) unsigned;
constexpr int KVBLK = 64, LDK = 1024, LDQ = 2048;
constexpr int SHM_V = 64 * 128 * 2, SHM_K = 64 * 128 * 2, WS_OFF = 2 * SHM_V + 2 * SHM_K, LDS_BYTES = WS_OFF + 8 * 64 * 4;
constexpr float THR2 = 6.0f;
#define KSWZ(row, colB) ((row) * 256 + ((colB) ^ (((row) & 7) << 4)))
#define SBAR() __builtin_amdgcn_sched_barrier(0)
__device__ __forceinline__ int crow(int r, int hi) { return (r & 3) + 8 * (r >> 2) + 4 * hi; }
__device__ __forceinline__ unsigned cvtpk(float lo, float hi) { unsigned r; asm volatile("v_cvt_pk_bf16_f32 %0, %1, %2" : "=v"(r) : "v"(lo), "v"(hi)); return r; }
__device__ __forceinline__ void partialSM(f32x16& p0, f32x16& p1, float& m_reg, float& alpha) {
    float pmax = p0[0];
#pragma unroll
    for (int r = 1; r < 16; ++r) pmax = fmaxf(pmax, p0[r]);
#pragma unroll
    for (int r = 0; r < 16; ++r) pmax = fmaxf(pmax, p1[r]);
    { auto rr = __builtin_amdgcn_permlane32_swap(__float_as_uint(pmax), __float_as_uint(pmax), false, false); pmax = fmaxf(__uint_as_float(rr[0]), __uint_as_float(rr[1])); }
    float mn;
    if (__builtin_expect(__all(pmax - m_reg <= THR2), 1)) { mn = m_reg; alpha = 1.f; }
    else { mn = fmaxf(m_reg, pmax); alpha = __builtin_amdgcn_exp2f(m_reg - mn); m_reg = mn; }
#pragma unroll
    for (int r = 0; r < 16; ++r) { p0[r] -= mn; p1[r] -= mn; }
#pragma unroll
    for (int r = 0; r < 16; ++r) p0[r] = __builtin_amdgcn_exp2f(p0[r]);
}
__device__ __forceinline__ void finishSM(f32x16& p0, f32x16& p1, float alpha, float& l_reg, bf16x8& pa0, bf16x8& pa1, bf16x8& pa2, bf16x8& pa3) {
#pragma unroll
    for (int r = 0; r < 16; ++r) p1[r] = __builtin_amdgcn_exp2f(p1[r]);
    float ps = 0;
#pragma unroll
    for (int r = 0; r < 16; ++r) ps += p0[r];
#pragma unroll
    for (int r = 0; r < 16; ++r) ps += p1[r];
    { auto rr = __builtin_amdgcn_permlane32_swap(__float_as_uint(ps), __float_as_uint(ps), false, false); ps = __uint_as_float(rr[0]) + __uint_as_float(rr[1]); }
    l_reg = l_reg * alpha + ps;
#define PK4(P, BASE, OUT) do { unsigned a0 = cvtpk(P[BASE + 0], P[BASE + 1]), a1 = cvtpk(P[BASE + 2], P[BASE + 3]);   \
    unsigned b0 = cvtpk(P[BASE + 4], P[BASE + 5]), b1 = cvtpk(P[BASE + 6], P[BASE + 7]);                              \
    auto r0 = __builtin_amdgcn_permlane32_swap(a0, b0, false, false); auto r1 = __builtin_amdgcn_permlane32_swap(a1, b1, false, false); \
    u32x4 w = {r0[0], r1[0], r0[1], r1[1]}; OUT = *reinterpret_cast<bf16x8*>(&w); } while (0)
    PK4(p0, 0, pa0); PK4(p0, 8, pa1); PK4(p1, 0, pa2); PK4(p1, 8, pa3);
#undef PK4
}
__device__ __forceinline__ void qkt(f32x16& p0, f32x16& p1, const char* Ks, const bf16x8* qr, int c, int r32, int hi) {
    p0 = f32x16{}; p1 = f32x16{};
#pragma unroll
    for (int d0 = 0; d0 < 4; ++d0) { const int cb = ((c * 4 + d0) * 16 + hi * 8) * 2;
        const bf16x8 b0 = *reinterpret_cast<const bf16x8*>(Ks + KSWZ(r32, cb));
        const bf16x8 b1 = *reinterpret_cast<const bf16x8*>(Ks + KSWZ(32 + r32, cb));
        p0 = __builtin_amdgcn_mfma_f32_32x32x16_bf16(b0, qr[d0], p0, 0, 0, 0);
        p1 = __builtin_amdgcn_mfma_f32_32x32x16_bf16(b1, qr[d0], p1, 0, 0, 0); }
}
__device__ __forceinline__ int v_st(int k, int c) { const int kk = (k & ~0xC) | ((k & 4) << 1) | ((k & 8) >> 1); return ((kk >> 3) * 4 + (c >> 5)) * 512 + ((kk & 7) * 32 + (c & 31)) * 2; }
__device__ __forceinline__ int v_rd_base(int lane) { return ((lane & 3) << 3) | (((lane >> 2) & 3) << 6) | (((lane >> 4) & 1) << 5) | (((lane >> 5) & 1) << 8); }
constexpr int v_rd_off(int d0, int ks, int half) { return d0 * 512 + ks * 4096 + half * 2048; }
template <int OFF> __device__ __forceinline__ s16x4 tr_read(int vb) { s16x4 r; asm volatile("ds_read_b64_tr_b16 %0, %1 offset:%2" : "=&v"(r) : "v"(vb), "i"(OFF) : "memory"); return r; }
template <int D0> __device__ __forceinline__ void pv_one(f32x16& od, int vb, bf16x8 pa0, bf16x8 pa1, bf16x8 pa2, bf16x8 pa3) {
    const s16x4 l0 = tr_read<v_rd_off(D0, 0, 0)>(vb), h0 = tr_read<v_rd_off(D0, 0, 1)>(vb), l1 = tr_read<v_rd_off(D0, 1, 0)>(vb), h1 = tr_read<v_rd_off(D0, 1, 1)>(vb);
    const s16x4 l2 = tr_read<v_rd_off(D0, 2, 0)>(vb), h2 = tr_read<v_rd_off(D0, 2, 1)>(vb), l3 = tr_read<v_rd_off(D0, 3, 0)>(vb), h3 = tr_read<v_rd_off(D0, 3, 1)>(vb);
    asm volatile("s_waitcnt lgkmcnt(0)" ::: "memory"); SBAR();
#define PK(L, H) (bf16x8){L[0], L[1], L[2], L[3], H[0], H[1], H[2], H[3]}
    od = __builtin_amdgcn_mfma_f32_32x32x16_bf16(pa0, PK(l0, h0), od, 0, 0, 0);
    od = __builtin_amdgcn_mfma_f32_32x32x16_bf16(pa1, PK(l1, h1), od, 0, 0, 0);
    od = __builtin_amdgcn_mfma_f32_32x32x16_bf16(pa2, PK(l2, h2), od, 0, 0, 0);
    od = __builtin_amdgcn_mfma_f32_32x32x16_bf16(pa3, PK(l3, h3), od, 0, 0, 0);
#undef PK
}
__device__ __forceinline__ void pv_d0(f32x16* o, int vb, bf16x8 pa0, bf16x8 pa1, bf16x8 pa2, bf16x8 pa3) {
    pv_one<0>(o[0], vb, pa0, pa1, pa2, pa3); pv_one<1>(o[1], vb, pa0, pa1, pa2, pa3); pv_one<2>(o[2], vb, pa0, pa1, pa2, pa3); pv_one<3>(o[3], vb, pa0, pa1, pa2, pa3);
}
template <bool DUMMY> __device__ __forceinline__ void attn_unit(int b, int h, int qb, bf16_t* AO, const bf16_t* __restrict__ KB, const bf16_t* __restrict__ VB, float lam, const float* __restrict__ subg, char* lds, bf16_t* Odummy) {
    const int tid = threadIdx.x, wid = tid >> 6, lane = tid & 63, r32 = lane & 31, hi = lane >> 5, c = wid >> 2, wq = wid & 3;
    char* V_lds = lds; char* K_lds = lds + 2 * SHM_V;
    float* ws = (float*)(lds + WS_OFF) + wid * 64; float* li_l = ws; float* al_l = ws + 32;
    const size_t rowbase = (size_t)b * SEQ; const int q0 = qb * 128;
    float m_reg = -1e30f, l_reg = 0; f32x16 o[4] = {}; bf16x8 qr[4];
    bf16_t* Qrow = AO + (rowbase + q0 + wq * 32) * LDQ + 1024 + h * 128;
    { const bf16_t* Qw = Qrow + (size_t)r32 * LDQ + c * 64 + hi * 8;
#pragma unroll
      for (int d0 = 0; d0 < 4; ++d0) qr[d0] = *reinterpret_cast<const bf16x8*>(Qw + d0 * 16); }
    const bf16_t* Kh = KB + rowbase * LDK + h * 128; const bf16_t* Vh = VB + rowbase * LDK + h * 128;
    const int sr = tid >> 4, sc = (tid & 15) * 8, vst0 = v_st(sr, sc), vst1 = v_st(32 + sr, sc);
    const int vb0 = (int)(uintptr_t)V_lds + v_rd_base(lane);
    struct { bf16x8 vs0, vs1, ks0, ks1; } sr_[1];
#define SLOAD(i, k0) do { sr_[i].vs0 = *reinterpret_cast<const bf16x8*>(&Vh[(size_t)((k0) + sr) * LDK + sc]); sr_[i].vs1 = *reinterpret_cast<const bf16x8*>(&Vh[(size_t)((k0) + 32 + sr) * LDK + sc]); \
    sr_[i].ks0 = *reinterpret_cast<const bf16x8*>(&Kh[(size_t)((k0) + sr) * LDK + sc]); sr_[i].ks1 = *reinterpret_cast<const bf16x8*>(&Kh[(size_t)((k0) + 32 + sr) * LDK + sc]); } while (0)
#define SWRITE(bf, i) do { *(bf16x8*)(V_lds + (bf) * SHM_V + vst0) = sr_[i].vs0; *(bf16x8*)(V_lds + (bf) * SHM_V + vst1) = sr_[i].vs1; const int kc = sc * 2; \
    *(bf16x8*)(K_lds + (bf) * SHM_K + KSWZ(sr, kc)) = sr_[i].ks0; *(bf16x8*)(K_lds + (bf) * SHM_K + KSWZ(32 + sr, kc)) = sr_[i].ks1; } while (0)
#define SWAIT() asm volatile("s_waitcnt vmcnt(0)" ::: "memory")
#define RESC(a) do { if (__any((a) < 1.f)) { if (hi == 0) al_l[r32] = (a); asm volatile("s_waitcnt lgkmcnt(0)" ::: "memory"); \
    _Pragma("unroll") for (int d = 0; d < 4; ++d) _Pragma("unroll") for (int r = 0; r < 16; ++r) o[d][r] *= al_l[crow(r, hi)]; } } while (0)
    f32x16 pA0, pA1, pB0, pB1; float alA, alB; bf16x8 pa0, pa1, pa2, pa3; constexpr int NT = SEQ / KVBLK;
    constexpr int SE = 0, SO = 0;
    SLOAD(SE, 0); asm volatile("s_waitcnt vmcnt(0)" ::: "memory"); SWRITE(0, SE); __syncthreads();
    qkt(pA0, pA1, K_lds, qr, c, r32, hi); partialSM(pA0, pA1, m_reg, alA);
    SLOAD(SO, KVBLK);
    SWAIT(); SWRITE(1, SO); __syncthreads();
    for (int j = 1; j + 1 < NT; j += 2) {
        SBAR(); qkt(pB0, pB1, K_lds + SHM_K, qr, c, r32, hi);
        finishSM(pA0, pA1, alA, l_reg, pa0, pa1, pa2, pa3); SBAR();
        SLOAD(SO, (j + 1) * KVBLK); SBAR();
        pv_d0(o, vb0, pa0, pa1, pa2, pa3); partialSM(pB0, pB1, m_reg, alB);
        __syncthreads(); SWAIT(); SWRITE(0, SE);
        RESC(alB); __syncthreads();
        SBAR(); qkt(pA0, pA1, K_lds, qr, c, r32, hi);
        finishSM(pB0, pB1, alB, l_reg, pa0, pa1, pa2, pa3); SBAR();
        SLOAD(SE, (j + 2) * KVBLK); SBAR();
        pv_d0(o, vb0 + SHM_V, pa0, pa1, pa2, pa3); partialSM(pA0, pA1, m_reg, alA);
        __syncthreads(); SWAIT(); SWRITE(1, SO);
        RESC(alA); __syncthreads();
    }
    SBAR(); qkt(pB0, pB1, K_lds + SHM_K, qr, c, r32, hi);
    finishSM(pA0, pA1, alA, l_reg, pa0, pa1, pa2, pa3); SBAR();
    pv_d0(o, vb0, pa0, pa1, pa2, pa3); partialSM(pB0, pB1, m_reg, alB);
    __syncthreads(); RESC(alB);
    finishSM(pB0, pB1, alB, l_reg, pa0, pa1, pa2, pa3); SBAR();
    pv_d0(o, vb0 + SHM_V, pa0, pa1, pa2, pa3);
    if (hi == 0) li_l[r32] = l_reg; asm volatile("s_waitcnt lgkmcnt(0)" ::: "memory");
    float rli[16];
#pragma unroll
    for (int r = 0; r < 16; ++r) rli[r] = __builtin_amdgcn_rcpf(li_l[crow(r, hi)]);
    __syncthreads();
    float* X = (float*)lds + wq * 4096;
    if (c == 1) {
#pragma unroll
        for (int r = 0; r < 16; ++r)
#pragma unroll
            for (int d0 = 0; d0 < 4; ++d0) X[crow(r, hi) * 128 + d0 * 32 + r32] = o[d0][r] * rli[r];
    }
    __syncthreads();
    if (c == 0) {
        float g4[4];
#pragma unroll
        for (int d0 = 0; d0 < 4; ++d0) g4[d0] = subg[d0 * 32 + r32] * 0.8f;
#pragma unroll
        for (int r = 0; r < 16; ++r) {
            float v[4], ss = 0.f;
#pragma unroll
            for (int d0 = 0; d0 < 4; ++d0) { v[d0] = o[d0][r] * rli[r] - lam * X[crow(r, hi) * 128 + d0 * 32 + r32]; ss += v[d0] * v[d0]; }
            ss += __shfl_xor(ss, 1); ss += __shfl_xor(ss, 2); ss += __shfl_xor(ss, 4); ss += __shfl_xor(ss, 8); ss += __shfl_xor(ss, 16);
            const float rstd = rsqrtf(ss * (1.f / 128.f) + EPS);
            bf16_t* Or = DUMMY ? Odummy + (rowbase + q0 + wq * 32 + crow(r, hi)) * (size_t)1024 + h * 128 + r32 : Qrow + (size_t)crow(r, hi) * LDQ + r32;
#pragma unroll
            for (int d0 = 0; d0 < 4; ++d0) Or[d0 * 32] = f2bf(v[d0] * rstd * g4[d0]);
        }
    }
    __syncthreads();
#undef SLOAD
#undef SWRITE
#undef SWAIT
#undef RESC
}
#undef KSWZ
#undef SBAR
}
namespace att2 {
using bf16x8=__attribute__((ext_vector_type(8)))short;
using s16x4=__attribute__((ext_vector_type(4)))short;
using f32x16=__attribute__((ext_vector_type(16)))float;
using u32x4=__attribute__((ext_vector_type(4)))unsigned;
constexpr int LDK=1024, LDQ=2048, KVBLK=64, NT=SEQ/KVBLK;
constexpr int NSLOT=3, SLOTB=16384;
constexpr int LDS_K=0, LDS_V=NSLOT*SLOTB, LDS_WS=2*NSLOT*SLOTB, LDS_QF=LDS_WS+8*64*4, LDS_BYTES=LDS_QF+8*4096;
__device__ __forceinline__ int crow(int r,int hi){return (r&3)+8*(r>>2)+4*hi;}
#define SBAR() __builtin_amdgcn_sched_barrier(0)
__device__ __forceinline__ void glds16(const void*gsrc,unsigned lds_dst){unsigned keep;
  asm volatile("s_mov_b32 %0, m0\n\ts_mov_b32 m0, %2\n\ts_nop 0\n\tglobal_load_lds_dwordx4 %1, off\n\ts_mov_b32 m0, %0":"=&s"(keep):"v"(gsrc),"s"(lds_dst):"memory");}
__device__ __forceinline__ float max3f(float a,float b,float c){float r;asm("v_max3_f32 %0, %1, %2, %3":"=v"(r):"v"(a),"v"(b),"v"(c));return r;}
__device__ __forceinline__ float max2f(float a,float b){float r;asm("v_max_f32_e32 %0, %1, %2":"=v"(r):"v"(a),"v"(b));return r;}
__device__ __forceinline__ float fadd_s(float a,float b){float r;asm("v_add_f32_e32 %0, %1, %2":"=v"(r):"v"(a),"v"(b));return r;}
__device__ __forceinline__ float fsub_s(float a,float b){float r;asm("v_sub_f32_e32 %0, %1, %2":"=v"(r):"v"(a),"v"(b));return r;}
typedef float f32x2_t __attribute__((ext_vector_type(2))); typedef __bf16 bf16x2_t __attribute__((ext_vector_type(2)));
__device__ __forceinline__ unsigned cvtpk_s(float lo,float hi){f32x2_t v={lo,hi};bf16x2_t b=__builtin_convertvector(v,bf16x2_t);return __builtin_bit_cast(unsigned,b);}
#define WAIT_BAR(N) asm volatile("s_waitcnt vmcnt(" #N ") lgkmcnt(0)\n\ts_barrier":::"memory")
typedef __attribute__((address_space(3))) const char* lds_cptr;
typedef short v4i16_t __attribute__((ext_vector_type(4)));
#define LDS8(p) (*(const __attribute__((address_space(3))) bf16x8*)(p))
__device__ __forceinline__ void kload8(bf16x8*kf,lds_cptr kp){
  kf[0]=LDS8(kp);      kf[1]=LDS8(kp+512);  kf[2]=LDS8(kp+2048); kf[3]=LDS8(kp+2560);
  kf[4]=LDS8(kp+4096); kf[5]=LDS8(kp+4608); kf[6]=LDS8(kp+6144); kf[7]=LDS8(kp+6656);
}
__device__ __forceinline__ s16x4 vtr(lds_cptr p){ return __builtin_bit_cast(s16x4,__builtin_amdgcn_ds_read_tr16_b64_v4i16((__attribute__((address_space(3))) v4i16_t*)p)); }
__device__ __forceinline__ float rowmax(const f32x16&p0,const f32x16&p1){
  float a=max3f(p0[0],p0[1],p1[0]),b=max3f(p0[2],p0[3],p1[1]);a=max3f(a,p1[2],p1[3]);
  #pragma unroll
  for(int r=4;r<16;r+=4){a=max3f(a,p0[r],p0[r+1]);b=max3f(b,p0[r+2],p0[r+3]);a=max3f(a,p1[r],p1[r+1]);b=max3f(b,p1[r+2],p1[r+3]);}
  const float m=max2f(a,b);
  auto rr=__builtin_amdgcn_permlane32_swap(__float_as_uint(m),__float_as_uint(m),false,false);
  return max2f(__uint_as_float(rr[0]),__uint_as_float(rr[1]));
}
__device__ __forceinline__ void pv_all(f32x16*o,int vb,bf16x8 pa0,bf16x8 pa1,bf16x8 pa2,bf16x8 pa3){
  #pragma unroll
  for(int d0=0;d0<4;++d0){s16x4 lo[4],hi[4];
    #pragma unroll
    for(int ks=0;ks<4;++ks){
      asm volatile("ds_read_b64_tr_b16 %0,%1 offset:%c2":"=&v"(lo[ks]):"v"(vb),"i"(d0*4096+ks*1024):"memory");
      asm volatile("ds_read_b64_tr_b16 %0,%1 offset:%c2":"=&v"(hi[ks]):"v"(vb),"i"(d0*4096+ks*1024+512):"memory");}
    asm volatile("s_waitcnt lgkmcnt(0)":::"memory");SBAR();
    #define PK(k) (bf16x8){lo[k][0],lo[k][1],lo[k][2],lo[k][3],hi[k][0],hi[k][1],hi[k][2],hi[k][3]}
    o[d0]=__builtin_amdgcn_mfma_f32_32x32x16_bf16(pa0,PK(0),o[d0],0,0,0);
    o[d0]=__builtin_amdgcn_mfma_f32_32x32x16_bf16(pa1,PK(1),o[d0],0,0,0);
    o[d0]=__builtin_amdgcn_mfma_f32_32x32x16_bf16(pa2,PK(2),o[d0],0,0,0);
    o[d0]=__builtin_amdgcn_mfma_f32_32x32x16_bf16(pa3,PK(3),o[d0],0,0,0);
    #undef PK
  }
}
template<int THRL,bool DUMMY> __device__ __forceinline__ void attn_unit(int b,int h,int qb,bf16_t*AO,const bf16_t*__restrict__ KB,const bf16_t*__restrict__ VB,float lam,const float*__restrict__ subg,char*shm,bf16_t*Odummy){
  const int tid=threadIdx.x,lane=tid&63,r32=lane&31,hi=lane>>5; const int wid=__builtin_amdgcn_readfirstlane(tid>>6); const int c=wid>>2,wq=wid&3;
  const size_t rowbase=(size_t)b*SEQ; const int q0=qb*128;
  bf16_t*Qrow=AO+(rowbase+q0+wq*32)*LDQ+1024+h*128;
  const bf16_t*Kh=KB+rowbase*LDK+h*128,*Vh=VB+rowbase*LDK+h*128;
  const unsigned lds0=(unsigned)(uintptr_t)shm;
  float*wsf=(float*)(shm+LDS_WS)+wid*64;
  const bf16_t*ksrc=Kh+(size_t)lane*LDK+wid*8;
  const bf16_t*vsrc=Vh+(size_t)(16*(wid&3)+(lane>>2))*LDK+(wid>>2)*32+(lane&3)*8;
  const unsigned kdst=lds0+LDS_K+wid*1024, vdst=lds0+LDS_V+(wid>>2)*4096+(wid&3)*1024;
  #define DMA_K(t,slot) do{ glds16(ksrc+(size_t)(t)*KVBLK*LDK,(unsigned)__builtin_amdgcn_readfirstlane(kdst+(slot))); glds16(ksrc+(size_t)(t)*KVBLK*LDK+64,(unsigned)__builtin_amdgcn_readfirstlane(kdst+(slot)+8192)); }while(0)
  #define DMA_V(t,slot) do{ glds16(vsrc+(size_t)(t)*KVBLK*LDK,(unsigned)__builtin_amdgcn_readfirstlane(vdst+(slot))); glds16(vsrc+(size_t)(t)*KVBLK*LDK+64,(unsigned)__builtin_amdgcn_readfirstlane(vdst+(slot)+8192)); }while(0)
  #define DMA_K0(t,slot) glds16(ksrc+(size_t)(t)*KVBLK*LDK,(unsigned)__builtin_amdgcn_readfirstlane(kdst+(slot)))
  #define DMA_K1(t,slot) glds16(ksrc+(size_t)(t)*KVBLK*LDK+64,(unsigned)__builtin_amdgcn_readfirstlane(kdst+(slot)+8192))
  #define DMA_V0(t,slot) glds16(vsrc+(size_t)(t)*KVBLK*LDK,(unsigned)__builtin_amdgcn_readfirstlane(vdst+(slot)))
  #define DMA_V1(t,slot) glds16(vsrc+(size_t)(t)*KVBLK*LDK+64,(unsigned)__builtin_amdgcn_readfirstlane(vdst+(slot)+8192))
  const int vb0=(int)(lds0+LDS_V)+((lane>>4)&1)*32+(lane&3)*8+(4*hi+((lane&15)>>2))*64;
  bf16x8 kf[8];
  const lds_cptr shm3=(lds_cptr)shm; const lds_cptr kp0=shm3+LDS_K+c*8192+hi*1024+r32*16; const lds_cptr vp0=shm3+LDS_V+((lane>>4)&1)*32+(lane&3)*8+(4*hi+((lane&15)>>2))*64;
  const lds_cptr qf=shm3+LDS_QF+wid*4096+lane*16;
  DMA_K(0,0);DMA_V(0,0);DMA_K(1,SLOTB);
  { const bf16_t*Qw=Qrow+(size_t)r32*LDQ+c*64+hi*8; char*qw=shm+LDS_QF+wid*4096+lane*16;
    #pragma unroll
    for(int d0=0;d0<4;++d0)*reinterpret_cast<bf16x8*>(qw+d0*1024)=*reinterpret_cast<const bf16x8*>(Qw+d0*16); }
  float mhat=0.f,l_reg=0.f;f32x16 o[4];o[0]=f32x16{};o[1]=f32x16{};o[2]=f32x16{};o[3]=f32x16{};const f32x16 zero16=f32x16{};
  bool resc=false;
  #define START(P0,P1) do{ const float rm=rowmax(P0,P1); resc=false; \
    { const float dl=rm; mhat=fadd_s(mhat,dl); \
      _Pragma("unroll") for(int r=0;r<16;++r){P0[r]=fsub_s(P0[r],dl);P1[r]=fsub_s(P1[r],dl);} \
      } \
    _Pragma("unroll") for(int r=0;r<16;++r)P0[r]=__builtin_amdgcn_exp2f(P0[r]); }while(0)
  #define RESC() do{ if(resc){ asm volatile("s_waitcnt lgkmcnt(0)":::"memory"); \
      _Pragma("unroll") for(int d_=0;d_<4;++d_) _Pragma("unroll") for(int r=0;r<16;++r)o[d_][r]*=wsf[crow(r,hi)]; } }while(0)
  f32x16 pA0,pA1,pB0,pB1;
  int sl_prev=0,sl_cur=0,sl_next=SLOTB;
  #define ROT() do{sl_prev=sl_cur;sl_cur=sl_next;sl_next=(sl_next==(NSLOT-1)*SLOTB)?0:sl_next+SLOTB;}while(0)
  DMA_K(2,2*SLOTB);
  WAIT_BAR(6);
  { pA0=zero16; pA1=zero16;
    #pragma unroll
    for(int d0=0;d0<4;++d0){ const bf16x8 q=LDS8(qf+d0*1024); const bf16x8 b0=LDS8(kp0+d0*2048), b1=LDS8(kp0+d0*2048+512);
      pA0=__builtin_amdgcn_mfma_f32_32x32x16_bf16(b0,q,pA0,0,0,0); pA1=__builtin_amdgcn_mfma_f32_32x32x16_bf16(b1,q,pA1,0,0,0); } }
  asm volatile("s_nop 15\n\ts_nop 7":"+v"(pA0),"+v"(pA1));
  START(pA0,pA1);
  _Pragma("unroll") for(int r=0;r<16;++r)pA1[r]=__builtin_amdgcn_exp2f(pA1[r]);
  WAIT_BAR(0);
  DMA_K(3,0);DMA_V(1,SLOTB);
  ROT();
  kload8(kf,kp0+sl_cur);
  WAIT_BAR(4);
  s16x4 vlo[8],vhi[8]; u32x4 pw0,pw1,pw2,pw3;
  #define PKW(P,B) cvtpk_s(P[B],P[B+1])
  #define PAF(k) __builtin_bit_cast(bf16x8,pw##k)
  #define VFR(i) (bf16x8){vlo[i][0],vlo[i][1],vlo[i][2],vlo[i][3],vhi[i][0],vhi[i][1],vhi[i][2],vhi[i][3]}
  #define PIN(x) asm volatile("":"+v"(x))
  #define MX3(a,b,c) __builtin_fmaxf(__builtin_fmaxf((a),(b)),(c))
  #define GAPA(MF,A0,A1,A2,A3,W0,W1,PW) do{ MF; sacc+=A0; sacc+=A1; sacc+=A2; sacc+=A3; PIN(sacc); W0; W1; PIN(PW); SBAR(); }while(0)
  #define EX(v) __builtin_amdgcn_exp2f(v)
  #define GAPB(MF,X,B) do{ MF; X[B]=EX(X[B]-mhat); X[B+1]=EX(X[B+1]-mhat); PIN(X); SBAR(); }while(0)
  #define VRDS(s,f) do{ vlo[s]=vtr(vp_+(((f)>>2)*4096+((f)&3)*1024)); vhi[s]=vtr(vp_+(((f)>>2)*4096+((f)&3)*1024+512)); }while(0)
  #define KRD(G,j) do{ if(G){ kf[j]=LDS8(kp0+sl_next+((j)>>1)*2048+((j)&1)*512); SBAR(); } }while(0)
  #define QKM(Cx,kk,qq,Cin) Cx=__builtin_amdgcn_mfma_f32_32x32x16_bf16(kf[kk],qq,Cin,0,0,0)
  #define PVM(d,k,s) o[d]=__builtin_amdgcn_mfma_f32_32x32x16_bf16(PAF(k),VFR(s),o[d],0,0,0)
  #define STEP(C0,C1,P0,P1,t,GK,GV,GL) do{ SBAR(); \
    const lds_cptr vp_=vp0+sl_prev; \
    bf16x8 qa=LDS8(qf), qb_; \
    VRDS(0,0); SBAR(); float sacc=(P0[0]+P0[1]); \
    GAPA(QKM(C0,0,qa,zero16), P0[2],P0[3],P0[4],P0[5],     pw0[0]=PKW(P0,0), pw0[1]=PKW(P0,2), pw0); \
    VRDS(1,4); qb_=LDS8(qf+1024); SBAR(); GAPA(QKM(C1,1,qa,zero16), P0[6],P0[7],P0[8],P0[9],     pw0[2]=PKW(P0,4), pw0[3]=PKW(P0,6), pw0); \
    VRDS(2,1); SBAR(); GAPA(QKM(C0,2,qb_,C0),   P0[10],P0[11],P0[12],P0[13], pw1[0]=PKW(P0,8), pw1[1]=PKW(P0,10), pw1); \
    VRDS(3,5); qa=LDS8(qf+2048); SBAR(); GAPA(QKM(C1,3,qb_,C1),   P0[14],P0[15],P1[0],P1[1],   pw1[2]=PKW(P0,12),pw1[3]=PKW(P0,14), pw1); \
    VRDS(4,2); SBAR(); GAPA(QKM(C0,4,qa,C0),   P1[2],P1[3],P1[4],P1[5],     pw2[0]=PKW(P1,0), pw2[1]=PKW(P1,2), pw2); \
    VRDS(5,6); qb_=LDS8(qf+3072); SBAR(); GAPA(QKM(C1,5,qa,C1),   P1[6],P1[7],P1[8],P1[9],     pw2[2]=PKW(P1,4), pw2[3]=PKW(P1,6), pw2); \
    VRDS(6,3); SBAR(); GAPA(QKM(C0,6,qb_,C0),   P1[10],P1[11],P1[12],P1[13], pw3[0]=PKW(P1,8), pw3[1]=PKW(P1,10), pw3); \
    VRDS(7,7); SBAR(); GAPA(QKM(C1,7,qb_,C1),   P1[14],P1[15],0.f,0.f,       pw3[2]=PKW(P1,12),pw3[3]=PKW(P1,14), pw3); \
    l_reg+=sacc; \
    { float a=MX3(C0[0],C0[1],C1[0]),b=MX3(C0[2],C0[3],C1[1]); a=MX3(a,C1[2],C1[3]); \
      _Pragma("unroll") for(int r=4;r<16;r+=4){a=MX3(a,C0[r],C0[r+1]);b=MX3(b,C0[r+2],C0[r+3]);a=MX3(a,C1[r],C1[r+1]);b=MX3(b,C1[r+2],C1[r+3]);} \
      float rm=__builtin_fmaxf(a,b); { auto rr=__builtin_amdgcn_permlane32_swap(__float_as_uint(rm),__float_as_uint(rm),false,false); rm=__builtin_fmaxf(__uint_as_float(rr[0]),__uint_as_float(rr[1])); } \
      resc=false; rm-=mhat; \
      if(__builtin_expect(__any(rm>(float)THRL),0)){ const float dl=__builtin_fmaxf(rm,0.f); mhat+=dl; \
        const float f=__builtin_amdgcn_exp2f(-dl); l_reg*=f; if(hi==0)wsf[r32]=f; resc=true; } } \
    SBAR(); \
    GAPB(PVM(0,0,0), C0,0);  VRDS(0,8);  SBAR(); \
    GAPB(PVM(1,0,1), C0,2);  VRDS(1,12); if(GK){DMA_K0((t)+3,sl_cur);} SBAR(); \
    GAPB(PVM(0,1,2), C0,4);  VRDS(2,9);  SBAR(); \
    GAPB(PVM(1,1,3), C0,6);  VRDS(3,13); if(GK){DMA_K1((t)+3,sl_cur);} SBAR(); \
    GAPB(PVM(0,2,4), C0,8);  VRDS(4,10); SBAR(); \
    GAPB(PVM(1,2,5), C0,10); VRDS(5,14); if(GV){DMA_V0((t)+1,sl_next);} SBAR(); \
    GAPB(PVM(0,3,6), C0,12); VRDS(6,11); SBAR(); \
    GAPB(PVM(1,3,7), C0,14); VRDS(7,15); if(GV){DMA_V1((t)+1,sl_next);} SBAR(); \
    KRD(GL,0); GAPB(PVM(2,0,0), C1,0); \
    KRD(GL,1); GAPB(PVM(3,0,1), C1,2); \
    KRD(GL,2); GAPB(PVM(2,1,2), C1,4); \
    KRD(GL,3); GAPB(PVM(3,1,3), C1,6); \
    KRD(GL,4); GAPB(PVM(2,2,4), C1,8); \
    KRD(GL,5); GAPB(PVM(3,2,5), C1,10); \
    KRD(GL,6); GAPB(PVM(2,3,6), C1,12); \
    KRD(GL,7); GAPB(PVM(3,3,7), C1,14); \
    }while(0)
  int t=1;
  for(;t+5<NT;t+=2){
    STEP(pB0,pB1,pA0,pA1,t,true,true,true);     WAIT_BAR(4); RESC(); ROT();
    STEP(pA0,pA1,pB0,pB1,t+1,true,true,true);   WAIT_BAR(4); RESC(); ROT();
  }
  #define ENDW(tt) do{ if((tt)+3<NT){WAIT_BAR(4);} else if((tt)+2<NT){WAIT_BAR(2);} else {WAIT_BAR(0);} }while(0)
  for(;t+1<NT;t+=2){
    STEP(pB0,pB1,pA0,pA1,t,(t+3<NT),(t+1<NT),(t+1<NT));       ENDW(t);   RESC(); ROT();
    STEP(pA0,pA1,pB0,pB1,t+1,(t+4<NT),(t+2<NT),(t+2<NT));     ENDW(t+1); RESC(); ROT();
  }
  STEP(pB0,pB1,pA0,pA1,NT-1,false,false,false); RESC();
  { float sacc=pB0[0]+pB0[1]; _Pragma("unroll") for(int r=2;r<16;++r)sacc+=pB0[r]; _Pragma("unroll") for(int r=0;r<16;++r)sacc+=pB1[r]; l_reg+=sacc;
    pw0=(u32x4){PKW(pB0,0),PKW(pB0,2),PKW(pB0,4),PKW(pB0,6)};pw1=(u32x4){PKW(pB0,8),PKW(pB0,10),PKW(pB0,12),PKW(pB0,14)};pw2=(u32x4){PKW(pB1,0),PKW(pB1,2),PKW(pB1,4),PKW(pB1,6)};pw3=(u32x4){PKW(pB1,8),PKW(pB1,10),PKW(pB1,12),PKW(pB1,14)};
    SBAR(); pv_all(o,vb0+sl_cur,PAF(0),PAF(1),PAF(2),PAF(3)); }
  {auto rr=__builtin_amdgcn_permlane32_swap(__float_as_uint(l_reg),__float_as_uint(l_reg),false,false);l_reg=__uint_as_float(rr[0])+__uint_as_float(rr[1]);}
  if(hi==0)wsf[32+r32]=l_reg;asm volatile("s_waitcnt lgkmcnt(0)":::"memory");
  float rli[16];
  #pragma unroll
  for(int r=0;r<16;++r)rli[r]=__builtin_amdgcn_rcpf(wsf[32+crow(r,hi)]);
  asm volatile("s_waitcnt lgkmcnt(0)\n\ts_barrier":::"memory");
  float*X=(float*)shm+wq*4096;
  if(c==1){
    #pragma unroll
    for(int r=0;r<16;++r)
      #pragma unroll
      for(int d0=0;d0<4;++d0)X[crow(r,hi)*128+d0*32+r32]=o[d0][r]*rli[r];
  }
  asm volatile("s_waitcnt lgkmcnt(0)\n\ts_barrier":::"memory");
  if(c==0){
    float g4[4];
    #pragma unroll
    for(int d0=0;d0<4;++d0)g4[d0]=subg[d0*32+r32]*0.8f;
    #pragma unroll
    for(int r=0;r<16;++r){
      float v[4],ss=0.f;
      #pragma unroll
      for(int d0=0;d0<4;++d0){v[d0]=o[d0][r]*rli[r]-lam*X[crow(r,hi)*128+d0*32+r32];ss+=v[d0]*v[d0];}
      ss+=__shfl_xor(ss,1);ss+=__shfl_xor(ss,2);ss+=__shfl_xor(ss,4);ss+=__shfl_xor(ss,8);ss+=__shfl_xor(ss,16);
      const float rstd=rsqrtf(ss*(1.f/128.f)+EPS);
      bf16_t*Or=DUMMY?Odummy+(rowbase+q0+wq*32+crow(r,hi))*(size_t)1024+h*128+r32:Qrow+(size_t)crow(r,hi)*LDQ+r32;
      #pragma unroll
      for(int d0=0;d0<4;++d0)Or[d0*32]=f2bf(v[d0]*rstd*g4[d0]);
    }
  }
  asm volatile("s_waitcnt lgkmcnt(0)\n\ts_barrier":::"memory");
  #undef DMA_K
  #undef DMA_K0
  #undef DMA_K1
  #undef DMA_V0
  #undef DMA_V1
  #undef DMA_V
  #undef START
  #undef RESC
  #undef ROT
  #undef PKW
  #undef PAF
  #undef VFR
  #undef PIN
  #undef MX3
  #undef GAPA
  #undef GAPB
  #undef EX
  #undef VRDS
  #undef KRD
  #undef QKM
  #undef PVM
  #undef STEP
  #undef ENDW
}
#undef SBAR
#undef WAIT_BAR
#undef LDS8
}
namespace rg {
typedef float f32x4v __attribute__((ext_vector_type(4)));
typedef short bf16x8v __attribute__((ext_vector_type(8)));
constexpr int T = 128, XS = 72, FS = 68;
constexpr int L_XRAW = 0, L_XCF = 16896, L_XCB = L_XCF + T * FS * 4, L_WA = L_XCB + T * XS * 2, L_WI = L_WA + 64 * XS * 2, L_SUM = L_WI + 64 * XS * 2, L_CAR = L_SUM + 8 * 64 * 2 * 4, L_END = L_CAR + 2 * 64 * 4;
static_assert(L_END <= 131072, "rg lds");
template <int DIR> __device__ __forceinline__ void sweep(int b, int n, const bf16_t* __restrict__ XR, bf16_t* AO, bf16_t* HF, const float* __restrict__ cw, const float* __restrict__ cb,
        const float* __restrict__ w_a, const float* __restrict__ b_a, const float* __restrict__ w_i, const float* __restrict__ b_i, const float* __restrict__ lam, LAS unsigned char* lds, bf16_t* Odummy) {
    const int tid = threadIdx.x, wid = __builtin_amdgcn_readfirstlane(tid >> 6), lane = tid & 63, fr = lane & 15, fq = lane >> 4;
    LAS bf16_t* XRAW = (LAS bf16_t*)(lds + L_XRAW); LAS float* XCF = (LAS float*)(lds + L_XCF); LAS bf16_t* XCB = (LAS bf16_t*)(lds + L_XCB);
    LAS bf16_t* WA = (LAS bf16_t*)(lds + L_WA); LAS bf16_t* WI = (LAS bf16_t*)(lds + L_WI); LAS float* SUM = (LAS float*)(lds + L_SUM); LAS float* CAR = (LAS float*)(lds + L_CAR);
    const size_t rowbase = (size_t)b * SEQ;
    __syncthreads();
    { const float* wa = w_a + ((size_t)DIR * 16 + n) * 4096; const float* wi = w_i + ((size_t)DIR * 16 + n) * 4096;
#pragma unroll
      for (int i = 0; i < 8; ++i) { const int idx = tid + 512 * i, k = idx >> 6, j = idx & 63; WA[j * XS + k] = f2bf(wa[idx]); WI[j * XS + k] = f2bf(wi[idx]); }
      if (tid < 128) CAR[tid] = 0.f; }
    float ba[4], bi[4], sp[4];
#pragma unroll
    for (int nf = 0; nf < 4; ++nf) { const int ch = n * 64 + nf * 16 + fr; ba[nf] = b_a[DIR * DM + ch]; bi[nf] = b_i[DIR * DM + ch]; sp[nf] = -8.f * log1pf(__expf(-lam[DIR * DM + ch])); }
    const int p2 = (tid & 31) * 2; const int chp = n * 64 + p2;
    const float k00 = cw[0 * DM + chp], k01 = cw[0 * DM + chp + 1], k10 = cw[1 * DM + chp], k11 = cw[1 * DM + chp + 1], k20 = cw[2 * DM + chp], k21 = cw[2 * DM + chp + 1], k30 = cw[3 * DM + chp], k31 = cw[3 * DM + chp + 1];
    const float cb0 = cb[chp], cb1 = cb[chp + 1];
    v4u pre[3];
#define RG_LOAD(t0_) do { _Pragma("unroll") for (int i = 0; i < 3; ++i) { const int pidx = tid + 512 * i; const int rr = pidx >> 3, cc = pidx & 7; const int t = (t0_) - 2 + rr; \
        pre[i] = (v4u){0u, 0u, 0u, 0u}; if (pidx < (T + 3) * 8 && t >= 0 && t < SEQ) pre[i] = *(const v4u*)(XR + (rowbase + t) * DM + n * 64 + cc * 8); } } while (0)
    RG_LOAD(DIR == 0 ? 0 : SEQ - T);
    for (int ci = 0; ci < SEQ / T; ++ci) {
        const int chunk = DIR == 0 ? ci : SEQ / T - 1 - ci; const int t0 = chunk * T; const int cur = ci & 1;
        __syncthreads();
#pragma unroll
        for (int i = 0; i < 3; ++i) { const int pidx = tid + 512 * i; if (pidx < (T + 3) * 8) *(LAS v4u*)(XRAW + pidx * 8) = pre[i]; }
        __syncthreads();
        if (ci + 1 < SEQ / T) RG_LOAD(DIR == 0 ? t0 + T : t0 - T);
#pragma unroll
        for (int i = 0; i < 8; ++i) { const int r = (tid >> 5) + 16 * i;
            const unsigned x0 = *(LAS unsigned*)(XRAW + (r + 0) * 64 + p2), x1 = *(LAS unsigned*)(XRAW + (r + 1) * 64 + p2), x2 = *(LAS unsigned*)(XRAW + (r + 2) * 64 + p2), x3 = *(LAS unsigned*)(XRAW + (r + 3) * 64 + p2);
            const float v0 = cb0 + k00 * lo_bf(x0) + k10 * lo_bf(x1) + k20 * lo_bf(x2) + k30 * lo_bf(x3);
            const float v1 = cb1 + k01 * hi_bf(x0) + k11 * hi_bf(x1) + k21 * hi_bf(x2) + k31 * hi_bf(x3);
            *(LAS f32x2*)(XCF + r * FS + p2) = (f32x2){v0, v1}; *(LAS unsigned*)(XCB + r * XS + p2) = pk2(v0, v1); }
        __syncthreads();
        bf16x8v a0 = *(LAS bf16x8v*)(XCB + (wid * 16 + fr) * XS + fq * 8), a1 = *(LAS bf16x8v*)(XCB + (wid * 16 + fr) * XS + 32 + fq * 8);
        f32x4v ga[4], gi[4];
#pragma unroll
        for (int nf = 0; nf < 4; ++nf) {
            const bf16x8v wa0 = *(LAS bf16x8v*)(WA + (nf * 16 + fr) * XS + fq * 8), wa1 = *(LAS bf16x8v*)(WA + (nf * 16 + fr) * XS + 32 + fq * 8);
            const bf16x8v wi0 = *(LAS bf16x8v*)(WI + (nf * 16 + fr) * XS + fq * 8), wi1 = *(LAS bf16x8v*)(WI + (nf * 16 + fr) * XS + 32 + fq * 8);
            ga[nf] = __builtin_amdgcn_mfma_f32_16x16x32_bf16(a0, wa0, (f32x4v){0.f, 0.f, 0.f, 0.f}, 0, 0, 0); ga[nf] = __builtin_amdgcn_mfma_f32_16x16x32_bf16(a1, wa1, ga[nf], 0, 0, 0);
            gi[nf] = __builtin_amdgcn_mfma_f32_16x16x32_bf16(a0, wi0, (f32x4v){0.f, 0.f, 0.f, 0.f}, 0, 0, 0); gi[nf] = __builtin_amdgcn_mfma_f32_16x16x32_bf16(a1, wi1, gi[nf], 0, 0, 0);
        }
        float hl[4][4], P[4][4], Ain[4], Hin[4], Aex[4], Hex[4];
#pragma unroll
        for (int nf = 0; nf < 4; ++nf) {
            float av[4], uv[4];
#pragma unroll
            for (int g = 0; g < 4; ++g) {
                const float r = sigmoidf_(ga[nf][g] + ba[nf]), ig = sigmoidf_(gi[nf][g] + bi[nf]);
                const float la = sp[nf] * r, a = fexp(la), x2 = 2.f * la;
                const float poly = -x2 * (1.f + x2 * (0.5f + x2 * (0.16666667f + x2 * (0.041666668f + x2 * (0.0083333333f + x2 * 0.0013888889f)))));
                const float om = x2 > -0.25f ? poly : 1.f - a * a;
                const float xc = XCF[(wid * 16 + fq * 4 + g) * FS + nf * 16 + fr];
                av[g] = a; uv[g] = __builtin_amdgcn_sqrtf(om) * ig * xc;
            }
            if (DIR == 0) { hl[nf][0] = uv[0]; P[nf][0] = av[0];
#pragma unroll
                for (int g = 1; g < 4; ++g) { hl[nf][g] = av[g] * hl[nf][g - 1] + uv[g]; P[nf][g] = av[g] * P[nf][g - 1]; } }
            else { hl[nf][3] = uv[3]; P[nf][3] = av[3];
#pragma unroll
                for (int g = 2; g >= 0; --g) { hl[nf][g] = av[g] * hl[nf][g + 1] + uv[g]; P[nf][g] = av[g] * P[nf][g + 1]; } }
            float A = DIR == 0 ? P[nf][3] : P[nf][0], H = DIR == 0 ? hl[nf][3] : hl[nf][0];
            { const float Ap = DIR == 0 ? __shfl_up(A, 16) : __shfl_down(A, 16), Hp = DIR == 0 ? __shfl_up(H, 16) : __shfl_down(H, 16);
              if (DIR == 0 ? fq >= 1 : fq <= 2) { H = A * Hp + H; A = A * Ap; } }
            { const float Ap = DIR == 0 ? __shfl_up(A, 32) : __shfl_down(A, 32), Hp = DIR == 0 ? __shfl_up(H, 32) : __shfl_down(H, 32);
              if (DIR == 0 ? fq >= 2 : fq <= 1) { H = A * Hp + H; A = A * Ap; } }
            Ain[nf] = A; Hin[nf] = H;
            { const float Ae = DIR == 0 ? __shfl_up(A, 16) : __shfl_down(A, 16), He = DIR == 0 ? __shfl_up(H, 16) : __shfl_down(H, 16);
              const bool first = DIR == 0 ? fq == 0 : fq == 3; Aex[nf] = first ? 1.f : Ae; Hex[nf] = first ? 0.f : He; }
            if (DIR == 0 ? fq == 3 : fq == 0) { SUM[(wid * 64 + nf * 16 + fr) * 2] = A; SUM[(wid * 64 + nf * 16 + fr) * 2 + 1] = H; }
        }
        __syncthreads();
#pragma unroll
        for (int nf = 0; nf < 4; ++nf) {
            const int chl = nf * 16 + fr;
            float cwv = CAR[cur * 64 + chl];
            if (DIR == 0) { for (int w2 = 0; w2 < wid; ++w2) cwv = SUM[(w2 * 64 + chl) * 2] * cwv + SUM[(w2 * 64 + chl) * 2 + 1]; }
            else { for (int w2 = 7; w2 > wid; --w2) cwv = SUM[(w2 * 64 + chl) * 2] * cwv + SUM[(w2 * 64 + chl) * 2 + 1]; }
            if ((DIR == 0 ? wid == 7 && fq == 3 : wid == 0 && fq == 0)) CAR[(cur ^ 1) * 64 + chl] = Ain[nf] * cwv + Hin[nf];
            const float cl = Aex[nf] * cwv + Hex[nf];
#pragma unroll
            for (int g = 0; g < 4; ++g) {
                const float hv = hl[nf][g] + P[nf][g] * cl;
                const size_t row = rowbase + t0 + wid * 16 + fq * 4 + g; const int ch = n * 64 + chl;
                if (DIR == 0) HF[row * DM + ch] = f2bf(hv);
                else { const float yr = bf2f(AO[row * 2048 + ch]); const bf16_t ov = f2bf((hv + bf2f(HF[row * DM + ch])) * gelu_tanh(yr)); if (Odummy) Odummy[row * DM + ch] = ov; else AO[row * 2048 + ch] = ov; }
            }
        }
    }
#undef RG_LOAD
}
}
#define XB_TMO      128
#define XB_XCNT(j)  (256  + 64 * (j))
#define XB_XSUB(j)  (1280 + 64 * (j))
#define XB_XGEN(j)  (2304 + 64 * (j))
#define XB_TOP      3328
#define XB_TOPGEN   3392
#define XCD_BAR_WORDS 3456
#define XB_SPIN_CAP (1u << 18)

__device__ __forceinline__ unsigned xb_ld(unsigned* p)              { return __hip_atomic_load(p, __ATOMIC_RELAXED, __HIP_MEMORY_SCOPE_AGENT); }
__device__ __forceinline__ unsigned xb_add(unsigned* p, unsigned v) { return __hip_atomic_fetch_add(p, v, __ATOMIC_RELAXED, __HIP_MEMORY_SCOPE_AGENT); }
__device__ __forceinline__ unsigned xb_xcc_id() { return (unsigned)__builtin_amdgcn_s_getreg((3 << 11) | 20) & 0xFu; }
#define XB_SPIN(cond, bar) do { unsigned _sp = 0; while (cond) { __builtin_amdgcn_s_sleep(1); \
    if ((++_sp & 255u) == 0u) { if (xb_ld(&(bar)[XB_TMO])) break; if (_sp > XB_SPIN_CAP) { atomicAdd(&(bar)[XB_TMO], 1u); break; } } } } while (0)

struct XcdBarrier {
    unsigned* bar; unsigned x;
    volatile LAS unsigned* st;
};

__device__ __forceinline__ XcdBarrier xcd_barrier_post(unsigned* bar, volatile LAS unsigned* st) {
    XcdBarrier b; b.bar = bar; b.x = xb_xcc_id(); b.st = st;
    if (threadIdx.x == 0) (void)xb_add(&bar[XB_XCNT(b.x)], 1u);
    return b;
}
__device__ __forceinline__ void xcd_barrier_complete(unsigned* bar, unsigned x, unsigned& nloc, unsigned& nx) {
    const unsigned G = gridDim.x * gridDim.y * gridDim.z;
    unsigned sum, cnt, mine, sp = 0u;
    for (;;) {
        sum = 0u; cnt = 0u; mine = 0u;
#pragma unroll
        for (unsigned j = 0; j < 16; ++j) { const unsigned c = xb_ld(&bar[XB_XCNT(j)]); sum += c; cnt += (c > 0u) ? 1u : 0u; mine = (j == x) ? c : mine; }
        if (sum == G) break;
        __builtin_amdgcn_s_sleep(1);
        if ((++sp & 255u) == 0u) { if (xb_ld(&bar[XB_TMO])) break; if (sp > XB_SPIN_CAP) { atomicAdd(&bar[XB_TMO], 1u); break; } }
    }
    nloc = mine > 0u ? mine : 1u; nx = cnt > 0u ? cnt : 1u;
}

__device__ __forceinline__ void xcd_barrier(const XcdBarrier& b) {
    asm volatile("s_waitcnt vmcnt(0)" ::: "memory");
    __syncthreads();
    if (threadIdx.x == 0) {
        unsigned* bar = b.bar;
        __builtin_amdgcn_s_waitcnt(0);
        unsigned nloc = b.st[0], nx = b.st[1];
        if (nloc == 0u) { xcd_barrier_complete(bar, b.x, nloc, nx); b.st[0] = nloc; b.st[1] = nx; }
        const unsigned old = xb_add(&bar[XB_XSUB(b.x)], 1u);
        const unsigned gen = old / nloc;
        if (old + 1u == (gen + 1u) * nloc) {
            __builtin_amdgcn_fence(__ATOMIC_RELEASE, "agent");
            asm volatile("s_waitcnt vmcnt(0)" ::: "memory");
            const unsigned og = xb_add(&bar[XB_TOP], 1u);
            const unsigned tg = og / nx;
            if (og + 1u == (tg + 1u) * nx) xb_add(&bar[XB_TOPGEN], 1u);
            else XB_SPIN(xb_ld(&bar[XB_TOPGEN]) == tg, bar);
            __builtin_amdgcn_fence(__ATOMIC_ACQUIRE, "agent");
            xb_add(&bar[XB_XGEN(b.x)], 1u);
            asm volatile("s_waitcnt vmcnt(0)" ::: "memory");
        } else {
            XB_SPIN(xb_ld(&bar[XB_XGEN(b.x)]) == gen, bar);
            __builtin_amdgcn_fence(__ATOMIC_ACQUIRE, "agent");
            asm volatile("s_waitcnt vmcnt(0)" ::: "memory");
        }
    }
    __syncthreads();
}
struct Frame {
    LAS unsigned char* lds;
    int tid, lane, wave, vcu, G;
};
__device__ __forceinline__ void p0_transpose_item(const float* W, int K, int N, bf16_t* WT, int row_off, LAS float* scr, int kb, int nb, int lane, int ldt, int koff) {
    const int k0 = 64 * kb, n0 = 32 * nb;
#pragma unroll 8
    for (int i = 0; i < 32; ++i) { const int kk = 2 * i + (lane >> 5); scr[kk * 33 + (lane & 31)] = W[(size_t)(k0 + kk) * N + n0 + (lane & 31)]; }
    LDS_WAIT(); asm volatile("" ::: "memory");
    const int c = lane & 7;
#pragma unroll
    for (int j = 0; j < 4; ++j) { const int n = (lane >> 3) + 8 * j; const LAS float* s = scr + (8 * c) * 33 + n;
        v4u o; o.x = pk2(s[0 * 33], s[1 * 33]); o.y = pk2(s[2 * 33], s[3 * 33]); o.z = pk2(s[4 * 33], s[5 * 33]); o.w = pk2(s[6 * 33], s[7 * 33]);
        *(GAS v4u*)(WT + (size_t)(row_off + n0 + n) * ldt + koff + k0 + 8 * c) = o; }
    LDS_WAIT(); asm volatile("" ::: "memory");
}
__device__ __forceinline__ void normmod_row(const float* xrow, const float* g, const float* sc, const float* sh, bf16_t* orow, int lane) {
    f32x4 v[4]; float s = 0.f;
#pragma unroll
    for (int j = 0; j < 4; ++j) { v[j] = *((const f32x4*)xrow + lane + 64 * j); s += (v[j].x * v[j].x + v[j].y * v[j].y) + (v[j].z * v[j].z + v[j].w * v[j].w); }
    const float rstd = rsqrtf(wave_sum(s) * (1.f / DM) + EPS);
#pragma unroll
    for (int j = 0; j < 4; ++j) { const f32x4 gg = *((const f32x4*)g + lane + 64 * j), cc = *((const f32x4*)sc + lane + 64 * j), hh = *((const f32x4*)sh + lane + 64 * j);
        const f32x4 y = v[j] * rstd * gg * (cc + 1.f) + hh; v2u w; w.x = pk2(y.x, y.y); w.y = pk2(y.z, y.w); *((v2u*)orow + lane + 64 * j) = w; }
}

#ifndef PROBE_REP
#define PROBE_REP 0
#endif
#ifndef ATT_V2
#define ATT_V2 1
#endif
#ifndef MIX_SEL
#define MIX_SEL 3
#endif
#ifndef PH_MASK
#define PH_MASK 0x7ff
#endif
struct Args { const void* in[28]; float* out; unsigned char* ws; int ph_lo, ph_hi, li, pad; };
typedef const __attribute__((address_space(4))) Args KArgs;
__device__ __forceinline__ KArgs* ka_ptr() { auto p = __builtin_amdgcn_kernarg_segment_ptr(); asm volatile("" : "+s"(p)); return (KArgs*)p; }
enum { P_PRO = 0, P_NORM1, P_PROJ, P_MIX, P_MERGE, P_OUT, P_NORM2, P_UP, P_FIX, P_DOWN, P_FINAL, N_PHASES };

__global__ void __launch_bounds__(NWAVES * 64, 2) mk_fwd(Args args) {
    extern __shared__ __attribute__((aligned(16))) unsigned char lds[];
    for (int u = threadIdx.x; u < (LDS_BYTES - LDSCTL_OFF) / 4; u += NWAVES * 64) ((LAS unsigned*)((LAS unsigned char*)lds + LDSCTL_OFF))[u] = 0u;
    __syncthreads();
    { KArgs* KA = ka_ptr(); if (KA->ph_hi - KA->ph_lo > 1) (void)xcd_barrier_post((unsigned*)(KA->ws + WS_CTL) + CW_BAR + KA->li * XCD_BAR_WORDS, (volatile LAS unsigned*)((LAS unsigned char*)lds + MISC_OFF) + 8); }
#define INP(k) ((const float*)KA->in[k])
#define WSP(T, off) ((T*)(KA->ws + (off)))
#define IN(k) (((PH_MASK >> (k)) & 1) && ka_ptr()->ph_lo <= (k) && (k) < ka_ptr()->ph_hi)
#define SEAM(k) do { KArgs* KB_ = ka_ptr(); if (KB_->ph_lo <= (k) && (k) + 1 < KB_->ph_hi) { XcdBarrier bar; bar.bar = (unsigned*)(KB_->ws + WS_CTL) + CW_BAR + KB_->li * XCD_BAR_WORDS; bar.x = xb_xcc_id(); \
        bar.st = (volatile LAS unsigned*)((LAS unsigned char*)lds + MISC_OFF) + 8; xcd_barrier(bar); } } while (0)
#define FRAME() Frame F; F.lds = (LAS unsigned char*)lds; F.tid = threadIdx.x; F.lane = F.tid & 63; F.wave = __builtin_amdgcn_readfirstlane(F.tid >> 6); F.G = gridDim.x; \
        { const int bx = blockIdx.x; F.vcu = (F.G % 8 == 0) ? (bx % 8) * (F.G / 8) + bx / 8 : bx; } const int gw = F.vcu * NWAVES + F.wave, NGW = F.G * NWAVES; (void)gw; (void)NGW;

    if (IN(P_PRO)) for (int rep_ = (PROBE_REP >> P_PRO) & 1; rep_ >= 0; --rep_) {
        KArgs* KA = ka_ptr(); FRAME(); const float* cvec = INP(1); const int* pos = (const int*)KA->in[2]; const float* w_ada = INP(3); const float* b_ada = INP(4);
        float* MOD = WSP(float, WS_MOD); float* COS = WSP(float, WS_COS); float* SIN = WSP(float, WS_SIN);
        {
            LAS float* SC = (LAS float*)F.lds;
            for (int i = F.tid; i < BATCH * DM; i += NWAVES * 64) { const float cv = cvec[i]; SC[i] = cv * sigmoidf_(cv); }
            __syncthreads();
            const int ncol = NMODC / 256;
            const int col0 = F.vcu * ncol;
            LAS float* RED = (LAS float*)F.lds + BATCH * DM;
            if (F.tid < 192) {
                const int ks = F.tid / 6, cg = F.tid % 6; f32x4 accm[16];
#pragma unroll
                for (int b = 0; b < 16; ++b) accm[b] = (f32x4){0.f, 0.f, 0.f, 0.f};
#pragma unroll 8
                for (int kk = 0; kk < 32; ++kk) { const int k = ks * 32 + kk; const f32x4 w4 = *(const f32x4*)(w_ada + (size_t)k * NMODC + col0 + 4 * cg);
#pragma unroll
                    for (int b = 0; b < 16; ++b) accm[b] += w4 * SC[b * DM + k]; }
#pragma unroll
                for (int b = 0; b < 16; ++b) *(LAS f32x4*)(RED + (ks * 16 + b) * 24 + 4 * cg) = accm[b];
            }
            __syncthreads();
            if (F.tid < 16 * 24) { const int bb = F.tid / 24, q = F.tid % 24; float s = b_ada[col0 + q];
                for (int k2 = 0; k2 < 32; ++k2) s += RED[(k2 * 16 + bb) * 24 + q];
                MOD[(size_t)bb * NMODC + col0 + q] = s; }
            __syncthreads();
        }
        for (int idx = F.vcu * 512 + F.tid; idx < M * 8; idx += F.G * 512) {
            const int row = idx >> 3, i = idx & 7;
            const float invf = powf(500000.0f, -(float)i / 8.0f);
            const float ang = (float)pos[row] * invf;
            const double rev = (double)ang * 0.15915494309189535; const double fr = rev - rint(rev);
            COS[idx] = __builtin_amdgcn_cosf((float)fr); SIN[idx] = __builtin_amdgcn_sinf((float)fr);
        }
        if (gw == 0) {
            const float* lq1 = INP(15); const float* lk1 = INP(16); const float* lq2 = INP(17); const float* lk2 = INP(18);
            const float s1 = wave_sum(lq1[F.lane] * lk1[F.lane]), s2 = wave_sum(lq2[F.lane] * lk2[F.lane]);
            if (F.lane == 0) MOD[BATCH * NMODC] = fexp(s1) - fexp(s2) + 0.2f;
        }
    }
    SEAM(P_PRO);
    if (IN(P_NORM1)) for (int rep_ = (PROBE_REP >> P_NORM1) & 1; rep_ >= 0; --rep_) { KArgs* KA = ka_ptr(); FRAME(); const float* x = INP(0); const float* norm1_g = INP(5); const float* MOD = WSP(float, WS_MOD); bf16_t* H = WSP(bf16_t, WS_H);
        {
            const float* w_in = INP(6); const float* w_rnn_o = INP(14); const float* w_attn_o = INP(20); const float* w_out = INP(21); const float* w_up = INP(23); const float* w_down = INP(26);
            bf16_t* WIN_T = WSP(bf16_t, WS_WIN); bf16_t* WA_T = WSP(bf16_t, WS_WA); bf16_t* WB_T = WSP(bf16_t, WS_WB); bf16_t* WOUT_T = WSP(bf16_t, WS_WOUT); bf16_t* WUP_T = WSP(bf16_t, WS_WUP); bf16_t* WDOWN_T = WSP(bf16_t, WS_WDOWN);
            LAS float* scr = (LAS float*)(F.lds + F.wave * 16384);
            constexpr int I_IN = 16 * (INCOLS / 32), I_SQ = 16 * 32, I_UP = 16 * (2 * DFF / 32), I_DN = (DFF / 64) * 32;
            constexpr int NITEMS = I_IN + 3 * I_SQ + I_UP + I_DN;
            for (int it = gw; it < NITEMS; it += NGW) {
                int r = it;
                if (r < I_IN) { const int kb = r / (INCOLS / 32), nb = r % (INCOLS / 32), n0 = nb * 32; int mapped = n0;
                    if (n0 >= 5120) { const int g = n0 - 5120, jn = g < 1024 ? g : g - 1024; mapped = 5120 + (jn / 128) * 256 + (g < 1024 ? 0 : 128) + (jn % 128); }
                    p0_transpose_item(w_in, DM, INCOLS, WIN_T, mapped - n0, scr, kb, nb, F.lane, DM, 0); continue; } r -= I_IN;
                if (r < I_SQ) { p0_transpose_item(w_rnn_o, DM, DM, WA_T, 0, scr, r / 32, r % 32, F.lane, 2048, 0); continue; } r -= I_SQ;
                if (r < I_SQ) { p0_transpose_item(w_attn_o, DM, DM, WA_T, 0, scr, r / 32, r % 32, F.lane, 2048, 1024); continue; } r -= I_SQ;
                if (r < I_SQ) { p0_transpose_item(w_out, DM, DM, WOUT_T, 0, scr, r / 32, r % 32, F.lane, DM, 0); continue; } r -= I_SQ;
                if (r < I_UP) { const int kb = r / (2 * DFF / 32), nb = r % (2 * DFF / 32), n0 = nb * 32; const int jn = n0 < DFF ? n0 : n0 - DFF; const int mapped = (jn / 128) * 256 + (n0 < DFF ? 0 : 128) + (jn % 128);
                    p0_transpose_item(w_up, DM, 2 * DFF, WUP_T, mapped - n0, scr, kb, nb, F.lane, DM, 0); continue; } r -= I_UP;
                p0_transpose_item(w_down, DFF, DM, WDOWN_T, 0, scr, r / 32, r % 32, F.lane, DFF, 0);
            }
        }
        for (int m = gw; m < M; m += NGW) { const float* mb = MOD + (size_t)(m / SEQ) * NMODC; normmod_row(x + (size_t)m * DM, norm1_g, mb + 1024, mb, H + (size_t)m * DM, F.lane); } }
    SEAM(P_NORM1);
    if (IN(P_PROJ)) for (int rep_ = (PROBE_REP >> P_PROJ) & 1; rep_ >= 0; --rep_) {
        KArgs* KA = ka_ptr(); FRAME(); bf16_t* H = WSP(bf16_t, WS_H); bf16_t* WIN_T = WSP(bf16_t, WS_WIN); bf16_t* XR = WSP(bf16_t, WS_XR); bf16_t* AO = WSP(bf16_t, WS_AO); bf16_t* KB = WSP(bf16_t, WS_K); bf16_t* VB = WSP(bf16_t, WS_V);
        bf16_t* GT = (bf16_t*)KA->out; const float* COS = WSP(float, WS_COS); const float* SIN = WSP(float, WS_SIN);
        pg8::Gemm g{H, WIN_T, M, INCOLS, DM, DM}; pg8::StaticOrder S; S.init(M, INCOLS, F.G, (int)blockIdx.x);
        EpiProj E{XR, AO, KB, VB, GT, COS, SIN, nullptr};
#if defined(STAGGER_US)
        { const unsigned sg = (unsigned)F.vcu & 3u; if (sg) { const unsigned long long t0 = __builtin_amdgcn_s_memrealtime(); while (__builtin_amdgcn_s_memrealtime() - t0 < (unsigned long long)(sg * STAGGER_US * 100)) __builtin_amdgcn_s_sleep(32); } }
#endif
#if defined(PROBE_LOCALEPI)
        if (rep_) { EpiProj EL{XR, AO, KB, VB, GT, COS, SIN, WSP(bf16_t, WS_HF)}; pg8::gemm_phase<EpiProj, pg8::StaticOrder, PG8_ALIGN, PG8_SP2>(F.lds + RING_OFF, g, S, EL); } else
#endif
#if defined(PROBE_NULLEPI)
        if (rep_) { EpiNull EN{(float*)WSP(float, WS_HF)}; pg8::gemm_phase<EpiNull, pg8::StaticOrder, PG8_ALIGN, PG8_SP2>(F.lds + RING_OFF, g, S, EN); } else
#endif
        pg8::gemm_phase<EpiProj, pg8::StaticOrder, PG8_ALIGN, PG8_SP2>(F.lds + RING_OFF, g, S, E);
    }
    SEAM(P_PROJ);
    if (IN(P_MIX)) {
        KArgs* KA = ka_ptr(); FRAME(); bf16_t* XR = WSP(bf16_t, WS_XR); bf16_t* AO = WSP(bf16_t, WS_AO); bf16_t* KB = WSP(bf16_t, WS_K); bf16_t* VB = WSP(bf16_t, WS_V); bf16_t* HF = WSP(bf16_t, WS_HF); const float* MOD = WSP(float, WS_MOD);
        const float* conv_rnn_w = INP(7); const float* conv_rnn_b = INP(8); const float* w_rg_a = INP(9); const float* b_rg_a = INP(10); const float* w_rg_i = INP(11); const float* b_rg_i = INP(12); const float* rg_lambda = INP(13); const float* subln_g = INP(19);
        if ((MIX_SEL & 1) && (KA->pad & 1) && F.vcu < 256) { const int b = F.vcu >> 4, n = F.vcu & 15;
            for (int rep_ = (PROBE_REP >> P_MIX) & 1; rep_ >= 0; --rep_) {
                rg::sweep<0>(b, n, XR, AO, HF, conv_rnn_w, conv_rnn_b, w_rg_a, b_rg_a, w_rg_i, b_rg_i, rg_lambda, F.lds, nullptr);
                rg::sweep<1>(b, n, XR, AO, HF, conv_rnn_w, conv_rnn_b, w_rg_a, b_rg_a, w_rg_i, b_rg_i, rg_lambda, F.lds, rep_ ? WSP(bf16_t, WS_H) : (bf16_t*)nullptr);
                __syncthreads(); } }
        const float lam = MOD[BATCH * NMODC];
        if (((PROBE_REP >> 11) & 1) && (KA->pad & 2)) for (int uidx = F.vcu * 8; uidx < BATCH * 8 * 16; uidx += F.G * 8) {
#pragma unroll 1
            for (int q = 0; q < 8; ++q) { const int un = uidx + q; const int bh = un >> 4, qb = un & 15;
#if ATT_V2
                att2::attn_unit<8, true>(bh >> 3, bh & 7, qb, AO, KB, VB, lam, subln_g, (char*)lds, WSP(bf16_t, WS_H)); }
#else
                att::attn_unit<true>(bh >> 3, bh & 7, qb, AO, KB, VB, lam, subln_g, (char*)lds, WSP(bf16_t, WS_H)); }
#endif
        }
        if ((MIX_SEL & 2) && (KA->pad & 2)) for (int uidx = F.vcu * 8; uidx < BATCH * 8 * 16; uidx += F.G * 8) {
#pragma unroll 1
            for (int q = 0; q < 8; ++q) { const int un = uidx + q; const int bh = un >> 4, qb = un & 15;
#if ATT_V2
                att2::attn_unit<8, false>(bh >> 3, bh & 7, qb, AO, KB, VB, lam, subln_g, (char*)lds, nullptr); }
#else
                att::attn_unit<false>(bh >> 3, bh & 7, qb, AO, KB, VB, lam, subln_g, (char*)lds, nullptr); }
#endif
        }
    }
    SEAM(P_MIX);
    if (IN(P_MERGE)) for (int rep_ = (PROBE_REP >> P_MERGE) & 1; rep_ >= 0; --rep_) {
        KArgs* KA = ka_ptr(); FRAME(); bf16_t* AO = WSP(bf16_t, WS_AO); bf16_t* WA_T = WSP(bf16_t, WS_WA); bf16_t* WB_T = WSP(bf16_t, WS_WB); bf16_t* GT = (bf16_t*)KA->out; bf16_t* MG = WSP(bf16_t, WS_XR);
        pg8::StaticOrder S; S.init(M, DM, F.G, (int)blockIdx.x);
        pg8::Gemm g{AO, WA_T, M, DM, 2048, 2048}; EpiMerge E{GT, MG}; pg8::gemm_phase<EpiMerge, pg8::StaticOrder, PG8_ALIGN, PG8_SP2>(F.lds + RING_OFF, g, S, E);
    }
    SEAM(P_MERGE);
    if (IN(P_OUT)) for (int rep_ = (PROBE_REP >> P_OUT) & 1; rep_ >= 0; --rep_) {
        KArgs* KA = ka_ptr(); FRAME(); bf16_t* MG = WSP(bf16_t, WS_XR); bf16_t* WOUT_T = WSP(bf16_t, WS_WOUT); const float* x = INP(0); float* out = KA->out; const float* MOD = WSP(float, WS_MOD);
        pg8::Gemm g{MG, WOUT_T, M, DM, DM, DM}; pg8::StaticOrder S; S.init(M, DM, F.G, (int)blockIdx.x);
        EpiResid1 E{x, WSP(bf16_t, WS_AO), MOD + 2048}; pg8::gemm_phase<EpiResid1, pg8::StaticOrder, PG8_ALIGN, PG8_SP2>(F.lds + RING_OFF, g, S, E);
    }
    SEAM(P_OUT);
    if (IN(P_NORM2)) for (int rep_ = (PROBE_REP >> P_NORM2) & 1; rep_ >= 0; --rep_) { KArgs* KA = ka_ptr(); FRAME(); const bf16_t* X1 = WSP(bf16_t, WS_AO); const float* norm2_g = INP(22); const float* MOD = WSP(float, WS_MOD); bf16_t* H = WSP(bf16_t, WS_H);
        for (int m = gw; m < M; m += NGW) { const float* mb = MOD + (size_t)(m / SEQ) * NMODC;
            f32x4 v[4]; float s = 0.f;
#pragma unroll
            for (int j = 0; j < 2; ++j) { const v4u x = *((const v4u*)(X1 + (size_t)m * DM) + F.lane + 64 * j); v[2 * j] = (f32x4){lo_bf(x.x), hi_bf(x.x), lo_bf(x.y), hi_bf(x.y)}; v[2 * j + 1] = (f32x4){lo_bf(x.z), hi_bf(x.z), lo_bf(x.w), hi_bf(x.w)}; }
#pragma unroll
            for (int j = 0; j < 4; ++j) s += (v[j].x * v[j].x + v[j].y * v[j].y) + (v[j].z * v[j].z + v[j].w * v[j].w);
            const float rstd = rsqrtf(wave_sum(s) * (1.f / DM) + EPS);
#pragma unroll
            for (int j = 0; j < 2; ++j) { const int cb = 8 * F.lane + 512 * j; v4u w;
                { const f32x4 gg = *(const f32x4*)(norm2_g + cb), cc = *(const f32x4*)(mb + 4096 + cb), hh = *(const f32x4*)(mb + 3072 + cb); const f32x4 y = v[2 * j] * rstd * gg * (cc + 1.f) + hh; w.x = pk2(y.x, y.y); w.y = pk2(y.z, y.w); }
                { const f32x4 gg = *(const f32x4*)(norm2_g + cb + 4), cc = *(const f32x4*)(mb + 4096 + cb + 4), hh = *(const f32x4*)(mb + 3072 + cb + 4); const f32x4 y = v[2 * j + 1] * rstd * gg * (cc + 1.f) + hh; w.z = pk2(y.x, y.y); w.w = pk2(y.z, y.w); }
                *((v4u*)(H + (size_t)m * DM) + F.lane + 64 * j) = w; } } }
    SEAM(P_NORM2);
    if (IN(P_UP)) for (int rep_ = (PROBE_REP >> P_UP) & 1; rep_ >= 0; --rep_) {
        KArgs* KA = ka_ptr(); FRAME(); bf16_t* H = WSP(bf16_t, WS_H); bf16_t* WUP_T = WSP(bf16_t, WS_WUP); bf16_t* ACT = WSP(bf16_t, WS_ACT); float* EDGE = WSP(float, WS_EDGE); const float* conv_ffn_w = INP(24); const float* conv_ffn_b = INP(25);
        pg8::Gemm g{H, WUP_T, M, 2 * DFF, DM, DM}; pg8::StaticOrder S; S.init(M, 2 * DFF, F.G, (int)blockIdx.x);
        EpiUpConv E{ACT, EDGE, conv_ffn_w, conv_ffn_b}; pg8::gemm_phase<EpiUpConv, pg8::StaticOrder, PG8_ALIGN, PG8_SP2>(F.lds + RING_OFF, g, S, E);
    }
    SEAM(P_UP);
    if (IN(P_FIX)) for (int rep_ = (PROBE_REP >> P_FIX) & 1; rep_ >= 0; --rep_) {
        KArgs* KA = ka_ptr(); FRAME(); bf16_t* ACT = WSP(bf16_t, WS_ACT); const float* EDGE = WSP(float, WS_EDGE); const float* conv_ffn_w = INP(24); const float* conv_ffn_b = INP(25);
        for (int idx = F.vcu * 512 + F.tid; idx < 512 * 2 * (DFF / 4); idx += F.G * 512) {
            const int j = (idx % (DFF / 4)) * 4, ge = idx / (DFF / 4), e = ge & 1, gband = ge >> 1;
            const int pc = (j / 128) * 256 + (j % 128);
            const float* Eb = EDGE + (size_t)gband * 4 * 5632;
            const f32x4 z4 = {0.f, 0.f, 0.f, 0.f}; f32x4 pv, pg, cv, cg, nv, ng;
            if (e == 0) { const bool z = (gband % 32) == 0; pv = z ? z4 : *(const f32x4*)(Eb - 5632 + pc); pg = z ? z4 : *(const f32x4*)(Eb - 5632 + pc + 128); cv = *(const f32x4*)(Eb + pc); cg = *(const f32x4*)(Eb + pc + 128); nv = *(const f32x4*)(Eb + 5632 + pc); ng = *(const f32x4*)(Eb + 5632 + pc + 128); }
            else { const bool z = ((gband + 1) % 32) == 0; pv = *(const f32x4*)(Eb + 2 * 5632 + pc); pg = *(const f32x4*)(Eb + 2 * 5632 + pc + 128); cv = *(const f32x4*)(Eb + 3 * 5632 + pc); cg = *(const f32x4*)(Eb + 3 * 5632 + pc + 128); nv = z ? z4 : *(const f32x4*)(Eb + 4 * 5632 + pc); ng = z ? z4 : *(const f32x4*)(Eb + 4 * 5632 + pc + 128); }
            const f32x4 vcv = *(const f32x4*)(conv_ffn_b + j) + *(const f32x4*)(conv_ffn_w + j) * pv + *(const f32x4*)(conv_ffn_w + 2 * DFF + j) * cv + *(const f32x4*)(conv_ffn_w + 4 * DFF + j) * nv;
            const f32x4 gcv = *(const f32x4*)(conv_ffn_b + DFF + j) + *(const f32x4*)(conv_ffn_w + DFF + j) * pg + *(const f32x4*)(conv_ffn_w + 3 * DFF + j) * cg + *(const f32x4*)(conv_ffn_w + 5 * DFF + j) * ng;
            v2u w; w.x = pk2(gcv.x * sigmoidf_(gcv.x) * vcv.x, gcv.y * sigmoidf_(gcv.y) * vcv.y); w.y = pk2(gcv.z * sigmoidf_(gcv.z) * vcv.z, gcv.w * sigmoidf_(gcv.w) * vcv.w);
            *(v2u*)(ACT + (size_t)(gband * 64 + (e ? 63 : 0)) * DFF + j) = w;
        }
    }
    SEAM(P_FIX);
    if (IN(P_DOWN)) {
        KArgs* KA = ka_ptr(); FRAME(); bf16_t* ACT = WSP(bf16_t, WS_ACT); bf16_t* WDOWN_T = WSP(bf16_t, WS_WDOWN); float* out = KA->out; const float* MOD = WSP(float, WS_MOD);
        pg8::Gemm g{ACT, WDOWN_T, M, DM, DFF, DFF}; pg8::StaticOrder S; S.init(M, DM, F.G, (int)blockIdx.x);
        for (int rep_ = (PROBE_REP >> P_DOWN) & 1; rep_ >= 0; --rep_) { EpiResid2 E{WSP(bf16_t, WS_AO), rep_ ? WSP(float, 112 * MiB) : out, MOD + 5120}; pg8::gemm_phase<EpiResid2, pg8::StaticOrder, PG8_ALIGN, PG8_SP2>(F.lds + RING_OFF, g, S, E); }
    }
    SEAM(P_DOWN);
    if (IN(P_FINAL)) {
        KArgs* KA = ka_ptr(); FRAME(); float* out = KA->out; const float* final_g = INP(27);
        for (int rep_ = (PROBE_REP >> P_FINAL) & 1; rep_ >= 0; --rep_) for (int m = gw; m < M; m += NGW) { float* xr = out + (size_t)m * DM; float* xo = rep_ ? WSP(float, 112 * MiB) + (size_t)m * DM : xr; f32x4 v[4]; float s = 0.f;
#pragma unroll
            for (int j = 0; j < 4; ++j) { v[j] = *((const f32x4*)xr + F.lane + 64 * j); s += (v[j].x * v[j].x + v[j].y * v[j].y) + (v[j].z * v[j].z + v[j].w * v[j].w); }
            const float rstd = rsqrtf(wave_sum(s) * (1.f / DM) + EPS);
#pragma unroll
            for (int j = 0; j < 4; ++j) { const f32x4 gg = *((const f32x4*)final_g + F.lane + 64 * j); *((f32x4*)xo + F.lane + 64 * j) = v[j] * rstd * gg; } }
    }
#undef IN
#undef SEAM
#undef INP
#undef WSP
#undef FRAME
}
__device__ __forceinline__ float nv_sigmoid(float x) { return 1.f / (1.f + __expf(-x)); }
__device__ __forceinline__ float nv_gelu(float x) { const float u = 1.5957691216057308f * (x + 0.044715f * x * x * x); return x / (1.f + __expf(-u)); }
__global__ void __launch_bounds__(256) k_mod(const float* __restrict__ c, const float* __restrict__ w_ada, const float* __restrict__ b_ada, float* __restrict__ mod,
                                             const float* lq1, const float* lk1, const float* lq2, const float* lk2) {
    const int j = blockIdx.x * 256 + threadIdx.x, b = blockIdx.y;
    float acc = b_ada[j];
    for (int k = 0; k < DM; ++k) { const float cv = c[b * DM + k]; acc += (cv / (1.f + __expf(-cv))) * w_ada[(size_t)k * NMODC + j]; }
    mod[b * NMODC + j] = acc;
    if (blockIdx.x == 0 && blockIdx.y == 0 && threadIdx.x == 0) {
        float s1 = 0.f, s2 = 0.f;
        for (int i = 0; i < 64; ++i) { s1 += lq1[i] * lk1[i]; s2 += lq2[i] * lk2[i]; }
        mod[BATCH * NMODC] = __expf(s1) - __expf(s2) + 0.2f;
    }
}
__global__ void __launch_bounds__(256) k_rope_tab(const int* __restrict__ pos, float* __restrict__ cs, float* __restrict__ sn) {
    const int idx = blockIdx.x * 256 + threadIdx.x; if (idx >= M * 8) return;
    const int row = idx >> 3, i = idx & 7;
    const float invf = powf(500000.0f, -(float)i / 8.0f);
    const float ang = (float)pos[row] * invf;
    const double rev = (double)ang * 0.15915494309189535;
    const double fr = rev - rint(rev);
    cs[idx] = __builtin_amdgcn_cosf((float)fr); sn[idx] = __builtin_amdgcn_sinf((float)fr);
}
__global__ void __launch_bounds__(256) k_normmod(const float* __restrict__ x, const float* __restrict__ g, const float* __restrict__ mod, int sh_off, int sc_off, bf16_t* __restrict__ out) {
    const int row = blockIdx.x * 4 + (threadIdx.x >> 6), lane = threadIdx.x & 63, b = row / SEQ;
    const float* xr = x + (size_t)row * DM; float v[16]; float ss = 0.f;
#pragma unroll
    for (int j = 0; j < 16; ++j) { v[j] = xr[lane + 64 * j]; ss += v[j] * v[j]; }
#pragma unroll
    for (int o = 1; o < 64; o <<= 1) ss += __shfl_xor(ss, o);
    const float rstd = rsqrtf(ss * (1.f / DM) + EPS);
#pragma unroll
    for (int j = 0; j < 16; ++j) { const int k = lane + 64 * j; out[(size_t)row * DM + k] = f2bf(v[j] * rstd * g[k] * (1.f + mod[b * NMODC + sc_off + k]) + mod[b * NMODC + sh_off + k]); }
}
__global__ void __launch_bounds__(256) k_final(float* __restrict__ x, const float* __restrict__ g) {
    const int row = blockIdx.x * 4 + (threadIdx.x >> 6), lane = threadIdx.x & 63;
    float* xr = x + (size_t)row * DM; float v[16]; float ss = 0.f;
#pragma unroll
    for (int j = 0; j < 16; ++j) { v[j] = xr[lane + 64 * j]; ss += v[j] * v[j]; }
#pragma unroll
    for (int o = 1; o < 64; o <<= 1) ss += __shfl_xor(ss, o);
    const float rstd = rsqrtf(ss * (1.f / DM) + EPS);
#pragma unroll
    for (int j = 0; j < 16; ++j) { const int k = lane + 64 * j; xr[k] = v[j] * rstd * g[k]; }
}
template <class Epi> __global__ void __launch_bounds__(256) nv_gemm(const bf16_t* __restrict__ A, int lda, const float* __restrict__ W, int N, int K, Epi E) {
    __shared__ float As[16][68]; __shared__ float Bs[16][64];
    const int tid = threadIdx.x, tx = tid & 15, ty = tid >> 4, m0 = blockIdx.y * 64, n0 = blockIdx.x * 64;
    float acc[4][4] = {};
    for (int k0 = 0; k0 < K; k0 += 16) {
        { const int r = tid >> 2, kk = (tid & 3) * 4; const bf16_t* ap = A + (size_t)(m0 + r) * lda + k0 + kk;
          As[kk + 0][r] = bf2f(ap[0]); As[kk + 1][r] = bf2f(ap[1]); As[kk + 2][r] = bf2f(ap[2]); As[kk + 3][r] = bf2f(ap[3]); }
        { const int kk = tid >> 4, n = (tid & 15) * 4; const float4 w = *(const float4*)(W + (size_t)(k0 + kk) * N + n0 + n); *(float4*)&Bs[kk][n] = w; }
        __syncthreads();
#pragma unroll
        for (int k = 0; k < 16; ++k) { const float4 a = *(const float4*)&As[k][ty * 4]; const float4 b = *(const float4*)&Bs[k][tx * 4];
            const float av[4] = {a.x, a.y, a.z, a.w}, bv[4] = {b.x, b.y, b.z, b.w};
#pragma unroll
            for (int i = 0; i < 4; ++i)
#pragma unroll
                for (int j = 0; j < 4; ++j) acc[i][j] += av[i] * bv[j]; }
        __syncthreads();
    }
#pragma unroll
    for (int i = 0; i < 4; ++i)
#pragma unroll
        for (int j = 0; j < 4; ++j) E(m0 + ty * 4 + i, n0 + tx * 4 + j, acc[i][j]);
}
struct EProj { bf16_t *XR, *AO, *KB, *VB, *GT;
    __device__ void operator()(int m, int n, float v) const { const bf16_t o = f2bf(v);
        if (n < 1024) XR[(size_t)m * 1024 + n] = o; else if (n < 2048) AO[(size_t)m * 2048 + n - 1024] = o; else if (n < 3072) AO[(size_t)m * 2048 + 1024 + n - 2048] = o;
        else if (n < 4096) KB[(size_t)m * 1024 + n - 3072] = o; else if (n < 5120) VB[(size_t)m * 1024 + n - 4096] = o; else GT[(size_t)m * 2048 + n - 5120] = o; } };
struct EMergeA { const bf16_t* GT; bf16_t* MG; __device__ void operator()(int m, int n, float v) const { MG[(size_t)m * 1024 + n] = f2bf(nv_sigmoid(bf2f(GT[(size_t)m * 2048 + n])) * v); } };
struct EMergeB { const bf16_t* GT; bf16_t* MG; __device__ void operator()(int m, int n, float v) const { MG[(size_t)m * 1024 + n] = f2bf(bf2f(MG[(size_t)m * 1024 + n]) + nv_sigmoid(bf2f(GT[(size_t)m * 2048 + 1024 + n])) * v); } };
struct EOut { const float* x; const float* mod; float* X1; __device__ void operator()(int m, int n, float v) const { X1[(size_t)m * 1024 + n] = x[(size_t)m * 1024 + n] + mod[(m / SEQ) * NMODC + 2048 + n] * v; } };
struct EUp { bf16_t* UP; __device__ void operator()(int m, int n, float v) const { UP[(size_t)m * 5632 + n] = f2bf(v); } };
struct EDown { float* X; const float* mod; __device__ void operator()(int m, int n, float v) const { X[(size_t)m * 1024 + n] += mod[(m / SEQ) * NMODC + 5120 + n] * v; } };

__global__ void __launch_bounds__(256) k_rope(bf16_t* __restrict__ AO, bf16_t* __restrict__ KB, const float* __restrict__ cs, const float* __restrict__ sn) {
    const int idx = blockIdx.x * 256 + threadIdx.x; const int row = idx >> 4, hc = idx & 15;
    bf16_t* q = AO + (size_t)row * 2048 + 1024 + hc * 64; bf16_t* k = KB + (size_t)row * 1024 + hc * 64;
    float qv[64];
#pragma unroll
    for (int d = 0; d < 64; ++d) qv[d] = bf2f(q[d]);
#pragma unroll
    for (int i = 0; i < 8; ++i) { const float c = cs[row * 8 + i], s = sn[row * 8 + i]; const float a = qv[i], b = qv[i + 8]; qv[i] = a * c - b * s; qv[i + 8] = b * c + a * s;
        const float ka = bf2f(k[i]), kb = bf2f(k[i + 8]); k[i] = f2bf(ka * c - kb * s); k[i + 8] = f2bf(kb * c + ka * s); }
#pragma unroll
    for (int d = 0; d < 64; ++d) q[d] = f2bf(qv[d] * C2);
}
__global__ void __launch_bounds__(64) nv_rglru(const bf16_t* __restrict__ XR, bf16_t* __restrict__ AO, bf16_t* __restrict__ HF, const float* __restrict__ cw, const float* __restrict__ cb,
                                               const float* __restrict__ w_a, const float* __restrict__ b_a, const float* __restrict__ w_i, const float* __restrict__ b_i, const float* __restrict__ lam) {
    __shared__ float wA[64][64]; __shared__ float wI[64][64]; __shared__ float xcs[64];
    const int j = threadIdx.x, n = blockIdx.x, b = blockIdx.y, ch = n * 64 + j;
    const float c0 = cw[0 * DM + ch], c1 = cw[1 * DM + ch], c2 = cw[2 * DM + ch], c3 = cw[3 * DM + ch], cbv = cb[ch];
    for (int d = 0; d < 2; ++d) {
        __syncthreads();
        for (int k = 0; k < 64; ++k) { wA[k][j] = w_a[(((size_t)d * 16 + n) * 64 + k) * 64 + j]; wI[k][j] = w_i[(((size_t)d * 16 + n) * 64 + k) * 64 + j]; }
        const float ba = b_a[d * DM + ch], bi = b_i[d * DM + ch], sp = log1pf(__expf(-lam[d * DM + ch]));
        float h = 0.f;
        for (int tt = 0; tt < SEQ; ++tt) {
            const int t = d == 0 ? tt : SEQ - 1 - tt; const size_t row = (size_t)b * SEQ + t;
            float xc = cbv;
            if (t >= 2) xc += c0 * bf2f(XR[(row - 2) * DM + ch]);
            if (t >= 1) xc += c1 * bf2f(XR[(row - 1) * DM + ch]);
            xc += c2 * bf2f(XR[row * DM + ch]);
            if (t + 1 < SEQ) xc += c3 * bf2f(XR[(row + 1) * DM + ch]);
            __syncthreads(); xcs[j] = xc; __syncthreads();
            float ga = ba, gi = bi;
#pragma unroll 16
            for (int k = 0; k < 64; ++k) { const float xv = xcs[k]; ga += xv * wA[k][j]; gi += xv * wI[k][j]; }
            const float r = nv_sigmoid(ga), ig = nv_sigmoid(gi), la = -8.f * r * sp, a = __expf(la), u = sqrtf(-expm1f(2.f * la)) * ig * xc;
            h = a * h + u;
            if (d == 0) HF[row * DM + ch] = f2bf(h);
            else { const float yr = bf2f(AO[row * 2048 + ch]); AO[row * 2048 + ch] = f2bf((h + bf2f(HF[row * DM + ch])) * nv_gelu(yr)); }
        }
    }
}
__global__ void __launch_bounds__(256) nv_attn(bf16_t* __restrict__ AO, const bf16_t* __restrict__ KB, const bf16_t* __restrict__ VB, const float* __restrict__ subg, const float* __restrict__ scal) {
    __shared__ float Ks[64][64]; __shared__ float Vs[64][128];
    const int tid = threadIdx.x, qi = tid >> 3, chn = tid & 7, h = blockIdx.y, b = blockIdx.z;
    const size_t row = (size_t)b * SEQ + blockIdx.x * 32 + qi; const float lam = scal[0];
    float res[16];
    for (int c = 0; c < 2; ++c) {
        float q[64];
#pragma unroll
        for (int d = 0; d < 64; ++d) q[d] = bf2f(AO[row * 2048 + 1024 + h * 128 + c * 64 + d]);
        float m = -1e30f, l = 0.f, acc[16];
#pragma unroll
        for (int e = 0; e < 16; ++e) acc[e] = 0.f;
        for (int kt = 0; kt < SEQ / 64; ++kt) {
            __syncthreads();
            for (int i = 0; i < 16; ++i) { const int idx = tid + 256 * i, key = idx >> 6, d = idx & 63; Ks[key][d] = bf2f(KB[((size_t)b * SEQ + kt * 64 + key) * 1024 + h * 128 + c * 64 + d]); }
            for (int i = 0; i < 32; ++i) { const int idx = tid + 256 * i, key = idx >> 7, d = idx & 127; Vs[key][d] = bf2f(VB[((size_t)b * SEQ + kt * 64 + key) * 1024 + h * 128 + d]); }
            __syncthreads();
            for (int key = 0; key < 64; ++key) {
                float s = 0.f;
#pragma unroll
                for (int d = 0; d < 64; ++d) s += q[d] * Ks[key][d];
                const float mn = fmaxf(m, s), al = exp2f(m - mn), p = exp2f(s - mn); l = l * al + p; m = mn;
#pragma unroll
                for (int e = 0; e < 16; ++e) acc[e] = acc[e] * al + p * Vs[key][chn * 16 + e];
            }
        }
        const float inv = 1.f / l;
#pragma unroll
        for (int e = 0; e < 16; ++e) res[e] = c == 0 ? acc[e] * inv : res[e] - lam * acc[e] * inv;
    }
    float ss = 0.f;
#pragma unroll
    for (int e = 0; e < 16; ++e) ss += res[e] * res[e];
    ss += __shfl_xor(ss, 1); ss += __shfl_xor(ss, 2); ss += __shfl_xor(ss, 4);
    const float rstd = rsqrtf(ss * (1.f / 128.f) + EPS);
    __syncthreads();
#pragma unroll
    for (int e = 0; e < 16; ++e) AO[row * 2048 + 1024 + h * 128 + chn * 16 + e] = f2bf(res[e] * rstd * subg[chn * 16 + e] * 0.8f);
}
__global__ void __launch_bounds__(256) k_convact(const bf16_t* __restrict__ UP, int m0, const float* __restrict__ cw, const float* __restrict__ cb, bf16_t* __restrict__ ACT) {
    const int j = blockIdx.x * 256 + threadIdx.x, r = blockIdx.y; const int s = (m0 + r) % SEQ;
    float v = cb[j], g = cb[DFF + j];
#pragma unroll
    for (int k = 0; k < 3; ++k) { const int ss = s + k - 1; if (ss >= 0 && ss < SEQ) { v += cw[k * 2 * DFF + j] * bf2f(UP[(size_t)(r + k - 1) * 5632 + j]); g += cw[k * 2 * DFF + DFF + j] * bf2f(UP[(size_t)(r + k - 1) * 5632 + DFF + j]); } }
    ACT[(size_t)(m0 + r) * DFF + j] = f2bf(g / (1.f + __expf(-g)) * v);
}

#ifndef NAIVE_MASK
#define NAIVE_MASK 0x0
#endif
#ifndef ONE_LAUNCH
#define ONE_LAUNCH 1
#endif
extern "C" void kernel_launch(void* const* d_in, const int* in_sizes, int n_in, void* d_out, int out_size, void* d_ws, size_t ws_size, hipStream_t stream) {
    static int grid = 0;
    if (grid == 0) {
        if (n_in != 28 || in_sizes[0] != M * DM || out_size != M * DM || ws_size < WS_NEED) { fprintf(stderr, "kernel_launch: unexpected shapes (n_in %d, in0 %d, out %d, ws %zu); nothing launched\n", n_in, n_in > 0 ? in_sizes[0] : -1, out_size, ws_size); grid = -1; return; }
        int dev = 0, cus = 0, per_cu = 0;
        if (hipGetDevice(&dev) != hipSuccess || hipDeviceGetAttribute(&cus, hipDeviceAttributeMultiprocessorCount, dev) != hipSuccess) { grid = -1; return; }
        if (hipFuncSetAttribute((const void*)mk_fwd, hipFuncAttributeMaxDynamicSharedMemorySize, LDS_BYTES) != hipSuccess) { fprintf(stderr, "kernel_launch: hipFuncSetAttribute failed\n"); grid = -1; return; }
        if (hipOccupancyMaxActiveBlocksPerMultiprocessor(&per_cu, (const void*)mk_fwd, NWAVES * 64, LDS_BYTES) != hipSuccess || per_cu < 1) fprintf(stderr, "kernel_launch: occupancy query says %d\n", per_cu);
        (void)hipGetLastError();
        grid = cus;
        if (grid != 256) fprintf(stderr, "kernel_launch: %d CUs; built for 256\n", grid);
    }
    if (grid < 0) return;
    (void)hipMemsetAsync((char*)d_ws + WS_CTL, 0, CTL_ZERO_BYTES, stream);
    Args a{};
    for (int i = 0; i < 28; ++i) a.in[i] = d_in[i];
    a.out = (float*)d_out; a.ws = (unsigned char*)d_ws;
    int li = 0;
    auto L = [&](int lo, int hi, int flags) { a.ph_lo = lo; a.ph_hi = hi; a.li = li++; a.pad = flags; hipLaunchKernelGGL(mk_fwd, dim3(grid), dim3(NWAVES * 64), LDS_BYTES, stream, a); };
#if ONE_LAUNCH && (NAIVE_MASK == 0)
    L(0, N_PHASES, 3);
#else
    const float* x = (const float*)d_in[0]; const float* c = (const float*)d_in[1]; const int* pos = (const int*)d_in[2];
    const float* w_ada = (const float*)d_in[3]; const float* b_ada = (const float*)d_in[4]; const float* norm1_g = (const float*)d_in[5]; const float* w_in = (const float*)d_in[6];
    const float* conv_rnn_w = (const float*)d_in[7]; const float* conv_rnn_b = (const float*)d_in[8]; const float* w_rg_a = (const float*)d_in[9]; const float* b_rg_a = (const float*)d_in[10];
    const float* w_rg_i = (const float*)d_in[11]; const float* b_rg_i = (const float*)d_in[12]; const float* rg_lambda = (const float*)d_in[13]; const float* w_rnn_o = (const float*)d_in[14];
    const float* lq1 = (const float*)d_in[15]; const float* lk1 = (const float*)d_in[16]; const float* lq2 = (const float*)d_in[17]; const float* lk2 = (const float*)d_in[18];
    const float* subln_g = (const float*)d_in[19]; const float* w_attn_o = (const float*)d_in[20]; const float* w_out = (const float*)d_in[21]; const float* norm2_g = (const float*)d_in[22];
    const float* w_up = (const float*)d_in[23]; const float* conv_ffn_w = (const float*)d_in[24]; const float* conv_ffn_b = (const float*)d_in[25]; const float* w_down = (const float*)d_in[26];
    const float* final_g = (const float*)d_in[27];
    unsigned char* ws = (unsigned char*)d_ws; float* out = (float*)d_out;
    float* MOD = (float*)(ws + WS_MOD); float* COS = (float*)(ws + WS_COS); float* SIN = (float*)(ws + WS_SIN);
    bf16_t* H = (bf16_t*)(ws + WS_H); bf16_t* XR = (bf16_t*)(ws + WS_XR); bf16_t* AO = (bf16_t*)(ws + WS_AO); bf16_t* KB = (bf16_t*)(ws + WS_K); bf16_t* VB = (bf16_t*)(ws + WS_V);
    bf16_t* HF = (bf16_t*)(ws + WS_HF); bf16_t* GT = (bf16_t*)d_out; bf16_t* MG = XR; bf16_t* UP = (bf16_t*)(ws + WS_UP); bf16_t* ACT = (bf16_t*)(ws + WS_ACT);
    constexpr int NM = NAIVE_MASK;
    L(P_PRO, P_PRO + 1, 3);
    if (NM & 1) { k_mod<<<dim3(NMODC / 256, BATCH), 256, 0, stream>>>(c, w_ada, b_ada, MOD, lq1, lk1, lq2, lk2); k_rope_tab<<<M * 8 / 256, 256, 0, stream>>>(pos, COS, SIN); }
    if (NM & 2) k_normmod<<<M / 4, 256, 0, stream>>>(x, norm1_g, MOD, 0, 1024, H); else L(P_NORM1, P_NORM1 + 1, 3);
    if (NM & 4) { nv_gemm<EProj><<<dim3(INCOLS / 64, M / 64), 256, 0, stream>>>(H, DM, w_in, INCOLS, DM, EProj{XR, AO, KB, VB, GT}); k_rope<<<M * 16 / 256, 256, 0, stream>>>(AO, KB, COS, SIN); }
    else L(P_PROJ, P_PROJ + 1, 3);
    if (NM & 8) nv_rglru<<<dim3(16, BATCH), 64, 0, stream>>>(XR, AO, HF, conv_rnn_w, conv_rnn_b, w_rg_a, b_rg_a, w_rg_i, b_rg_i, rg_lambda); else L(P_MIX, P_MIX + 1, 1);
    if (NM & 16) nv_attn<<<dim3(SEQ / 32, 8, BATCH), 256, 0, stream>>>(AO, KB, VB, subln_g, MOD + BATCH * NMODC); else L(P_MIX, P_MIX + 1, 2);
    if (NM & 32) { nv_gemm<EMergeA><<<dim3(DM / 64, M / 64), 256, 0, stream>>>(AO, 2048, w_rnn_o, DM, DM, EMergeA{GT, MG}); nv_gemm<EMergeB><<<dim3(DM / 64, M / 64), 256, 0, stream>>>(AO + 1024, 2048, w_attn_o, DM, DM, EMergeB{GT, MG}); }
    else L(P_MERGE, P_MERGE + 1, 3);
    if (NM & 64) nv_gemm<EOut><<<dim3(DM / 64, M / 64), 256, 0, stream>>>(MG, DM, w_out, DM, DM, EOut{x, MOD, out}); else L(P_OUT, P_OUT + 1, 3);
    if (NM & 128) k_normmod<<<M / 4, 256, 0, stream>>>(out, norm2_g, MOD, 3072, 4096, H); else L(P_NORM2, P_NORM2 + 1, 3);
    if (NM & 256) { for (int half = 0; half < 2; ++half) { const int m0 = half * (M / 2);
            nv_gemm<EUp><<<dim3(2 * DFF / 64, M / 2 / 64), 256, 0, stream>>>(H + (size_t)m0 * DM, DM, w_up, 2 * DFF, DM, EUp{UP});
            k_convact<<<dim3(DFF / 256, M / 2), 256, 0, stream>>>(UP, m0, conv_ffn_w, conv_ffn_b, ACT); } }
    else { L(P_UP, P_UP + 1, 3); L(P_FIX, P_FIX + 1, 3); }
    if (NM & 512) nv_gemm<EDown><<<dim3(DM / 64, M / 64), 256, 0, stream>>>(ACT, DFF, w_down, DM, DFF, EDown{out, MOD}); else L(P_DOWN, P_DOWN + 1, 3);
    if (NM & 1024) k_final<<<M / 4, 256, 0, stream>>>(out, final_g); else L(P_FINAL, P_FINAL + 1, 3);
#endif
}
```
